# Optimizing an MI355X kernel written in HIP

```python
import math
import jax
import jax.numpy as jnp
from jax import lax
import numpy as np

D_MODEL = 2048
BATCH = 2
SEQ = 8192
DEPTH = 1

N_META = 16
POOL_WIDTH = D_MODEL // 2
POOL_WINDOWS = (2, 4, 8, 16)
POOL_GROUPS = len(POOL_WINDOWS)
POOL_GROUP_WIDTH = POOL_WIDTH // POOL_GROUPS
SSM_WIDTH = D_MODEL // 2
SSM_GROUP_CH = 16
SSM_GROUPS = SSM_WIDTH // SSM_GROUP_CH
SSM_STATE = 64
DT_MIN = 1e-3
DT_MAX = 1e-1
GATE_OFFSET = POOL_WIDTH + SSM_WIDTH
IN_WIDTH = GATE_OFFSET + 2 * D_MODEL
MOE_GROUPS = 8
EXPERTS_PER_GROUP = 8
N_EXPERTS = MOE_GROUPS * EXPERTS_PER_GROUP
TOP_K_WITHIN = 2
EXPERT_FF = D_MODEL // 4
MOE_BLOCK = 128
RMS_EPS = 1e-6

kernel_name = 'hybrid_pool_s5_hmoe_block'


def rms_norm(x, g):
    x32 = x.astype(jnp.float32)
    y = x32 * lax.rsqrt(jnp.mean(x32 * x32, axis=-1, keepdims=True) + RMS_EPS)
    return (y * g.astype(jnp.float32)).astype(x.dtype)


def pool_mixer(u, pool_w, pool_scale):
    bn, L, C = u.shape
    u32 = u.astype(jnp.float32)
    cs = jnp.cumsum(u32, axis=1)
    pos = jnp.arange(L)
    parts = []
    for g, w in enumerate(POOL_WINDOWS):
        sl = slice(g * POOL_GROUP_WIDTH, (g + 1) * POOL_GROUP_WIDTH)
        csg = cs[..., sl]
        shifted = jnp.pad(csg, ((0, 0), (w, 0), (0, 0)))[:, :L]
        cnt = jnp.minimum(pos + 1, w).astype(jnp.float32)[None, :, None]
        parts.append((csg - shifted) / cnt - u32[..., sl])
    d = jnp.stack(parts, axis=2).astype(u.dtype)
    y = jnp.einsum('blgc,gcd->blgd', d, pool_w).reshape(bn, L, C)
    return y * pool_scale


def s5_ssm(u, a_re, a_im, log_dt, b_re, b_im, c_re, c_im, d):
    bn, L, Q = u.shape
    u32 = u.astype(jnp.float32)
    ug = u32.reshape(bn, L, SSM_GROUPS, SSM_GROUP_CH)
    ar = a_re.astype(jnp.float32)
    ai = a_im.astype(jnp.float32)
    dt = jnp.exp(log_dt.astype(jnp.float32))[:, None]
    mag = jnp.exp(ar * dt)
    lam_re = mag * jnp.cos(ai * dt)
    lam_im = mag * jnp.sin(ai * dt)
    den = ar * ar + ai * ai
    nr = lam_re - 1.0
    coef_re = (nr * ar + lam_im * ai) / den
    coef_im = (lam_im * ar - nr * ai) / den
    br = b_re.astype(jnp.float32)
    bi = b_im.astype(jnp.float32)
    bb_re = coef_re[..., None] * br - coef_im[..., None] * bi
    bb_im = coef_re[..., None] * bi + coef_im[..., None] * br
    bu_re = jnp.einsum('blgh,gnh->blgn', ug, bb_re)
    bu_im = jnp.einsum('blgh,gnh->blgn', ug, bb_im)
    la_re = jnp.broadcast_to(lam_re, bu_re.shape)
    la_im = jnp.broadcast_to(lam_im, bu_im.shape)

    def combine(e1, e2):
        a1r, a1i, b1r, b1i = e1
        a2r, a2i, b2r, b2i = e2
        return (a2r * a1r - a2i * a1i,
                a2r * a1i + a2i * a1r,
                a2r * b1r - a2i * b1i + b2r,
                a2r * b1i + a2i * b1r + b2i)

    _, _, xr, xi = lax.associative_scan(combine, (la_re, la_im, bu_re, bu_im), axis=1)
    y = (jnp.einsum('blgn,ghn->blgh', xr, c_re.astype(jnp.float32))
         - jnp.einsum('blgn,ghn->blgh', xi, c_im.astype(jnp.float32)))
    y = y.reshape(bn, L, Q) + d.astype(jnp.float32) * u32
    return y.astype(u.dtype)


def hier_moe(v, w_rg, b_rg, w_re, b_re, w_gate, w_up, w_down):
    bn, L, D = v.shape
    N = bn * L
    vf = v.reshape(N, D)
    gl = (vf @ w_rg).astype(jnp.float32) + b_rg.astype(jnp.float32)
    p_group = jax.nn.softmax(gl, axis=-1)
    _, g_star = lax.top_k(gl, 1)
    pg = jnp.take_along_axis(p_group, g_star, axis=1)
    el = ((vf @ w_re).astype(jnp.float32) + b_re.astype(jnp.float32)).reshape(N, MOE_GROUPS, EXPERTS_PER_GROUP)
    g_idx = jnp.broadcast_to(g_star[:, :, None], (N, 1, EXPERTS_PER_GROUP))
    el_sel = jnp.take_along_axis(el, g_idx, axis=1)[:, 0]
    ev, ei = lax.top_k(el_sel, TOP_K_WITHIN)
    gate = pg * jax.nn.softmax(ev, axis=-1)
    eid = g_star * EXPERTS_PER_GROUP + ei

    M = N * TOP_K_WITHIN
    e_flat = eid.reshape(M)
    w_flat = gate.reshape(M)
    tok_flat = jnp.arange(M, dtype=jnp.int32) // TOP_K_WITHIN
    order = jnp.argsort(e_flat)
    se = e_flat[order]
    stok = tok_flat[order]
    sw = w_flat[order]
    counts = jnp.zeros((N_EXPERTS,), jnp.int32).at[e_flat].add(1)
    padded = ((counts + MOE_BLOCK - 1) // MOE_BLOCK) * MOE_BLOCK
    pend = jnp.cumsum(padded)
    pstart = pend - padded
    start = jnp.cumsum(counts) - counts
    dest = pstart[se] + (jnp.arange(M, dtype=jnp.int32) - start[se])
    T = ((M + N_EXPERTS * (MOE_BLOCK - 1) + MOE_BLOCK - 1) // MOE_BLOCK) * MOE_BLOCK
    NB = T // MOE_BLOCK
    buf_tok = jnp.full((T,), N, jnp.int32).at[dest].set(stok)
    buf_w = jnp.zeros((T,), jnp.float32).at[dest].set(sw)
    block_e = jnp.clip(jnp.searchsorted(pend, jnp.arange(NB, dtype=jnp.int32) * MOE_BLOCK, side='right'),
                       0, N_EXPERTS - 1)
    vpad = jnp.concatenate([vf, jnp.zeros((1, D), vf.dtype)], axis=0)
    xb = vpad[buf_tok].reshape(NB, MOE_BLOCK, D)

    def expert_block(args):
        xblk, e = args
        hg = xblk @ w_gate[e]
        hu = xblk @ w_up[e]
        return (jax.nn.silu(hg) * hu) @ w_down[e]

    yb = lax.map(expert_block, (xb, block_e)).reshape(T, D)
    yb = yb * buf_w[:, None].astype(yb.dtype)
    out = jnp.zeros((N + 1, D), yb.dtype).at[buf_tok].add(yb)[:N]
    return out.reshape(bn, L, D)


def setup_inputs(seed: int = 0) -> dict:
    key = jax.random.key(seed)
    ks = jax.random.split(key, 32)
    f32 = jnp.float32

    def nrm(k, shape, scale):
        return jax.random.normal(k, shape, f32) * scale

    D = D_MODEL
    G, N, H = SSM_GROUPS, SSM_STATE, SSM_GROUP_CH
    n_idx = jnp.arange(SSM_STATE, dtype=f32)
    return {
        'x': nrm(ks[0], (BATCH, SEQ, D), 1.0),
        'meta': nrm(ks[1], (N_META, D), 1.0),
        'norm_mix': 1.0 + nrm(ks[2], (DEPTH, D), 0.02),
        'w_in': nrm(ks[3], (DEPTH, D, IN_WIDTH), D ** -0.5),
        'pool_w': nrm(ks[4], (DEPTH, POOL_GROUPS, POOL_GROUP_WIDTH, POOL_GROUP_WIDTH), POOL_GROUP_WIDTH ** -0.5),
        'pool_scale': 1.0 + nrm(ks[5], (DEPTH, POOL_WIDTH), 0.1),
        'ssm_a_re': -0.5 + nrm(ks[6], (DEPTH, G, N), 0.01),
        'ssm_a_im': math.pi * n_idx + nrm(ks[7], (DEPTH, G, N), 0.01),
        'ssm_log_dt': jax.random.uniform(ks[8], (DEPTH, G), f32, math.log(DT_MIN), math.log(DT_MAX)),
        'ssm_b_re': nrm(ks[9], (DEPTH, G, N, H), (2 * H) ** -0.5),
        'ssm_b_im': nrm(ks[10], (DEPTH, G, N, H), (2 * H) ** -0.5),
        'ssm_c_re': nrm(ks[11], (DEPTH, G, H, N), N ** -0.5),
        'ssm_c_im': nrm(ks[12], (DEPTH, G, H, N), N ** -0.5),
        'ssm_d': nrm(ks[13], (DEPTH, SSM_WIDTH), 1.0),
        'w_glu': nrm(ks[14], (DEPTH, SSM_WIDTH, SSM_WIDTH), SSM_WIDTH ** -0.5),
        'b_glu': nrm(ks[15], (DEPTH, SSM_WIDTH), 0.01),
        'w_branch_pool': nrm(ks[16], (DEPTH, POOL_WIDTH, D), POOL_WIDTH ** -0.5),
        'w_branch_ssm': nrm(ks[17], (DEPTH, SSM_WIDTH, D), SSM_WIDTH ** -0.5),
        'w_out': nrm(ks[18], (DEPTH, D, D), D ** -0.5),
        'norm_ffn': 1.0 + nrm(ks[19], (DEPTH, D), 0.02),
        'w_router_group': nrm(ks[20], (DEPTH, D, MOE_GROUPS), D ** -0.5),
        'b_router_group': nrm(ks[21], (DEPTH, MOE_GROUPS), 0.01),
        'w_router_expert': nrm(ks[22], (DEPTH, D, N_EXPERTS), D ** -0.5),
        'b_router_expert': nrm(ks[23], (DEPTH, N_EXPERTS), 0.01),
        'w_gate': nrm(ks[24], (DEPTH, N_EXPERTS, D, EXPERT_FF), D ** -0.5),
        'w_up': nrm(ks[25], (DEPTH, N_EXPERTS, D, EXPERT_FF), D ** -0.5),
        'w_down': nrm(ks[26], (DEPTH, N_EXPERTS, EXPERT_FF, D), EXPERT_FF ** -0.5),
        'norm_final': 1.0 + nrm(ks[27], (D,), 0.02),
    }


def reference(x, meta, norm_mix, w_in, pool_w, pool_scale, ssm_a_re, ssm_a_im, ssm_log_dt,
              ssm_b_re, ssm_b_im, ssm_c_re, ssm_c_im, ssm_d, w_glu, b_glu, w_branch_pool,
              w_branch_ssm, w_out, norm_ffn, w_router_group, b_router_group, w_router_expert,
              b_router_expert, w_gate, w_up, w_down, norm_final):
    bn = x.shape[0]
    meta_b = jnp.broadcast_to(meta[None].astype(x.dtype), (bn, N_META, D_MODEL))
    h = jnp.concatenate([meta_b, x], axis=1)
    for l in range(DEPTH):
        u = rms_norm(h, norm_mix[l])
        z = u @ w_in[l]
        z_pool = z[..., :POOL_WIDTH]
        z_ssm = z[..., POOL_WIDTH:GATE_OFFSET]
        gate_pool = jax.nn.sigmoid(z[..., GATE_OFFSET:GATE_OFFSET + D_MODEL])
        gate_ssm = jax.nn.sigmoid(z[..., GATE_OFFSET + D_MODEL:])
        y_pool = pool_mixer(z_pool, pool_w[l], pool_scale[l]) @ w_branch_pool[l]
        s = s5_ssm(z_ssm, ssm_a_re[l], ssm_a_im[l], ssm_log_dt[l], ssm_b_re[l], ssm_b_im[l],
                   ssm_c_re[l], ssm_c_im[l], ssm_d[l])
        s = jax.nn.gelu(s)
        s = s * jax.nn.sigmoid(s @ w_glu[l] + b_glu[l])
        y_ssm = s @ w_branch_ssm[l]
        merged = gate_pool * y_pool + gate_ssm * y_ssm
        h = h + merged @ w_out[l]
        v = rms_norm(h, norm_ffn[l])
        h = h + hier_moe(v, w_router_group[l], b_router_group[l], w_router_expert[l],
                         b_router_expert[l], w_gate[l], w_up[l], w_down[l])
    return rms_norm(h, norm_final)[:, N_META:]
```

```cpp
#include <hip/hip_runtime.h>
#include <hip/hip_cooperative_groups.h>
#include <cstdio>
#include <cstdint>
namespace cg = cooperative_groups;

#define GAS __attribute__((address_space(1)))
#define LAS __attribute__((address_space(3)))
typedef unsigned short bf16_t;
typedef short bf16x8 __attribute__((ext_vector_type(8)));
typedef float f32x4 __attribute__((ext_vector_type(4)));
typedef float f32x16 __attribute__((ext_vector_type(16)));
typedef float f32x2 __attribute__((ext_vector_type(2)));
typedef unsigned u32x4 __attribute__((ext_vector_type(4)));
typedef unsigned u32x2 __attribute__((ext_vector_type(2)));
typedef __bf16 bf16x2v __attribute__((ext_vector_type(2)));
#define DI __device__ __forceinline__
#define RLX_AGENT __ATOMIC_RELAXED, __HIP_MEMORY_SCOPE_AGENT
#define LDS_WAIT() asm volatile("s_waitcnt lgkmcnt(0)" ::: "memory")
#define VM_WAIT() asm volatile("s_waitcnt vmcnt(0)" ::: "memory")

DI unsigned pk2(float lo, float hi) { f32x2 v = {lo, hi}; bf16x2v r = __builtin_convertvector(v, bf16x2v); return __builtin_bit_cast(unsigned, r); }
DI float bflo(unsigned w) { return __uint_as_float(w << 16); }
DI float bfhi(unsigned w) { return __uint_as_float(w & 0xffff0000u); }
DI float fsigm(float x) { return __builtin_amdgcn_rcpf(1.f + __builtin_amdgcn_exp2f(-1.4426950408889634f * x)); }
DI float gelu_t(float x) { const float z = 1.5957691216057308f * (x + 0.044715f * x * x * x); return x * fsigm(z); }
DI float wave_sum(float v) {
#pragma unroll
    for (int o = 1; o < 64; o <<= 1) v += __shfl_xor(v, o);
    return v;
}

constexpr int DM = 2048, SEQ = 8192, NTOK = 16384, NMETA = 16, INW = 6144, PW = 1024, SW = 1024, FF = 512, NE = 64;
constexpr int NCH = 64, CHL = 128;
constexpr int LISTCAP = 16384;
constexpr int HH_ROWS = 49152;
constexpr float RMS_EPS = 1e-6f;
constexpr size_t MiB = 1u << 20;
constexpr size_t WS_CTL = 0, CTL_ZERO_BYTES = 1 * MiB;
constexpr size_t WS_LAM = 1 * MiB, WS_LAMP = WS_LAM + 65536, WS_BCAT = WS_LAM + 262144, WS_CCATT = WS_LAM + 524288, WS_WRH = WS_LAM + 786432, WS_WRL = WS_WRH + 393216,
                 WS_A1M = WS_WRL + 393216, WS_SCR = WS_A1M + 65536, WS_RSTD1 = WS_SCR + 65536, WS_E = 3 * MiB, WS_LIST = 8 * MiB;
constexpr size_t WS_WIN = 24 * MiB, WS_POOLW = 48 * MiB, WS_WGLU = 49 * MiB, WS_WBP = 51 * MiB, WS_WBS = 55 * MiB, WS_WOUT = 59 * MiB, WS_WGU = 68 * MiB, WS_WD = 324 * MiB;
constexpr size_t WS_A1 = 452 * MiB, WS_V = WS_A1;
constexpr size_t WS_ZP = 516 * MiB, WS_ZS = 549 * MiB, WS_DD = 582 * MiB, WS_PP = 614 * MiB, WS_S0 = 646 * MiB, WS_SS = 678 * MiB, WS_HH = 516 * MiB, WS_DL = WS_DD;
constexpr size_t WS_GP = 710 * MiB, WS_GS = 774 * MiB, WS_YB = 710 * MiB, WS_MP = 838 * MiB, WS_DBG = 902 * MiB, WS_END = 1024 * MiB;
static_assert(WS_RSTD1 + 65536 <= WS_E && WS_E + (size_t)64 * 64 * 64 * 16 <= WS_LIST && WS_LIST + (size_t)NE * LISTCAP * 16 <= WS_WIN, "small region");
static_assert(WS_HH + (size_t)HH_ROWS * FF * 2 <= WS_GP && WS_YB + (size_t)32768 * DM * 2 <= WS_MP, "overlays");
constexpr int CW_BAR = 4096;
constexpr int CW_BAR2 = 8192;
constexpr int CW_CNT = 16384;
constexpr int CW_DBG = 20480;
constexpr int CW_Q = 24576;

#define XB_TMO      128
#define XB_XCNT(j)  (256  + 64 * (j))
#define XB_XSUB(j)  (1280 + 64 * (j))
#define XB_XGEN(j)  (2304 + 64 * (j))
#define XB_TOP      3328
#define XB_TOPGEN   3392
#define XCD_BAR_WORDS 3456
#define XB_SPIN_CAP (1u << 18)
DI unsigned xb_ld(unsigned* p)              { return __hip_atomic_load(p, __ATOMIC_RELAXED, __HIP_MEMORY_SCOPE_AGENT); }
DI unsigned xb_add(unsigned* p, unsigned v) { return __hip_atomic_fetch_add(p, v, __ATOMIC_RELAXED, __HIP_MEMORY_SCOPE_AGENT); }
DI unsigned xb_xcc_id() { return (unsigned)__builtin_amdgcn_s_getreg((3 << 11) | 20) & 0xFu; }
#define XB_SPIN(cond, bar) do { unsigned _sp = 0; while (cond) { __builtin_amdgcn_s_sleep(1); \
    if ((++_sp & 255u) == 0u) { if (xb_ld(&(bar)[XB_TMO])) break; if (_sp > XB_SPIN_CAP) { atomicAdd(&(bar)[XB_TMO], 1u); break; } } } } while (0)
struct XcdBarrier { unsigned* bar; unsigned x; volatile LAS unsigned* st; unsigned expected; };
DI XcdBarrier xcd_barrier_post(unsigned* bar, volatile LAS unsigned* st, unsigned expected) {
    XcdBarrier b; b.bar = bar; b.x = xb_xcc_id(); b.st = st; b.expected = expected;
    if (threadIdx.x == 0) (void)xb_add(&bar[XB_XCNT(b.x)], 1u);
    return b;
}
DI void xcd_barrier_complete(unsigned* bar, unsigned x, unsigned& nloc, unsigned& nx, unsigned G) {
    unsigned sum, cnt, mine, sp = 0u;
    for (;;) {
        sum = 0u; cnt = 0u; mine = 0u;
#pragma unroll
        for (unsigned j = 0; j < 16; ++j) { const unsigned c = xb_ld(&bar[XB_XCNT(j)]); sum += c; cnt += (c > 0u) ? 1u : 0u; mine = (j == x) ? c : mine; }
        if (sum == G) break;
        __builtin_amdgcn_s_sleep(1);
        if ((++sp & 255u) == 0u) { if (xb_ld(&bar[XB_TMO])) break; if (sp > XB_SPIN_CAP) { atomicAdd(&bar[XB_TMO], 1u); break; } }
    }
    nloc = mine > 0u ? mine : 1u; nx = cnt > 0u ? cnt : 1u;
}
DI void xcd_barrier(const XcdBarrier& b) {
    asm volatile("s_waitcnt vmcnt(0)" ::: "memory");
    __syncthreads();
    if (threadIdx.x == 0) {
        unsigned* bar = b.bar;
        __builtin_amdgcn_s_waitcnt(0);
        unsigned nloc = b.st[0], nx = b.st[1];
        if (nloc == 0u) { xcd_barrier_complete(bar, b.x, nloc, nx, b.expected); b.st[0] = nloc; b.st[1] = nx; }
        const unsigned old = xb_add(&bar[XB_XSUB(b.x)], 1u);
        const unsigned gen = old / nloc;
        if (old + 1u == (gen + 1u) * nloc) {
            __builtin_amdgcn_fence(__ATOMIC_RELEASE, "agent");
            asm volatile("s_waitcnt vmcnt(0)" ::: "memory");
            const unsigned og = xb_add(&bar[XB_TOP], 1u);
            const unsigned tg = og / nx;
            if (og + 1u == (tg + 1u) * nx) xb_add(&bar[XB_TOPGEN], 1u);
            else XB_SPIN(xb_ld(&bar[XB_TOPGEN]) == tg, bar);
            __builtin_amdgcn_fence(__ATOMIC_ACQUIRE, "agent");
            xb_add(&bar[XB_XGEN(b.x)], 1u);
            asm volatile("s_waitcnt vmcnt(0)" ::: "memory");
        } else {
            XB_SPIN(xb_ld(&bar[XB_XGEN(b.x)]) == gen, bar);
            __builtin_amdgcn_fence(__ATOMIC_ACQUIRE, "agent");
            asm volatile("s_waitcnt vmcnt(0)" ::: "memory");
        }
    }
    __syncthreads();
}

namespace pg8 {
constexpr int BM = 256, BK = 64, HALF = 128, HTB = HALF * BK * 2, STAGE_BYTES = 8 * HTB, NXCD = 8, WGM = 8;
__host__ __device__ __forceinline__ int lds_byte(int r, int c) { const int st = (r >> 4) * 2 + (c >> 5), rr = r & 15, cc = c & 31, ob = rr * 64 + cc * 2; return st * 1024 + (ob ^ (((ob >> 9) & 1) << 5)); }
__host__ __device__ __forceinline__ void stage_rc(int b, int& R, int& C) { const int st = b / 1024, sb = b % 1024, swz = sb ^ (((sb >> 9) & 1) << 5); R = (st >> 1) * 16 + swz / 64; C = (st & 1) * 32 + (swz % 64) / 2; }
__host__ __device__ __forceinline__ int perm32(int rho) { const int n = rho >> 4, i = rho & 15; return 8 * (i >> 2) + 4 * n + (i & 3); }

struct Unit { const char* A; const char* B; int pm, pn, e, cnt; const uint4* list; };
struct Gemm { int lda, ldb, K; };

struct GridOrder {
    int nM, nN, nwg, G, c;
    DI void init(int nM_, int nN_, int G_, int c_) { nM = nM_; nN = nN_; nwg = nM * nN; G = G_; c = c_; }
    DI bool tile(int i, int& pm, int& pn) const {
        const long L = (long)i * G + c; if (L >= nwg) return false;
        int wgid = (int)L; { const int q = nwg / NXCD, r = nwg % NXCD, xcd = wgid % NXCD, off = wgid / NXCD; wgid = (xcd < r ? xcd * (q + 1) : r * (q + 1) + (xcd - r) * q) + off; }
        const int nig = WGM * nN, gid = wgid / nig, fm = gid * WGM, gsz = (nM - fm) < WGM ? (nM - fm) : WGM;
        pm = fm + ((wgid % nig) % gsz); pn = (wgid % nig) / gsz; return true;
    }
};
struct DenseOrder : GridOrder {
    static constexpr bool GATHER = false;
    const char* A; const char* Bt; size_t tstepA, tstepB;
    DI void setup(const void* A_, const void* Bt_, int M, int N, int lda, int ldb, int G_, int c_) { init(M / BM, N / BM, G_, c_); A = (const char*)A_; Bt = (const char*)Bt_; tstepA = (size_t)BM * lda * 2; tstepB = (size_t)BM * ldb * 2; }
    DI bool next(int i, Unit& u) const { int pm, pn; if (!tile(i, pm, pn)) return false; u.pm = pm; u.pn = pn; u.e = 0; u.cnt = 256; u.list = nullptr; u.A = A + (size_t)pm * tstepA; u.B = Bt + (size_t)pn * tstepB; return true; }
};

constexpr int SIDE_I_GU = 64 * 32 * 16, SIDE_I_DN = 64 * 8 * 64, SIDE_ITEMS = 2 * SIDE_I_GU + SIDE_I_DN;
struct SideNone { static constexpr bool ON = false; };
struct SideConv {
    static constexpr bool ON = true;
    const float *wg, *wu, *wd; bf16_t *WGU, *WD, *scratch; LAS unsigned char* xb;
    int next, end, stride;
    bf16_t* dst0; bf16_t* dst1; int ldt0, ldt1;
    DI void init(const float* wg_, const float* wu_, const float* wd_, bf16_t* WGU_, bf16_t* WD_, bf16_t* scratch_, LAS unsigned char* xb_, int begin, int end_, int stride_) {
        wg = wg_; wu = wu_; wd = wd_; WGU = WGU_; WD = WD_; scratch = scratch_; xb = xb_; next = begin; end = end_; stride = stride_; dst0 = scratch_; dst1 = scratch_; ldt0 = 0; ldt1 = 0; }
    template <int SLOT> DI void issue(int wid, int lane) {
#ifndef SIDE_PROBE
#define SIDE_PROBE 0
#endif
        int idx = next; bool valid = idx < end; if (valid) next += stride; else idx = 0;
        if (SIDE_PROBE == 2) idx = 0;
        const float* W; int ldw, k0, n0, ldt, drow0; bf16_t* WT;
        if (idx < 2 * SIDE_I_GU) { const int up = idx / SIDE_I_GU, q = idx % SIDE_I_GU, e = q >> 9, q2 = q & 511, kb = q2 >> 4, nb = q2 & 15; n0 = 32 * nb; k0 = 64 * kb;
            W = (up ? wu : wg) + (size_t)e * 2048 * 512; ldw = 512; WT = WGU + (size_t)e * 1024 * 2048; ldt = 2048; drow0 = (n0 >> 7) * 256 + (n0 & 127) + up * 128; }
        else { const int r = idx - 2 * SIDE_I_GU, e = r >> 9, q2 = r & 511, kb = q2 >> 6, nb = q2 & 63; n0 = 32 * nb; k0 = 64 * kb;
            W = wd + (size_t)e * 512 * 2048; ldw = 2048; WT = WD + (size_t)e * 2048 * 512; ldt = 512; drow0 = n0; }
        const float* src = W + (size_t)(k0 + 8 * wid + (lane >> 3)) * ldw + n0 + (lane & 7) * 4;
        __builtin_amdgcn_global_load_lds((const unsigned*)src, (LAS unsigned*)(xb + SLOT * 8192 + wid * 1024), 16, 0, 0);
        if (SIDE_PROBE == 1 || SIDE_PROBE == 2) valid = false;
        bf16_t* d = valid ? WT + (size_t)drow0 * ldt + k0 : scratch; const int l2 = valid ? ldt : 0;
        if (SLOT == 0) { dst0 = d; ldt0 = l2; } else { dst1 = d; ldt1 = l2; }
    }
    template <int SLOT> DI void read(int tid, f32x4& v) const {
        const LAS float* xf = (const LAS float*)(xb + SLOT * 8192) + (tid >> 5) * 128 + (tid & 31);
        v[0] = xf[0]; v[1] = xf[32]; v[2] = xf[64]; v[3] = xf[96];
    }
    template <int SLOT> DI void store(int tid, const f32x4& v) const {
        bf16_t* d = (SLOT == 0 ? dst0 : dst1) + (size_t)(tid & 31) * (SLOT == 0 ? ldt0 : ldt1) + 4 * (tid >> 5);
        u32x2 w; w.x = pk2(v[0], v[1]); w.y = pk2(v[2], v[3]); *(u32x2*)d = w;
    }
};

template <class Epi, class Sched, bool ALIGN_EPI = false, bool SP2 = true, class Side = SideNone>
__device__ __forceinline__ void gemm_phase(LAS unsigned char* lds, const Gemm g, const Sched& S, const Epi& E, Side side = Side()) {
    const int tid = threadIdx.x, wid = __builtin_amdgcn_readfirstlane(tid >> 6), lane = tid & 63, wr = wid >> 2, wc = wid & 3, fr = lane & 15, fq = lane >> 4;
    const int K = g.K, nt = K / BK;
    unsigned voffB[2], oA0[2], oA1[2], nA0[2], nA1[2]; int sR[2], sC[2];
    const size_t kstep = (size_t)(BK * 2);
    const unsigned hstepA = (unsigned)HALF * g.lda * 2u; const size_t hstepB = (size_t)HALF * g.ldb * 2;
#pragma unroll
    for (int i = 0; i < 2; ++i) { int R, C; stage_rc(tid * 16 + i * 8192, R, C); const int Rb = Epi::PERM ? ((R & ~31) + perm32(R & 31)) : R; sR[i] = R; sC[i] = C;
        voffB[i] = (unsigned)(Rb * g.ldb + C) * 2u; oA0[i] = (unsigned)(R * g.lda + C) * 2u; oA1[i] = oA0[i] + hstepA; nA0[i] = oA0[i]; nA1[i] = oA1[i]; }
    const unsigned ldsw = (unsigned)wid * 1024u;
    const int aoff = lds_byte(wr * 64 + fr, fq * 8), boff = lds_byte(wc * 32 + fr, fq * 8);
#define PG8_SA(b, h) (((b) * 2 + (h)) * HTB)
#define PG8_SB(b, h) ((4 + (b) * 2 + (h)) * HTB)
#define PG8_STAGE(bufoff, gbase, voff) do { _Pragma("unroll") for (int _i = 0; _i < 2; ++_i) \
        __builtin_amdgcn_global_load_lds((const unsigned*)((const char*)(gbase) + (voff)[_i]), (LAS unsigned*)(lds + (bufoff) + ldsw + _i * 8192), 16, 0, 0); } while (0)
#define PG8_LDA(dst, b, h) do { _Pragma("unroll") for (int m = 0; m < 4; ++m) _Pragma("unroll") for (int k = 0; k < 2; ++k) dst[m][k] = *(const LAS bf16x8*)(lds + PG8_SA(b, h) + aoff + m * 2048 + k * 1024); } while (0)
#define PG8_LDB(dst, b, h) do { _Pragma("unroll") for (int n = 0; n < 2; ++n) _Pragma("unroll") for (int k = 0; k < 2; ++k) dst[n][k] = *(const LAS bf16x8*)(lds + PG8_SB(b, h) + boff + n * 2048 + k * 1024); } while (0)
#define PG8_MMA(ai, bj, At, Bt) do { __builtin_amdgcn_s_setprio(1); _Pragma("unroll") for (int m = 0; m < 4; ++m) _Pragma("unroll") for (int n = 0; n < 2; ++n) _Pragma("unroll") for (int k = 0; k < 2; ++k) \
        acc[ai][bj][m][n] = __builtin_amdgcn_mfma_f32_16x16x32_bf16(Bt[n][k], At[m][k], acc[ai][bj][m][n], 0, 0, 0); __builtin_amdgcn_s_setprio(0); } while (0)
#define PG8_WAIT_V(n) asm volatile("s_waitcnt vmcnt(" #n ")" ::: "memory")
#define PG8_WAIT_L(n) asm volatile("s_waitcnt lgkmcnt(" #n ")" ::: "memory")
#define PG8_BAR __builtin_amdgcn_s_barrier()
#define PG8_SCHED __builtin_amdgcn_sched_barrier(0)
#define PG8_GOFF(u, d0, d1) do { _Pragma("unroll") for (int _i = 0; _i < 2; ++_i) { \
        const unsigned _t0 = (u).list[sR[_i]].x, _t1 = (u).list[HALF + sR[_i]].x; d0[_i] = (_t0 * (unsigned)g.lda + (unsigned)sC[_i]) * 2u; d1[_i] = (_t1 * (unsigned)g.lda + (unsigned)sC[_i]) * 2u; } } while (0)
    Unit cur, nxt; int ui = 0;
    if (!S.next(0, cur)) return;
    f32x4 acc[2][2][4][2];
#pragma unroll
    for (int a = 0; a < 2; ++a)
#pragma unroll
        for (int b = 0; b < 2; ++b)
#pragma unroll
            for (int m = 0; m < 4; ++m)
#pragma unroll
                for (int n = 0; n < 2; ++n) acc[a][b][m][n] = (f32x4){0.f, 0.f, 0.f, 0.f};
    bf16x8 At[4][2], B0[2][2], B1[2][2];
    const char* cA = cur.A; const char* cB = cur.B;
    if constexpr (Sched::GATHER) { PG8_GOFF(cur, oA0, oA1); }
    if constexpr (SP2) {
        PG8_STAGE(PG8_SB(0, 0), cB, voffB); PG8_STAGE(PG8_SB(0, 1), cB + hstepB, voffB); PG8_STAGE(PG8_SA(0, 0), cA, oA0); PG8_STAGE(PG8_SA(0, 1), cA, oA1);
        if (wr == 1) PG8_BAR;
        PG8_WAIT_V(2); PG8_BAR;
        PG8_STAGE(PG8_SB(1, 0), cB + kstep, voffB); PG8_STAGE(PG8_SA(1, 0), cA + kstep, oA0); PG8_STAGE(PG8_SB(1, 1), cB + hstepB + kstep, voffB);
        PG8_WAIT_V(6); PG8_BAR;
    } else {
        PG8_STAGE(PG8_SB(0, 0), cB, voffB); PG8_STAGE(PG8_SA(0, 0), cA, oA0); PG8_STAGE(PG8_SB(0, 1), cB + hstepB, voffB); PG8_STAGE(PG8_SA(0, 1), cA, oA1);
        if (wr == 1) PG8_BAR;
        PG8_WAIT_V(4); PG8_BAR;
        PG8_STAGE(PG8_SB(1, 0), cB + kstep, voffB); PG8_STAGE(PG8_SA(1, 0), cA + kstep, oA0); PG8_STAGE(PG8_SB(1, 1), cB + hstepB + kstep, voffB);
        PG8_WAIT_V(6); PG8_BAR;
    }
    for (;;) {
        const bool has_next = S.next(ui + 1, nxt);
        const char* nA = has_next ? nxt.A : cA; const char* nB = has_next ? nxt.B : cB;
        if constexpr (Sched::GATHER) { if (has_next) { PG8_GOFF(nxt, nA0, nA1); } else {
#pragma unroll
            for (int i = 0; i < 2; ++i) { nA0[i] = oA0[i]; nA1[i] = oA1[i]; } } }
#pragma nounroll
        for (int t = 0; t < nt; t += 2) {
            const bool last = (t == nt - 2);
            const char* a1 = cA + (size_t)(t + 1) * kstep;
            const char* a2 = last ? nA : cA + (size_t)(t + 2) * kstep; const char* b2 = last ? nB : cB + (size_t)(t + 2) * kstep;
            const char* a3 = a2 + kstep; const char* b3 = b2 + kstep;
            unsigned q0[2], q1[2];
#pragma unroll
            for (int i = 0; i < 2; ++i) { q0[i] = (Sched::GATHER && last) ? nA0[i] : oA0[i]; q1[i] = (Sched::GATHER && last) ? nA1[i] : oA1[i]; }
            if constexpr (SP2) {
            if constexpr (Side::ON) {
            f32x4 sv;
            PG8_LDB(B0, 0, 0); PG8_LDB(B1, 0, 1); PG8_SCHED; PG8_LDA(At, 0, 0); PG8_STAGE(PG8_SA(1, 1), a1, oA1); side.template read<0>(tid, sv);
            PG8_WAIT_V(9); PG8_WAIT_L(0); PG8_BAR; PG8_MMA(0, 0, At, B0); side.template store<0>(tid, sv); PG8_MMA(0, 1, At, B1); PG8_BAR; PG8_SCHED;
            PG8_LDA(At, 0, 1); PG8_STAGE(PG8_SB(0, 0), b2, voffB); PG8_STAGE(PG8_SB(0, 1), b2 + hstepB, voffB); PG8_STAGE(PG8_SA(0, 0), a2, q0);
            PG8_WAIT_V(9); PG8_WAIT_L(0); PG8_BAR; PG8_MMA(1, 0, At, B0); side.template issue<0>(wid, lane); PG8_MMA(1, 1, At, B1); PG8_BAR; PG8_SCHED;
            PG8_LDB(B0, 1, 0); PG8_LDB(B1, 1, 1); PG8_SCHED; PG8_LDA(At, 1, 0); PG8_STAGE(PG8_SA(0, 1), a2, q1); side.template read<1>(tid, sv);
            PG8_WAIT_V(9); PG8_WAIT_L(0); PG8_BAR; PG8_MMA(0, 0, At, B0); side.template store<1>(tid, sv); PG8_MMA(0, 1, At, B1); PG8_BAR; PG8_SCHED;
            PG8_LDA(At, 1, 1); PG8_STAGE(PG8_SB(1, 0), b3, voffB); PG8_STAGE(PG8_SB(1, 1), b3 + hstepB, voffB); PG8_STAGE(PG8_SA(1, 0), a3, q0);
            PG8_WAIT_V(9); PG8_WAIT_L(0); PG8_BAR; PG8_MMA(1, 0, At, B0); side.template issue<1>(wid, lane); PG8_MMA(1, 1, At, B1); PG8_BAR; PG8_SCHED;
            } else {
            PG8_LDB(B0, 0, 0); PG8_LDB(B1, 0, 1); PG8_SCHED; PG8_LDA(At, 0, 0); PG8_STAGE(PG8_SA(1, 1), a1, oA1);
            PG8_WAIT_V(8); PG8_WAIT_L(0); PG8_BAR; PG8_MMA(0, 0, At, B0); PG8_MMA(0, 1, At, B1); PG8_BAR; PG8_SCHED;
            PG8_LDA(At, 0, 1); PG8_STAGE(PG8_SB(0, 0), b2, voffB); PG8_STAGE(PG8_SB(0, 1), b2 + hstepB, voffB); PG8_STAGE(PG8_SA(0, 0), a2, q0);
            PG8_WAIT_V(8); PG8_WAIT_L(0); PG8_BAR; PG8_MMA(1, 0, At, B0); PG8_MMA(1, 1, At, B1); PG8_BAR; PG8_SCHED;
            PG8_LDB(B0, 1, 0); PG8_LDB(B1, 1, 1); PG8_SCHED; PG8_LDA(At, 1, 0); PG8_STAGE(PG8_SA(0, 1), a2, q1);
            PG8_WAIT_V(8); PG8_WAIT_L(0); PG8_BAR; PG8_MMA(0, 0, At, B0); PG8_MMA(0, 1, At, B1); PG8_BAR; PG8_SCHED;
            PG8_LDA(At, 1, 1); PG8_STAGE(PG8_SB(1, 0), b3, voffB); PG8_STAGE(PG8_SB(1, 1), b3 + hstepB, voffB); PG8_STAGE(PG8_SA(1, 0), a3, q0);
            PG8_WAIT_V(8); PG8_WAIT_L(0); PG8_BAR; PG8_MMA(1, 0, At, B0); PG8_MMA(1, 1, At, B1); PG8_BAR; PG8_SCHED;
            }
            } else {
            PG8_LDB(B0, 0, 0); PG8_SCHED; PG8_LDA(At, 0, 0); PG8_STAGE(PG8_SA(1, 1), a1, oA1);
            PG8_WAIT_L(8); PG8_BAR; PG8_WAIT_L(0); PG8_MMA(0, 0, At, B0); PG8_BAR; PG8_SCHED;
            PG8_LDB(B1, 0, 1); PG8_STAGE(PG8_SB(0, 0), b2, voffB);
            PG8_BAR; PG8_WAIT_L(0); PG8_MMA(0, 1, At, B1); PG8_BAR;
            PG8_LDA(At, 0, 1); PG8_STAGE(PG8_SA(0, 0), a2, q0);
            PG8_BAR; PG8_WAIT_L(0); PG8_MMA(1, 0, At, B0); PG8_BAR; PG8_SCHED;
            PG8_STAGE(PG8_SB(0, 1), b2 + hstepB, voffB);
            PG8_WAIT_V(6); PG8_BAR; PG8_MMA(1, 1, At, B1); PG8_BAR;
            PG8_LDB(B0, 1, 0); PG8_SCHED; PG8_LDA(At, 1, 0); PG8_STAGE(PG8_SA(0, 1), a2, q1);
            PG8_WAIT_L(8); PG8_BAR; PG8_WAIT_L(0); PG8_MMA(0, 0, At, B0); PG8_BAR; PG8_SCHED;
            PG8_LDB(B1, 1, 1); PG8_STAGE(PG8_SB(1, 0), b3, voffB);
            PG8_BAR; PG8_WAIT_L(0); PG8_MMA(0, 1, At, B1); PG8_BAR;
            PG8_LDA(At, 1, 1); PG8_STAGE(PG8_SA(1, 0), a3, q0);
            PG8_BAR; PG8_WAIT_L(0); PG8_MMA(1, 0, At, B0); PG8_BAR; PG8_SCHED;
            PG8_STAGE(PG8_SB(1, 1), b3 + hstepB, voffB);
            PG8_WAIT_V(6); PG8_BAR; PG8_MMA(1, 1, At, B1); PG8_BAR;
            }
        }
        if constexpr (ALIGN_EPI) { if (wr == 0) PG8_BAR; }
#ifndef PROBE_EPI2
#define PROBE_EPI2 0
#endif
        E(acc, cur, wr, wc, fr, fq);
        if (((PROBE_EPI2 >> Epi::EID) & 1) && Epi::IDEMPOTENT) { asm volatile("" ::: "memory"); E(acc, cur, wr, wc, fr, fq); }
        if (!has_next) break;
        if (!Epi::keep_acc(cur)) {
#pragma unroll
        for (int a = 0; a < 2; ++a)
#pragma unroll
            for (int b = 0; b < 2; ++b)
#pragma unroll
                for (int m = 0; m < 4; ++m)
#pragma unroll
                    for (int n = 0; n < 2; ++n) acc[a][b][m][n] = (f32x4){0.f, 0.f, 0.f, 0.f};
        }
        cur = nxt; cA = nA; cB = nB; ++ui;
        if constexpr (Sched::GATHER) {
#pragma unroll
            for (int i = 0; i < 2; ++i) { oA0[i] = nA0[i]; oA1[i] = nA1[i]; } }
        if constexpr (ALIGN_EPI) { if (wr == 1) PG8_BAR; }
    }
    PG8_WAIT_V(0);
    if constexpr (!ALIGN_EPI) { if (wr == 0) PG8_BAR; }
    PG8_BAR;
    if constexpr (Side::ON) { f32x4 s0, s1; side.template read<0>(tid, s0); side.template read<1>(tid, s1); PG8_WAIT_L(0); side.template store<0>(tid, s0); side.template store<1>(tid, s1); PG8_WAIT_V(0); PG8_BAR; }
#undef PG8_SA
#undef PG8_SB
#undef PG8_STAGE
#undef PG8_LDA
#undef PG8_LDB
#undef PG8_MMA
#undef PG8_WAIT_V
#undef PG8_WAIT_L
#undef PG8_BAR
#undef PG8_SCHED
#undef PG8_GOFF
}
}
#ifndef YB_FP8
#define YB_FP8 1
#endif
namespace pg8 {
#ifndef NT_STORES
#define NT_STORES 0
#endif
#if NT_STORES == 1
#define ST16(p, v) __builtin_nontemporal_store((v), (p))
#elif NT_STORES == 2
DI void st16_sc1(u32x4* p, const u32x4& v) { asm volatile("global_store_dwordx4 %0, %1, off sc1\n\ts_nop 1" :: "v"(p), "v"(v) : "memory"); }
#define ST16(p, v) st16_sc1((p), (v))
#else
#define ST16(p, v) (*(p) = (v))
#endif
typedef f32x4 Acc[2][2][4][2];
DI u32x4 pack8(const f32x4& v0, const f32x4& v1) { u32x4 w; w.x = pk2(v0[0], v0[1]); w.y = pk2(v0[2], v0[3]); w.z = pk2(v1[0], v1[1]); w.w = pk2(v1[2], v1[3]); return w; }
DI void unpack8(const u32x4& w, f32x4& v0, f32x4& v1) { v0 = (f32x4){bflo(w.x), bfhi(w.x), bflo(w.y), bfhi(w.y)}; v1 = (f32x4){bflo(w.z), bfhi(w.z), bflo(w.w), bfhi(w.w)}; }

DI unsigned pack_u8x4(const f32x4& g, float lo) { unsigned w = 0;
    w = __builtin_amdgcn_cvt_pk_u8_f32(fmaxf(__builtin_floorf(255.f * g[0] + 0.5f), lo), 0, w); w = __builtin_amdgcn_cvt_pk_u8_f32(fmaxf(__builtin_floorf(255.f * g[1] + 0.5f), lo), 1, w);
    w = __builtin_amdgcn_cvt_pk_u8_f32(fmaxf(__builtin_floorf(255.f * g[2] + 0.5f), lo), 2, w); w = __builtin_amdgcn_cvt_pk_u8_f32(fmaxf(__builtin_floorf(255.f * g[3] + 0.5f), lo), 3, w); return w; }
DI f32x4 unpack_u8x4(unsigned w) { return (f32x4){(float)(w & 0xffu), (float)((w >> 8) & 0xffu), (float)((w >> 16) & 0xffu), (float)(w >> 24)}; }
struct EpiZ {
    static DI bool keep_acc(const Unit&) { return false; }
    static constexpr bool PERM = true, IDEMPOTENT = true; static constexpr int EID = 0;
    bf16_t *ZP, *ZS; unsigned char *GP, *GS;
    DI void operator()(Acc& acc, const Unit& u, int wr, int wc, int fr, int fq) const {
        const int pn = u.pn; const int row0 = u.pm * BM + wr * 64 + fr;
        if (pn < 8) {
            bf16_t* base = pn < 4 ? ZP : ZS; const int col0 = (pn & 3) * 256 + wc * 32 + 8 * fq;
#pragma unroll
            for (int ai = 0; ai < 2; ++ai)
#pragma unroll
                for (int m = 0; m < 4; ++m) { bf16_t* rowp = base + (size_t)(row0 + ai * HALF + m * 16) * PW + col0;
#pragma unroll
                    for (int bj = 0; bj < 2; ++bj) ST16((u32x4*)(rowp + bj * HALF), pack8(acc[ai][bj][m][0], acc[ai][bj][m][1])); }
        } else {
            unsigned char* base = pn < 16 ? GP : GS; const float lo = pn < 16 ? 0.f : 1.f; const int col0 = (pn & 7) * 256 + wc * 32 + 8 * fq;
#pragma unroll
            for (int ai = 0; ai < 2; ++ai)
#pragma unroll
                for (int m = 0; m < 4; ++m) { unsigned char* rowp = base + (size_t)(row0 + ai * HALF + m * 16) * DM + col0;
#pragma unroll
                    for (int bj = 0; bj < 2; ++bj) { f32x4 v0 = acc[ai][bj][m][0], v1 = acc[ai][bj][m][1];
#pragma unroll
                        for (int j = 0; j < 4; ++j) { v0[j] = fsigm(v0[j]); v1[j] = fsigm(v1[j]); }
                        *(u32x2*)(rowp + bj * HALF) = (u32x2){pack_u8x4(v0, lo), pack_u8x4(v1, lo)}; } }
        }
    }
};
struct EpiPool {
    static DI bool keep_acc(const Unit&) { return false; }
    static constexpr bool PERM = true, IDEMPOTENT = true; static constexpr int EID = 1;
    bf16_t* PP; const float* scale;
    DI void operator()(Acc& acc, const Unit& u, int wr, int wc, int fr, int fq) const {
        const int row0 = u.pm * BM + wr * 64 + fr, col0 = u.pn * 256 + wc * 32 + 8 * fq;
        f32x4 sc[2][2];
#pragma unroll
        for (int bj = 0; bj < 2; ++bj) { sc[bj][0] = *(const f32x4*)(scale + col0 + bj * HALF); sc[bj][1] = *(const f32x4*)(scale + col0 + bj * HALF + 4); }
#pragma unroll
        for (int ai = 0; ai < 2; ++ai)
#pragma unroll
            for (int m = 0; m < 4; ++m) { bf16_t* rowp = PP + (size_t)(row0 + ai * HALF + m * 16) * PW + col0;
#pragma unroll
                for (int bj = 0; bj < 2; ++bj) *(u32x4*)(rowp + bj * HALF) = pack8(acc[ai][bj][m][0] * sc[bj][0], acc[ai][bj][m][1] * sc[bj][1]); }
    }
};
struct EpiGlu {
    static DI bool keep_acc(const Unit&) { return false; }
    static constexpr bool PERM = true, IDEMPOTENT = true; static constexpr int EID = 2;
    const bf16_t* S0; bf16_t* SS; const float* bias;
    DI void operator()(Acc& acc, const Unit& u, int wr, int wc, int fr, int fq) const {
        const int row0 = u.pm * BM + wr * 64 + fr, col0 = u.pn * 256 + wc * 32 + 8 * fq;
        f32x4 bv[2][2];
#pragma unroll
        for (int bj = 0; bj < 2; ++bj) { bv[bj][0] = *(const f32x4*)(bias + col0 + bj * HALF); bv[bj][1] = *(const f32x4*)(bias + col0 + bj * HALF + 4); }
#pragma unroll
        for (int ai = 0; ai < 2; ++ai) {
            u32x4 sw[4][2];
#pragma unroll
            for (int m = 0; m < 4; ++m)
#pragma unroll
                for (int bj = 0; bj < 2; ++bj) sw[m][bj] = *(const u32x4*)(S0 + (size_t)(row0 + ai * HALF + m * 16) * SW + col0 + bj * HALF);
#pragma unroll
            for (int m = 0; m < 4; ++m) { const size_t off = (size_t)(row0 + ai * HALF + m * 16) * SW + col0;
#pragma unroll
                for (int bj = 0; bj < 2; ++bj) { f32x4 s0, s1; unpack8(sw[m][bj], s0, s1);
                    f32x4 t0 = acc[ai][bj][m][0] + bv[bj][0], t1 = acc[ai][bj][m][1] + bv[bj][1];
#pragma unroll
                    for (int j = 0; j < 4; ++j) { t0[j] = s0[j] * fsigm(t0[j]); t1[j] = s1[j] * fsigm(t1[j]); }
                    *(u32x4*)(SS + off + bj * HALF) = pack8(t0, t1); } }
            asm volatile("" ::: "memory");
        }
    }
};
template <bool ADD> struct EpiGate {
    static DI bool keep_acc(const Unit&) { return false; }
    static constexpr bool PERM = true, IDEMPOTENT = !ADD; static constexpr int EID = 3;
    const bf16_t* G; bf16_t* MP;
    DI void operator()(Acc& acc, const Unit& u, int wr, int wc, int fr, int fq) const {
        const int row0 = u.pm * BM + wr * 64 + fr, col0 = u.pn * 256 + wc * 32 + 8 * fq;
#pragma unroll
        for (int ai = 0; ai < 2; ++ai)
#pragma unroll
            for (int m = 0; m < 4; ++m) { const size_t off = (size_t)(row0 + ai * HALF + m * 16) * DM + col0;
#pragma unroll
                for (int bj = 0; bj < 2; ++bj) { const u32x4 gw = *(const u32x4*)(G + off + bj * HALF); f32x4 g0, g1; unpack8(gw, g0, g1);
                    f32x4 t0 = acc[ai][bj][m][0] * g0, t1 = acc[ai][bj][m][1] * g1;
                    if (ADD) { const u32x4 pw = *(const u32x4*)(MP + off + bj * HALF); f32x4 p0, p1; unpack8(pw, p0, p1); t0 += p0; t1 += p1; }
                    *(u32x4*)(MP + off + bj * HALF) = pack8(t0, t1); } }
    }
};
struct EpiMerge {
    static DI bool keep_acc(const Unit& u) { return u.e == 0; }
    static constexpr bool PERM = true, IDEMPOTENT = false; static constexpr int EID = 8;
    const unsigned char* GP; const unsigned char* GS; bf16_t* MP;
    DI void operator()(Acc& acc, const Unit& u, int wr, int wc, int fr, int fq) const {
        const int row0 = u.pm * BM + wr * 64 + fr, col0 = u.pn * 256 + wc * 32 + 8 * fq;
        if (u.e == 0) {
#pragma unroll
            for (int ai = 0; ai < 2; ++ai) {
                u32x2 sw[4][2], pw[4][2];
#pragma unroll
                for (int m = 0; m < 4; ++m)
#pragma unroll
                    for (int bj = 0; bj < 2; ++bj) { const size_t off = (size_t)(row0 + ai * HALF + m * 16) * DM + col0 + bj * HALF; sw[m][bj] = *(const u32x2*)(GS + off); pw[m][bj] = *(const u32x2*)(GP + off); }
#pragma unroll
                for (int m = 0; m < 4; ++m)
#pragma unroll
                    for (int bj = 0; bj < 2; ++bj) { const f32x4 s0 = unpack_u8x4(sw[m][bj].x), s1 = unpack_u8x4(sw[m][bj].y), p0 = unpack_u8x4(pw[m][bj].x), p1 = unpack_u8x4(pw[m][bj].y);
#pragma unroll
                        for (int j = 0; j < 4; ++j) { acc[ai][bj][m][0][j] *= p0[j] * __builtin_amdgcn_rcpf(s0[j]); acc[ai][bj][m][1][j] *= p1[j] * __builtin_amdgcn_rcpf(s1[j]); } }
            }
        } else {
            constexpr float I255 = 1.f / 255.f;
#pragma unroll
            for (int ai = 0; ai < 2; ++ai) {
                u32x2 sw[4][2];
#pragma unroll
                for (int m = 0; m < 4; ++m)
#pragma unroll
                    for (int bj = 0; bj < 2; ++bj) sw[m][bj] = *(const u32x2*)(GS + (size_t)(row0 + ai * HALF + m * 16) * DM + col0 + bj * HALF);
#pragma unroll
                for (int m = 0; m < 4; ++m)
#pragma unroll
                    for (int bj = 0; bj < 2; ++bj) { const f32x4 s0 = unpack_u8x4(sw[m][bj].x) * I255, s1 = unpack_u8x4(sw[m][bj].y) * I255;
                        *(u32x4*)(MP + (size_t)(row0 + ai * HALF + m * 16) * DM + col0 + bj * HALF) = pack8(acc[ai][bj][m][0] * s0, acc[ai][bj][m][1] * s1); }
                asm volatile("" ::: "memory");
            }
        }
    }
};
struct MergeOrder : GridOrder {
    static constexpr bool GATHER = false;
    const char *A0, *B0, *A1, *B1; size_t tstepA, tstepB;
    DI bool next(int i, Unit& u) const { int pm, pn; if (!tile(i >> 1, pm, pn)) return false; const int h = i & 1; u.pm = pm; u.pn = pn; u.e = h; u.cnt = 256; u.list = nullptr;
        u.A = (h ? A1 : A0) + (size_t)pm * tstepA; u.B = (h ? B1 : B0) + (size_t)pn * tstepB; return true; }
};
struct EpiDelta {
    static DI bool keep_acc(const Unit&) { return false; }
    static constexpr bool PERM = true, IDEMPOTENT = true; static constexpr int EID = 4;
    bf16_t* DL;
    DI void operator()(Acc& acc, const Unit& u, int wr, int wc, int fr, int fq) const {
        const int row0 = u.pm * BM + wr * 64 + fr, col0 = u.pn * 256 + wc * 32 + 8 * fq;
#pragma unroll
        for (int ai = 0; ai < 2; ++ai)
#pragma unroll
            for (int m = 0; m < 4; ++m) { bf16_t* rowp = DL + (size_t)(row0 + ai * HALF + m * 16) * DM + col0;
#pragma unroll
                for (int bj = 0; bj < 2; ++bj) ST16((u32x4*)(rowp + bj * HALF), pack8(acc[ai][bj][m][0], acc[ai][bj][m][1])); }
    }
};
struct EpiResid {
    static DI bool keep_acc(const Unit&) { return false; }
    static constexpr bool PERM = false, IDEMPOTENT = true; static constexpr int EID = 5;
    const float* X; float* H1;
    DI void operator()(Acc& acc, const Unit& u, int wr, int wc, int fr, int fq) const {
        const int row0 = u.pm * BM + wr * 64 + fr, col0 = u.pn * 256 + wc * 32 + 4 * fq;
#pragma unroll
        for (int ai = 0; ai < 2; ++ai)
#pragma unroll
            for (int m = 0; m < 4; ++m) { const size_t off = (size_t)(row0 + ai * HALF + m * 16) * DM + col0;
#pragma unroll
                for (int bj = 0; bj < 2; ++bj)
#pragma unroll
                    for (int n = 0; n < 2; ++n) { const f32x4 xv = *(const f32x4*)(X + off + bj * HALF + n * 16); *(f32x4*)(H1 + off + bj * HALF + n * 16) = xv + acc[ai][bj][m][n]; }
                asm volatile("" ::: "memory"); }
    }
};
struct EpiMoeUp {
    static DI bool keep_acc(const Unit&) { return false; }
    static constexpr bool PERM = true, IDEMPOTENT = true; static constexpr int EID = 6;
    bf16_t* HH;
    DI void operator()(Acc& acc, const Unit& u, int wr, int wc, int fr, int fq) const {
        const int col0 = u.pn * 128 + wc * 32 + 8 * fq;
        float rsv[2][4];
#pragma unroll
        for (int ai = 0; ai < 2; ++ai)
#pragma unroll
            for (int m = 0; m < 4; ++m) rsv[ai][m] = __uint_as_float(u.list[ai * HALF + wr * 64 + m * 16 + fr].w);
#pragma unroll
        for (int ai = 0; ai < 2; ++ai)
#pragma unroll
            for (int m = 0; m < 4; ++m) { const int r = ai * HALF + wr * 64 + m * 16 + fr; const float rs = rsv[ai][m];
                f32x4 g0 = acc[ai][0][m][0] * rs, g1 = acc[ai][0][m][1] * rs, u0 = acc[ai][1][m][0] * rs, u1 = acc[ai][1][m][1] * rs;
#pragma unroll
                for (int j = 0; j < 4; ++j) { g0[j] = g0[j] * fsigm(g0[j]) * u0[j]; g1[j] = g1[j] * fsigm(g1[j]) * u1[j]; }
                *(u32x4*)(HH + (size_t)(u.pm + r) * FF + col0) = pack8(g0, g1); }
    }
};
struct EpiMoeDown {
    static DI bool keep_acc(const Unit&) { return false; }
    static constexpr bool PERM = true, IDEMPOTENT = true; static constexpr int EID = 7;
    bf16_t* YB;
    DI void operator()(Acc& acc, const Unit& u, int wr, int wc, int fr, int fq) const {
        const int col0 = u.pn * 256 + wc * 32 + 8 * fq;
        unsigned dstv[2][4]; float wv[2][4];
#pragma unroll
        for (int ai = 0; ai < 2; ++ai)
#pragma unroll
            for (int m = 0; m < 4; ++m) { const uint4* le = u.list + (ai * HALF + wr * 64 + m * 16 + fr); dstv[ai][m] = le->y; wv[ai][m] = __uint_as_float(le->z); }
#pragma unroll
        for (int ai = 0; ai < 2; ++ai)
#pragma unroll
            for (int m = 0; m < 4; ++m) { const int r = ai * HALF + wr * 64 + m * 16 + fr;
#if YB_FP8
                if (r < u.cnt) { const float w = wv[ai][m] * 16.f; unsigned char* rowp = (unsigned char*)YB + (size_t)dstv[ai][m] * DM + col0;
#pragma unroll
                    for (int bj = 0; bj < 2; ++bj) { f32x4 a0 = acc[ai][bj][m][0] * w, a1 = acc[ai][bj][m][1] * w; int lo = 0, hi = 0;
#pragma unroll
                        for (int j = 0; j < 4; ++j) { a0[j] = __builtin_amdgcn_fmed3f(a0[j], -416.f, 416.f); a1[j] = __builtin_amdgcn_fmed3f(a1[j], -416.f, 416.f); }
                        lo = __builtin_amdgcn_cvt_pk_fp8_f32(a0[0], a0[1], lo, false); lo = __builtin_amdgcn_cvt_pk_fp8_f32(a0[2], a0[3], lo, true);
                        hi = __builtin_amdgcn_cvt_pk_fp8_f32(a1[0], a1[1], hi, false); hi = __builtin_amdgcn_cvt_pk_fp8_f32(a1[2], a1[3], hi, true);
                        *(u32x2*)(rowp + bj * HALF) = (u32x2){(unsigned)lo, (unsigned)hi}; } } }
#else
                if (r < u.cnt) { const float w = wv[ai][m]; bf16_t* rowp = YB + (size_t)dstv[ai][m] * DM + col0;
#pragma unroll
                    for (int bj = 0; bj < 2; ++bj) ST16((u32x4*)(rowp + bj * HALF), pack8(acc[ai][bj][m][0] * w, acc[ai][bj][m][1] * w)); } }
#endif
    }
};

struct MoeOrder {
    static constexpr bool GATHER_UP = true;
    const volatile LAS int* tab; int ntn, G, vcu; const uint4* list; const char* Abase; const char* Bbase; size_t bstep_e, bstep_n, astep_row; bool up;
    DI bool decode(int i, Unit& u) const {
        const int U = i * G + vcu; const int lane = threadIdx.x & 63;
        const int total = tab[64];
        if (U >= total) return false;
        const int ce = tab[lane + 1];
        const unsigned long long m = __ballot(ce > U);
        const int e = __builtin_amdgcn_readfirstlane((int)__builtin_ctzll(m));
        const int loc = U - tab[e]; const int mb = loc / ntn, nb = loc % ntn;
        const int cnt = tab[160 + e] - mb * 256;
        u.e = e; u.cnt = cnt < 256 ? cnt : 256; u.pn = nb; u.pm = tab[80 + e] + mb * 256; u.list = list + (size_t)e * LISTCAP + mb * 256;
        u.B = Bbase + (size_t)e * bstep_e + (size_t)nb * bstep_n;
        u.A = up ? Abase : Abase + (size_t)u.pm * astep_row;
        return true;
    }
};
struct MoeUpOrder : MoeOrder { static constexpr bool GATHER = true; DI bool next(int i, Unit& u) const { return decode(i, u); } };
struct MoeDownOrder : MoeOrder { static constexpr bool GATHER = false; DI bool next(int i, Unit& u) const { return decode(i, u); } };
struct PoolOrder : GridOrder {
    static constexpr bool GATHER = false;
    const char* DD; const char* PWT;
    DI bool next(int i, Unit& u) const { int pm, pn; if (!tile(i, pm, pn)) return false; u.pm = pm; u.pn = pn; u.e = 0; u.cnt = 256; u.list = nullptr;
        u.A = DD + ((size_t)pm * 256 * PW + (size_t)pn * 256) * 2; u.B = PWT + (size_t)pn * 65536 * 2; return true; }
};
}
constexpr int NWAVES = 8;
constexpr int RING_BYTES = 131072, XB_OFF = RING_BYTES, MISC_OFF = RING_BYTES + 16384, TAB_OFF = MISC_OFF + 256;
constexpr int LDS_BYTES = RING_BYTES + 2048 + 16384;
#ifndef SIDE_P1
#define SIDE_P1 0
#endif
#ifndef SIDE_P56
#define SIDE_P56 0
#endif
using pg8::SIDE_ITEMS;
constexpr int SIDE_N1 = SIDE_P1 ? 192 * 256 : 0, SIDE_N5 = SIDE_P56 ? 32 * 256 : 0, SIDE_N6 = SIDE_P56 ? 64 * 256 : 0;
#ifndef SIDE_PROBE
#define SIDE_PROBE 0
#endif
#ifndef CONV_PAIRS
#define CONV_PAIRS 49152
#endif
#ifndef NCONV
#define NCONV 64
#endif
#ifndef CV_QFRAC
#define CV_QFRAC 25
#endif
#define CV_GRAB 16
#define CV_STATIC (((2 * CONV_PAIRS) * (100 - CV_QFRAC) / 100) / 512 * 512)
#ifndef TAIL_IN_P8
#define TAIL_IN_P8 0
#endif
constexpr int SIDE_TOTAL = NCONV ? (TAIL_IN_P8 ? SIDE_ITEMS : 2 * CONV_PAIRS) : (SIDE_PROBE ? 0 : SIDE_N1 + 2 * SIDE_N5 + SIDE_N6);
static_assert(!TAIL_IN_P8 || 2 * CONV_PAIRS >= 2 * 64 * 32 * 16, "gate/up weights must be complete before P8");
struct Args { const float* in[28]; float* out; unsigned char* ws; int ph_lo, ph_hi, use_cg, pad; };

struct Ctx {
    LAS unsigned char* lds; unsigned char* ws; int tid, lane, wave, vcu, G, gw, NGW;
};

#define MFMA16(a, b, c) __builtin_amdgcn_mfma_f32_16x16x32_bf16((a), (b), (c), 0, 0, 0)
#define MFMA32(a, b, c) __builtin_amdgcn_mfma_f32_32x32x16_bf16((a), (b), (c), 0, 0, 0)

struct TrItem { const float* W; bf16_t* WT; const float* rs; int ldw, ldt; };
#ifndef RT_AUX
#define RT_AUX 0
#endif
#ifndef FIN_ST_NT
#define FIN_ST_NT 0
#endif
#ifndef FIN_NT
#define FIN_NT 0
#endif
#ifndef P0_NT
#define P0_NT 1
#endif
#ifndef CV_NT
#define CV_NT 1
#endif
template <bool NT = false> DI void tr_load(const TrItem& t, f32x4 (&v)[8], int lane) {
#pragma unroll
    for (int i = 0; i < 8; ++i) { const f32x4* p = (const f32x4*)(t.W + (size_t)(8 * i + (lane >> 3)) * t.ldw + 4 * (lane & 7)); v[i] = NT ? __builtin_nontemporal_load(p) : *p; }
}
template <bool NT = false> DI void tr_finish(const TrItem& t, const f32x4 (&v)[8], LAS float* scr, int lane) {
#pragma unroll
    for (int i = 0; i < 8; ++i) { LAS float* s = scr + (8 * i + (lane >> 3)) * 33 + 4 * (lane & 7); s[0] = v[i].x; s[1] = v[i].y; s[2] = v[i].z; s[3] = v[i].w; }
    LDS_WAIT(); asm volatile("" ::: "memory");
    const int c = lane & 7;
    f32x4 g0 = {1.f, 1.f, 1.f, 1.f}, g1 = g0; if (t.rs) { g0 = *(const f32x4*)(t.rs + 8 * c); g1 = *(const f32x4*)(t.rs + 8 * c + 4); }
#pragma unroll
    for (int j = 0; j < 4; ++j) { const int n = (lane >> 3) + 8 * j; const LAS float* s = scr + (8 * c) * 33 + n;
        u32x4 o; o.x = pk2(s[0 * 33] * g0.x, s[1 * 33] * g0.y); o.y = pk2(s[2 * 33] * g0.z, s[3 * 33] * g0.w); o.z = pk2(s[4 * 33] * g1.x, s[5 * 33] * g1.y); o.w = pk2(s[6 * 33] * g1.z, s[7 * 33] * g1.w);
        if (NT) __builtin_nontemporal_store(o, (u32x4*)(t.WT + (size_t)n * t.ldt + 8 * c)); else *(u32x4*)(t.WT + (size_t)n * t.ldt + 8 * c) = o; }
    LDS_WAIT(); asm volatile("" ::: "memory");
}
DI void norm_regs_bf16(const f32x4 (&v)[8], const float* g, bf16_t* orow, int lane, float* rstd_out) {
    const f32x4* gr = (const f32x4*)g + lane; float s = 0.f;
#pragma unroll
    for (int j = 0; j < 8; ++j) s += (v[j].x * v[j].x + v[j].y * v[j].y) + (v[j].z * v[j].z + v[j].w * v[j].w);
    const float rstd = rsqrtf(wave_sum(s) * (1.f / DM) + RMS_EPS);
    if (rstd_out && lane == 0) *rstd_out = rstd;
    u32x2* o8 = (u32x2*)orow + lane;
#pragma unroll
    for (int j = 0; j < 8; ++j) { const f32x4 gg = gr[64 * j]; u32x2 w; w.x = pk2(v[j].x * rstd * gg.x, v[j].y * rstd * gg.y); w.y = pk2(v[j].z * rstd * gg.z, v[j].w * rstd * gg.w); o8[64 * j] = w; }
}
DI void norm_row_bf16(const float* xrow, const float* g, bf16_t* orow, int lane, float* rstd_out = nullptr) {
    const f32x4* xr = (const f32x4*)xrow + lane; const f32x4* gr = (const f32x4*)g + lane;
    f32x4 v[8]; float s = 0.f;
#pragma unroll
    for (int j = 0; j < 8; ++j) { v[j] = xr[64 * j]; s += (v[j].x * v[j].x + v[j].y * v[j].y) + (v[j].z * v[j].z + v[j].w * v[j].w); }
    const float rstd = rsqrtf(wave_sum(s) * (1.f / DM) + RMS_EPS);
    if (rstd_out && lane == 0) *rstd_out = rstd;
    u32x2* o8 = (u32x2*)orow + lane;
#pragma unroll
    for (int j = 0; j < 8; ++j) { const f32x4 gg = gr[64 * j]; u32x2 w; w.x = pk2(v[j].x * rstd * gg.x, v[j].y * rstd * gg.y); w.y = pk2(v[j].z * rstd * gg.z, v[j].w * rstd * gg.w); o8[64 * j] = w; }
}
DI void p0_prologue(const Ctx& C, const Args& a, int part = 3) {
    unsigned char* ws = C.ws;
    LAS float* scr = (LAS float*)(C.lds + C.wave * 8448);
    LAS float* scrB = (LAS float*)(C.lds + (C.wave < 7 ? 67584 + C.wave * 8448 : XB_OFF));
    constexpr int I_IN = 32 * 192, I_PW = 4 * 32, I_GLU = 16 * 32, I_BR = 16 * 64, I_OUT = 32 * 64, I_GU = 64 * 32 * 16, I_DN = 64 * 8 * 64;
    constexpr int NSMALL = I_IN + I_PW + I_GLU + 2 * I_BR + I_OUT;
    constexpr int NITEMS = NSMALL + (2 * I_GU + I_DN - SIDE_TOTAL);
    auto decode = [&](int it, TrItem& t) {
        int r = it < NSMALL ? it : it + SIDE_TOTAL;
        const float* W; bf16_t* WT; int ldw, ldt, k0, n0, drow0; bool gu = false;
        if (r < I_IN) { const int kb = r / 192, nb = r % 192; W = a.in[3]; ldw = INW; WT = (bf16_t*)(ws + WS_WIN); ldt = DM; k0 = 64 * kb; n0 = 32 * nb; drow0 = n0; }
        else if ((r -= I_IN) < I_PW) { const int g = r / 32, q = r % 32, kb = q / 8, nb = q % 8; W = a.in[4] + (size_t)g * 65536; ldw = 256; WT = (bf16_t*)(ws + WS_POOLW) + (size_t)g * 65536; ldt = 256; k0 = 64 * kb; n0 = 32 * nb; drow0 = n0; }
        else if ((r -= I_PW) < I_GLU) { const int kb = r / 32, nb = r % 32; W = a.in[14]; ldw = SW; WT = (bf16_t*)(ws + WS_WGLU); ldt = SW; k0 = 64 * kb; n0 = 32 * nb; drow0 = n0; }
        else if ((r -= I_GLU) < I_BR) { const int kb = r / 64, nb = r % 64; W = a.in[16]; ldw = DM; WT = (bf16_t*)(ws + WS_WBP); ldt = PW; k0 = 64 * kb; n0 = 32 * nb; drow0 = n0; }
        else if ((r -= I_BR) < I_BR) { const int kb = r / 64, nb = r % 64; W = a.in[17]; ldw = DM; WT = (bf16_t*)(ws + WS_WBS); ldt = SW; k0 = 64 * kb; n0 = 32 * nb; drow0 = n0; }
        else if ((r -= I_BR) < I_OUT) { const int kb = r / 64, nb = r % 64; W = a.in[18]; ldw = DM; WT = (bf16_t*)(ws + WS_WOUT); ldt = DM; k0 = 64 * kb; n0 = 32 * nb; drow0 = n0; }
        else if ((r -= I_OUT) < 2 * I_GU) { const int up = r / I_GU, q = r % I_GU, e = q / 512, q2 = q % 512, kb = q2 / 16, nb = q2 % 16; n0 = 32 * nb; k0 = 64 * kb;
            W = a.in[24 + up] + (size_t)e * DM * FF; ldw = FF; WT = (bf16_t*)(ws + WS_WGU) + (size_t)e * 1024 * DM; ldt = DM; drow0 = (n0 >> 7) * 256 + (n0 & 127) + up * 128; gu = true; }
        else { r -= 2 * I_GU; const int e = r / 512, q2 = r % 512, kb = q2 / 64, nb = q2 % 64; W = a.in[26] + (size_t)e * FF * DM; ldw = DM; WT = (bf16_t*)(ws + WS_WD) + (size_t)e * DM * FF; ldt = FF; k0 = 64 * kb; n0 = 32 * nb; drow0 = n0; }
        t.W = W + (size_t)k0 * ldw + n0; t.WT = WT + (size_t)drow0 * ldt + k0; t.ldw = ldw; t.ldt = ldt; t.rs = gu ? a.in[19] + k0 : nullptr;
    };
    const int it_lo = (part & 1) ? 0 : I_IN, it_hi = (part & 2) ? NITEMS : I_IN;
    for (int it = it_lo + C.gw; it < it_hi; it += 2 * C.NGW) {
        TrItem t0, t1; f32x4 v0[8], v1[8];
        const bool two = it + C.NGW < it_hi;
        decode(it, t0); tr_load<(P0_NT != 0)>(t0, v0, C.lane);
        decode(two ? it + C.NGW : it, t1); if (!two) { t1.WT = (bf16_t*)(ws + WS_SCR); t1.ldt = 64; } tr_load<(P0_NT != 0)>(t1, v1, C.lane);
        tr_finish(t0, v0, scr, C.lane);
        tr_finish(t1, v1, scrB, C.lane);
    }
    if (part & 1) {
        for (int m = 2 * C.gw; m < NTOK; m += 2 * C.NGW) {
            const f32x4* x0 = (const f32x4*)(a.in[0] + (size_t)m * DM) + C.lane; const f32x4* x1 = x0 + DM / 4;
            f32x4 v0[8], v1[8];
#pragma unroll
            for (int j = 0; j < 8; ++j) { v0[j] = P0_NT ? __builtin_nontemporal_load(x0 + 64 * j) : x0[64 * j]; v1[j] = P0_NT ? __builtin_nontemporal_load(x1 + 64 * j) : x1[64 * j]; }
            norm_regs_bf16(v0, a.in[2], (bf16_t*)(ws + WS_A1) + (size_t)m * DM, C.lane, (float*)(ws + WS_RSTD1) + m);
            norm_regs_bf16(v1, a.in[2], (bf16_t*)(ws + WS_A1) + (size_t)(m + 1) * DM, C.lane, (float*)(ws + WS_RSTD1) + m + 1);
        }
        for (int m = C.gw; m < NMETA; m += C.NGW) norm_row_bf16(a.in[1] + (size_t)m * DM, a.in[2], (bf16_t*)(ws + WS_A1M) + (size_t)m * DM, C.lane);
    }
    if (!(part & 2)) return;
    for (int it = C.gw; it < 80 * DM / 64; it += C.NGW) { const int idx = it * 64 + C.lane, j = idx / DM, k = idx % DM;
        float w = 0.f; if (j < 8) w = a.in[20][k * 8 + j]; else if (j < 72) w = a.in[22][k * 64 + (j - 8)];
        w *= a.in[19][k];
        const unsigned hi = pk2(w, 0.f) & 0xffffu; const float lo = w - __uint_as_float(hi << 16);
        ((bf16_t*)(ws + WS_WRH))[idx] = (bf16_t)hi; ((bf16_t*)(ws + WS_WRL))[idx] = (bf16_t)(pk2(lo, 0.f) & 0xffffu); }
    for (int g = C.gw; g < 64; g += C.NGW) { const int n = C.lane;
        const float ar = a.in[6][g * 64 + n], ai = a.in[7][g * 64 + n], dt = expf(a.in[8][g]);
        const float mag = expf(ar * dt); float sn, cs; sincosf(ai * dt, &sn, &cs);
        const float lr = mag * cs, li = mag * sn, den = ar * ar + ai * ai, nr = lr - 1.f;
        const float cr = (nr * ar + li * ai) / den, ci = (li * ar - nr * ai) / den;
        ((f32x2*)(ws + WS_LAM))[g * 64 + n] = (f32x2){lr, li};
        float pr = lr, pi = li;
#pragma unroll
        for (int s = 0; s < 7; ++s) { const float t = pr * pr - pi * pi; pi = 2.f * pr * pi; pr = t; }
        ((f32x2*)(ws + WS_LAMP))[g * 64 + n] = (f32x2){pr, pi};
        bf16_t* bc = (bf16_t*)(ws + WS_BCAT) + (size_t)g * 128 * 16; bf16_t* cc = (bf16_t*)(ws + WS_CCATT) + (size_t)g * 16 * 128;
        unsigned rp[8], ip[8];
#pragma unroll
        for (int h = 0; h < 16; h += 2) { const float b0r = a.in[9][(g * 64 + n) * 16 + h], b0i = a.in[10][(g * 64 + n) * 16 + h], b1r = a.in[9][(g * 64 + n) * 16 + h + 1], b1i = a.in[10][(g * 64 + n) * 16 + h + 1];
            rp[h / 2] = pk2(cr * b0r - ci * b0i, cr * b1r - ci * b1i); ip[h / 2] = pk2(cr * b0i + ci * b0r, cr * b1i + ci * b1r); }
        *(u32x4*)(bc + (size_t)n * 16) = (u32x4){rp[0], rp[1], rp[2], rp[3]}; *(u32x4*)(bc + (size_t)n * 16 + 8) = (u32x4){rp[4], rp[5], rp[6], rp[7]};
        *(u32x4*)(bc + (size_t)(64 + n) * 16) = (u32x4){ip[0], ip[1], ip[2], ip[3]}; *(u32x4*)(bc + (size_t)(64 + n) * 16 + 8) = (u32x4){ip[4], ip[5], ip[6], ip[7]};
#pragma unroll
        for (int h = 0; h < 16; ++h) { cc[h * 128 + n] = (bf16_t)(pk2(a.in[11][(g * 16 + h) * 64 + n], 0.f) & 0xffffu); cc[h * 128 + 64 + n] = (bf16_t)(pk2(-a.in[12][(g * 16 + h) * 64 + n], 0.f) & 0xffffu); }
    }
    for (int it = C.gw; it < NE * LISTCAP / 64; it += C.NGW) ((u32x4*)(ws + WS_LIST))[(size_t)it * 64 + C.lane] = (u32x4){0u, 0u, 0u, 0u};
}

struct CvItem { const float* W; bf16_t* WT; int ldw, ldt, gk; };
DI void cv_decode(const Args& a, unsigned char* ws, int idx, CvItem& t) {
    constexpr int I_GU = 64 * 32 * 16;
    if (idx < 2 * I_GU) { const int up = idx / I_GU, q = idx % I_GU, e = q >> 9, q2 = q & 511, kb = q2 >> 4, nb = q2 & 15, n0 = 32 * nb, k0 = 64 * kb;
        t.W = a.in[24 + up] + (size_t)e * DM * FF + (size_t)k0 * FF + n0; t.ldw = FF; t.ldt = DM; t.gk = k0;
        t.WT = (bf16_t*)(ws + WS_WGU) + (size_t)e * 1024 * DM + (size_t)((n0 >> 7) * 256 + (n0 & 127) + up * 128) * DM + k0; }
    else { const int r = idx - 2 * I_GU, e = r >> 9, q2 = r & 511, kb = q2 >> 6, nb = q2 & 63, n0 = 32 * nb, k0 = 64 * kb;
        t.W = a.in[26] + (size_t)e * FF * DM + (size_t)k0 * DM + n0; t.ldw = DM; t.ldt = FF; t.gk = -1;
        t.WT = (bf16_t*)(ws + WS_WD) + (size_t)e * DM * FF + (size_t)n0 * FF + k0; }
}
DI void cv_issue(const Ctx& C, const Args& a, int idx, LAS unsigned char* slot) {
    CvItem t; cv_decode(a, C.ws, idx, t);
    const int l = C.lane, w = C.wave;
    const float* src = t.W + (size_t)(8 * w + (l >> 3)) * t.ldw + 4 * ((l & 7) ^ w);
    __builtin_amdgcn_global_load_lds((const unsigned*)src, (LAS unsigned*)(slot + 1024 * w), 16, 0, 0);
}
DI void cv_consume(const Ctx& C, const Args& a, int idx, const LAS unsigned char* slot, const LAS float* gl) {
    CvItem t; cv_decode(a, C.ws, idx, t);
    const int l = C.lane, c = l & 7, n = 8 * (C.wave & 3) + (l >> 3);
    const LAS float* xf = (const LAS float*)slot + (8 * c) * 32 + (((n >> 2) ^ c) << 2) + (n & 3);
    float v[8];
#pragma unroll
    for (int i = 0; i < 8; ++i) v[i] = xf[i * 32];
    if (t.gk >= 0) { const f32x4 g0 = *(const LAS f32x4*)(gl + t.gk + 8 * c), g1 = *(const LAS f32x4*)(gl + t.gk + 8 * c + 4);
        v[0] *= g0.x; v[1] *= g0.y; v[2] *= g0.z; v[3] *= g0.w; v[4] *= g1.x; v[5] *= g1.y; v[6] *= g1.z; v[7] *= g1.w; }
    u32x4 o; o.x = pk2(v[0], v[1]); o.y = pk2(v[2], v[3]); o.z = pk2(v[4], v[5]); o.w = pk2(v[6], v[7]);
    *(u32x4*)(t.WT + (size_t)n * t.ldt + 8 * c) = o;
}
DI void expert_item(const Args& a, unsigned char* ws, int idx, TrItem& t) {
    constexpr int I_GU = 64 * 32 * 16;
    if (idx < 2 * I_GU) { const int up = idx / I_GU, q = idx % I_GU, e = q >> 9, q2 = q & 511, kb = q2 >> 4, nb = q2 & 15, n0 = 32 * nb, k0 = 64 * kb;
        t.W = a.in[24 + up] + (size_t)e * DM * FF + (size_t)k0 * FF + n0; t.ldw = FF; t.ldt = DM; t.rs = a.in[19] + k0;
        t.WT = (bf16_t*)(ws + WS_WGU) + (size_t)e * 1024 * DM + (size_t)((n0 >> 7) * 256 + (n0 & 127) + up * 128) * DM + k0; }
    else { const int r = idx - 2 * I_GU, e = r >> 9, q2 = r & 511, kb = q2 >> 6, nb = q2 & 63, n0 = 32 * nb, k0 = 64 * kb;
        t.W = a.in[26] + (size_t)e * FF * DM + (size_t)k0 * DM + n0; t.ldw = DM; t.ldt = FF; t.rs = nullptr;
        t.WT = (bf16_t*)(ws + WS_WD) + (size_t)e * DM * FF + (size_t)n0 * FF + k0; }
}
DI void cv_item(const Args& a, unsigned char* ws, int idx, int nitems, TrItem& t) {
    expert_item(a, ws, idx < nitems ? idx : 0, t);
    if (idx >= nitems) { t.WT = (bf16_t*)(ws + WS_SCR); t.ldt = 64; }
}
DI void convert_range(const Ctx& C, const Args& a, int start, int stride, int end) {
    const int cw = start, ncw = stride, nitems = end;
    LAS float* scr = (LAS float*)(C.lds + C.wave * 8448);
#define CV_LD(k, idx) do { cv_item(a, C.ws, (idx), nitems, t##k); tr_load<(CV_NT >= 1)>(t##k, v##k, C.lane); } while (0)
#define CV_FIN(k) tr_finish<(CV_NT >= 2)>(t##k, v##k, scr, C.lane)
    TrItem t0, t1, t2, t3; f32x4 v0[8], v1[8], v2[8], v3[8];
    CV_LD(0, cw); CV_LD(1, cw + ncw); CV_LD(2, cw + 2 * ncw);
    for (int it = cw; it < nitems; it += 4 * ncw) {
        CV_LD(3, it + 3 * ncw); CV_FIN(0); CV_LD(0, it + 4 * ncw); CV_FIN(1); CV_LD(1, it + 5 * ncw); CV_FIN(2); CV_LD(2, it + 6 * ncw); CV_FIN(3);
    }
#undef CV_LD
#undef CV_FIN
}
DI void convert_queue(const Ctx& C, const Args& a) {
    unsigned* Q = (unsigned*)(C.ws + WS_CTL) + CW_Q;
    for (;;) {
        unsigned k = 0; if (C.lane == 0) k = atomicAdd(Q, (unsigned)CV_GRAB);
        const int idx = CV_STATIC + (int)__builtin_amdgcn_readfirstlane(k);
        if (idx >= 2 * CONV_PAIRS) break;
        const int end = idx + CV_GRAB < 2 * CONV_PAIRS ? idx + CV_GRAB : 2 * CONV_PAIRS;
        convert_range(C, a, idx, 1, end);
    }
}
DI void convert_stream(const Ctx& C, const Args& a, int ci, int nconv, int npairs) {
    (void)npairs;
    convert_range(C, a, ci * NWAVES + C.wave, nconv * NWAVES, CV_STATIC);
    convert_queue(C, a);
    VM_WAIT(); __syncthreads();
}

DI void convert_tail(const Ctx& C, const Args& a) {
#if TAIL_IN_P8
    unsigned* Q = (unsigned*)(C.ws + WS_CTL) + CW_Q;
    LAS float* scr = (LAS float*)(C.lds + C.wave * 8448); LAS float* scrB = (LAS float*)(C.lds + (C.wave < 7 ? 67584 + C.wave * 8448 : XB_OFF));
    for (;;) {
        unsigned k = 0; if (C.lane == 0) k = atomicAdd(Q, 2u);
        const int idx = 2 * CONV_PAIRS + (int)__builtin_amdgcn_readfirstlane(k);
        if (idx >= SIDE_ITEMS) break;
        TrItem t0, t1; f32x4 v0[8], v1[8];
        cv_item(a, C.ws, idx, SIDE_ITEMS, t0); tr_load(t0, v0, C.lane);
        cv_item(a, C.ws, idx + 1, SIDE_ITEMS, t1); tr_load(t1, v1, C.lane);
        tr_finish(t0, v0, scr, C.lane); tr_finish(t1, v1, scrB, C.lane);
    }
    VM_WAIT();
#endif
}

DI void meta_gemm(const Ctx& C) {
    if (C.vcu >= 128) return;
    const int n0 = 16 * C.vcu, l = C.lane, r = l & 15, q = l >> 4;
    const bf16_t* ap = (const bf16_t*)(C.ws + WS_A1M) + (size_t)r * DM + C.wave * 256 + 8 * q;
    const bf16_t* wp = (const bf16_t*)(C.ws + WS_WIN) + (size_t)(n0 + r) * DM + C.wave * 256 + 8 * q;
    f32x4 acc = {0.f, 0.f, 0.f, 0.f};
#pragma unroll
    for (int ks = 0; ks < 8; ++ks) { const bf16x8 af = *(const bf16x8*)(ap + 32 * ks), wf = *(const bf16x8*)(wp + 32 * ks); acc = MFMA16(wf, af, acc); }
    LAS f32x4* red = (LAS f32x4*)(C.lds);
    red[C.wave * 64 + l] = acc;
    __syncthreads();
    if (C.wave == 0) {
#pragma unroll
        for (int w = 1; w < 8; ++w) acc += red[w * 64 + l];
        const int col = n0 + 4 * q; bf16_t* dst = (col < PW) ? (bf16_t*)(C.ws + WS_ZP) + (size_t)(NTOK + r) * PW + col : (bf16_t*)(C.ws + WS_ZS) + (size_t)(NTOK + r) * SW + (col - PW);
        u32x2 w; w.x = pk2(acc[0], acc[1]); w.y = pk2(acc[2], acc[3]); *(u32x2*)dst = w;
    }
}

DI int zrow(int b, int s) { return s >= 0 ? b * SEQ + s : NTOK + NMETA + s; }
DI void pool_diff(const Ctx& C) {
    const bf16_t* ZP = (const bf16_t*)(C.ws + WS_ZP); bf16_t* DD = (bf16_t*)(C.ws + WS_DD);
    for (int it = C.gw; it < 2048; it += C.NGW) {
        const int tb = it >> 1, hf = it & 1, b = tb >> 9, s0 = (tb & 511) * 16, c0 = hf * 512 + C.lane * 8, w = 2 << (c0 >> 8);
        const float inv = 1.f / (float)w;
        f32x4 a0 = {0.f, 0.f, 0.f, 0.f}, a1 = a0;
        for (int j = 1; j < w; ++j) { f32x4 v0, v1; pg8::unpack8(*(const u32x4*)(ZP + (size_t)zrow(b, s0 - j) * PW + c0), v0, v1); a0 += v0; a1 += v1; }
        for (int i = 0; i < 16; ++i) { const int s = s0 + i; f32x4 c0v, c1v, l0, l1;
            pg8::unpack8(*(const u32x4*)(ZP + (size_t)zrow(b, s) * PW + c0), c0v, c1v); a0 += c0v; a1 += c1v;
            *(u32x4*)(DD + (size_t)(b * SEQ + s) * PW + c0) = pg8::pack8(a0 * inv - c0v, a1 * inv - c1v);
            pg8::unpack8(*(const u32x4*)(ZP + (size_t)zrow(b, s - w + 1) * PW + c0), l0, l1); a0 -= l0; a1 -= l1; }
    }
}

template <bool PASS2> DI void ssm_pass(const Ctx& C, const Args& a) {
    const bf16_t* ZS = (const bf16_t*)(C.ws + WS_ZS); bf16_t* S0 = (bf16_t*)(C.ws + WS_S0);
    f32x4* Eb = (f32x4*)(C.ws + WS_E);
    const int l = C.lane, rr = l & 31, bb = (rr >> 2) & 1, jj = (rr & 3) + 4 * (rr >> 3), kofs = 8 * (l >> 5);
    LAS unsigned char* xs = C.lds + C.wave * 8704;
    for (int it = C.gw; it < 64 * NCH; it += C.NGW) {
        const int g = it & 63, c0 = (it >> 6) & 31, c = (it >> 11) ? 63 - c0 : c0;
        const f32x2 lamA = ((const f32x2*)(C.ws + WS_LAM))[g * 64 + (l & 31)], lamB = ((const f32x2*)(C.ws + WS_LAM))[g * 64 + 32 + (l & 31)];
        bf16x8 bfr[4];
#pragma unroll
        for (int ct = 0; ct < 4; ++ct) bfr[ct] = *(const bf16x8*)((const bf16_t*)(C.ws + WS_BCAT) + ((size_t)g * 128 + 32 * ct + (l & 31)) * 16 + kofs);
        float xAr = 0.f, xAi = 0.f, xBr = 0.f, xBi = 0.f;
        bf16x8 cfr[4]; f32x4 dsk = {0.f, 0.f, 0.f, 0.f};
        if constexpr (PASS2) {
#pragma unroll
            for (int ks = 0; ks < 4; ++ks) cfr[ks] = *(const bf16x8*)((const bf16_t*)(C.ws + WS_CCATT) + ((size_t)g * 16 + (l & 15)) * 128 + 32 * ks + 8 * (l >> 4));
            dsk = *(const f32x4*)(a.in[13] + g * 16 + 4 * (l >> 4));
            if (c > 0) {
                const f32x2 LA = ((const f32x2*)(C.ws + WS_LAMP))[g * 64 + (l & 31)], LB = ((const f32x2*)(C.ws + WS_LAMP))[g * 64 + 32 + (l & 31)];
                const f32x4* ep = Eb + ((size_t)g * NCH) * 64 + l;
                f32x4 t = ep[0];
                for (int j0 = 1; j0 < c; j0 += 8) {
                    f32x4 eb[8];
#pragma unroll
                    for (int i = 0; i < 8; ++i) { const int j = (j0 + i < c) ? j0 + i : c - 1; eb[i] = ep[(size_t)j * 64]; }
#pragma unroll
                    for (int i = 0; i < 8; ++i) if (j0 + i < c) { const f32x4 e = eb[i];
                        const float ar = LA.x * t.x - LA.y * t.y + e.x, ai = LA.x * t.y + LA.y * t.x + e.y, br = LB.x * t.z - LB.y * t.w + e.z, bi = LB.x * t.w + LB.y * t.z + e.w;
                        t = (f32x4){ar, ai, br, bi}; }
                }
                xAr = t.x; xAi = t.y; xBr = t.z; xBi = t.w;
            }
        }
        const int nsteps = (c == 0) ? 9 : 8;
        auto urow = [&](int st) { const bool m = (c == 0 && st == 0); const int sb = c * CHL + 16 * (st - (c == 0 ? 1 : 0)); return m ? NTOK + jj : bb * SEQ + sb + jj; };
        bf16x8 af0 = *(const bf16x8*)(ZS + (size_t)urow(0) * SW + g * 16 + kofs), af1 = *(const bf16x8*)(ZS + (size_t)urow(1) * SW + g * 16 + kofs);
        for (int st = 0; st < nsteps; ++st) {
            const bool meta = (c == 0 && st == 0);
            const int sbase = c * CHL + 16 * (st - (c == 0 ? 1 : 0));
            const bf16x8 af = af0; af0 = af1;
            { const int stn = st + 2 < nsteps ? st + 2 : nsteps - 1; af1 = *(const bf16x8*)(ZS + (size_t)urow(stn) * SW + g * 16 + kofs); }
            f32x16 z16;
#pragma unroll
            for (int i = 0; i < 16; ++i) z16[i] = 0.f;
            f32x16 q0 = MFMA32(af, bfr[0], z16), q1 = MFMA32(af, bfr[1], z16), q2 = MFMA32(af, bfr[2], z16), q3 = MFMA32(af, bfr[3], z16);
#pragma unroll
            for (int r = 0; r < 16; ++r) {
                const float nar = lamA.x * xAr - lamA.y * xAi + q0[r], nai = lamA.x * xAi + lamA.y * xAr + q2[r];
                const float nbr = lamB.x * xBr - lamB.y * xBi + q1[r], nbi = lamB.x * xBi + lamB.y * xBr + q3[r];
                xAr = nar; xAi = nai; xBr = nbr; xBi = nbi;
                if constexpr (PASS2) { q0[r] = nar; q1[r] = nbr; q2[r] = nai; q3[r] = nbi; }
            }
            if constexpr (PASS2) {
                if (!meta) {
#pragma unroll
                    for (int r = 0; r < 16; ++r) { LAS unsigned short* xr = (LAS unsigned short*)(xs + (16 * (l >> 5) + r) * 272) + (l & 31);
                        const unsigned wre = pk2(q0[r], q1[r]), wim = pk2(q2[r], q3[r]);
                        xr[0] = (unsigned short)(wre & 0xffffu); xr[32] = (unsigned short)(wre >> 16); xr[64] = (unsigned short)(wim & 0xffffu); xr[96] = (unsigned short)(wim >> 16); }
                    asm volatile("" ::: "memory");
#pragma unroll
                    for (int hb = 0; hb < 2; ++hb) {
                        f32x4 y = {0.f, 0.f, 0.f, 0.f};
#pragma unroll
                        for (int ks = 0; ks < 4; ++ks) { const bf16x8 xf = *(const LAS bf16x8*)(xs + (16 * hb + (l & 15)) * 272 + (32 * ks + 8 * (l >> 4)) * 2); y = MFMA16(cfr[ks], xf, y); }
                        const size_t orow = (size_t)hb * SEQ + sbase + (l & 15);
                        const u32x2 uw = *(const u32x2*)(ZS + orow * SW + g * 16 + 4 * (l >> 4));
                        const float s0 = y[0] + dsk[0] * bflo(uw.x), s1 = y[1] + dsk[1] * bfhi(uw.x), s2 = y[2] + dsk[2] * bflo(uw.y), s3 = y[3] + dsk[3] * bfhi(uw.y);
                        u32x2 ow; ow.x = pk2(gelu_t(s0), gelu_t(s1)); ow.y = pk2(gelu_t(s2), gelu_t(s3));
                        *(u32x2*)(S0 + orow * SW + g * 16 + 4 * (l >> 4)) = ow;
                    }
                    asm volatile("" ::: "memory");
                }
            }
        }
        if constexpr (!PASS2) Eb[((size_t)g * NCH + c) * 64 + l] = (f32x4){xAr, xAi, xBr, xBi};
    }
}

constexpr int RT_XD = 16384, RT_X = 0, RT_D = 8192, RT_NXD = 6, RT_WOFF = RT_NXD * RT_XD, RT_W = 20480, RT_WH = 0, RT_WL = 10240;
DI void rt_issue_xd(const Ctx& C, const bf16_t* U, const bf16_t* DLT, int t0, int c, LAS unsigned char* stg) {
    const int l = C.lane, w = C.wave;
#pragma unroll
    for (int i = 0; i < 2; ++i) { const int j = 2 * w + i, row = 8 * j + (l >> 3), u = (l & 7) ^ (row & 7);
        __builtin_amdgcn_global_load_lds((const unsigned*)(U + (size_t)(t0 + row) * DM + 64 * c + 8 * u), (LAS unsigned*)(stg + RT_X + 1024 * j), 16, 0, RT_AUX);
        __builtin_amdgcn_global_load_lds((const unsigned*)(DLT + (size_t)(t0 + row) * DM + 64 * c + 8 * u), (LAS unsigned*)(stg + RT_D + 1024 * j), 16, 0, RT_AUX); }
}
DI void rt_issue_w(const Ctx& C, int c, LAS unsigned char* stg) {
    const int l = C.lane, w = C.wave - 4;
    const bf16_t* WRH = (const bf16_t*)(C.ws + WS_WRH); const bf16_t* WRL = (const bf16_t*)(C.ws + WS_WRL);
#pragma unroll
    for (int i = 0; i < 5; ++i) { const int j = 5 * w + i;
        const int jj = j < 10 ? j : j - 10, n = 8 * jj + (l >> 3), u = (l & 7) ^ (n & 7); const bf16_t* src = (j < 10 ? WRH : WRL) + (size_t)n * DM + 64 * c + 8 * u;
        __builtin_amdgcn_global_load_lds((const unsigned*)src, (LAS unsigned*)(stg + (j < 10 ? RT_WH : RT_WL) + 1024 * jj), 16, 0, 0); }
}
DI void router_phase(const Ctx& C, const Args& a) {
    const bf16_t* DLT = (const bf16_t*)(C.ws + WS_DL); bf16_t* V = (bf16_t*)(C.ws + WS_V);
    unsigned* counts = (unsigned*)(C.ws + WS_CTL) + CW_CNT; uint4* LIST = (uint4*)(C.ws + WS_LIST);
    const int l = C.lane, r = l & 15, q = l >> 4, rt = C.wave & 3, kp = C.wave >> 2;
    LAS float* part = (LAS float*)(C.lds);
    LAS float* lgb = (LAS float*)(C.lds + 32768);
    LAS float* igl = (LAS float*)(C.lds + RT_WOFF + 2 * RT_W);
    for (int i = C.tid; i < DM; i += NWAVES * 64) igl[i] = 1.f / a.in[2][i];
    __syncthreads();
    for (int tb = C.vcu; tb < NTOK / 64; tb += C.G) {
        const int t0 = tb * 64, row = 16 * rt + r;
        bf16_t* vrow = V + (size_t)(t0 + row) * DM + 32 * kp + 8 * q;
        LAS float* invl = (LAS float*)(C.lds + TAB_OFF);
        if (C.tid < 64) invl[C.tid] = 1.f / ((const float*)(C.ws + WS_RSTD1))[t0 + C.tid];
        VM_WAIT(); LDS_WAIT(); __syncthreads();
        const float inv = invl[row];
        f32x4 acc[5];
#pragma unroll
        for (int n = 0; n < 5; ++n) acc[n] = (f32x4){0.f, 0.f, 0.f, 0.f};
        float ss = 0.f;
        if (C.wave < 4) {
#pragma unroll
            for (int s = 0; s < RT_NXD - 1; ++s) rt_issue_xd(C, V, DLT, t0, s, C.lds + s * RT_XD);
        } else rt_issue_w(C, 0, C.lds + RT_WOFF);
        int sx = 0;
        for (int c = 0; c < 32; ++c) {
            if (C.wave < 4) {
                if (c + RT_NXD - 1 < 32) rt_issue_xd(C, V, DLT, t0, c + RT_NXD - 1, C.lds + (sx == 0 ? RT_NXD - 1 : sx - 1) * RT_XD);
                if (c + RT_NXD - 1 >= 32) asm volatile("s_waitcnt vmcnt(0)" ::: "memory");
                else if (c == 0) asm volatile("s_waitcnt vmcnt(20)" ::: "memory"); else if (c == 1) asm volatile("s_waitcnt vmcnt(21)" ::: "memory");
                else if (c == 2) asm volatile("s_waitcnt vmcnt(22)" ::: "memory"); else if (c == 3) asm volatile("s_waitcnt vmcnt(23)" ::: "memory");
                else if (c == 4) asm volatile("s_waitcnt vmcnt(24)" ::: "memory"); else asm volatile("s_waitcnt vmcnt(25)" ::: "memory");
            } else {
                if (c + 1 < 32) rt_issue_w(C, c + 1, C.lds + RT_WOFF + ((c + 1) & 1) * RT_W);
                if (c >= 31) asm volatile("s_waitcnt vmcnt(0)" ::: "memory");
                else if (c == 0) asm volatile("s_waitcnt vmcnt(5)" ::: "memory"); else asm volatile("s_waitcnt vmcnt(6)" ::: "memory");
            }
            __builtin_amdgcn_s_barrier(); asm volatile("" ::: "memory");
            const LAS unsigned char* stg = C.lds + sx * RT_XD; const LAS unsigned char* wst = C.lds + RT_WOFF + (c & 1) * RT_W;
            const u32x4 uw = *(const LAS u32x4*)(stg + RT_X + row * 128 + (((4 * kp + q) ^ (row & 7)) << 4));
            const u32x4 dw = *(const LAS u32x4*)(stg + RT_D + row * 128 + (((4 * kp + q) ^ (row & 7)) << 4));
            const f32x4 ig0 = *(const LAS f32x4*)(igl + 64 * c + 32 * kp + 8 * q), ig1 = *(const LAS f32x4*)(igl + 64 * c + 32 * kp + 8 * q + 4);
            bf16x8 wh[5], wl[5];
#pragma unroll
            for (int n = 0; n < 5; ++n) { const int nn = 16 * n + r; const int off = nn * 128 + (((4 * kp + q) ^ (nn & 7)) << 4);
                wh[n] = *(const LAS bf16x8*)(wst + RT_WH + off); wl[n] = *(const LAS bf16x8*)(wst + RT_WL + off); }
            f32x4 d0, d1, u0, u1; pg8::unpack8(dw, d0, d1); pg8::unpack8(uw, u0, u1);
            const f32x4 h0 = u0 * ig0 * inv + d0, h1 = u1 * ig1 * inv + d1;
            ss += (h0.x * h0.x + h0.y * h0.y) + (h0.z * h0.z + h0.w * h0.w) + (h1.x * h1.x + h1.y * h1.y) + (h1.z * h1.z + h1.w * h1.w);
            u32x4 hi; hi.x = pk2(h0.x, h0.y); hi.y = pk2(h0.z, h0.w); hi.z = pk2(h1.x, h1.y); hi.w = pk2(h1.z, h1.w);
            u32x4 lo; lo.x = pk2(h0.x - bflo(hi.x), h0.y - bfhi(hi.x)); lo.y = pk2(h0.z - bflo(hi.y), h0.w - bfhi(hi.y)); lo.z = pk2(h1.x - bflo(hi.z), h1.y - bfhi(hi.z)); lo.w = pk2(h1.z - bflo(hi.w), h1.w - bfhi(hi.w));
            *(u32x4*)(vrow + 64 * c) = hi;
            const bf16x8 ahi = __builtin_bit_cast(bf16x8, hi), alo = __builtin_bit_cast(bf16x8, lo);
#pragma unroll
            for (int n = 0; n < 5; ++n) { acc[n] = MFMA16(wh[n], ahi, acc[n]); acc[n] = MFMA16(wh[n], alo, acc[n]); acc[n] = MFMA16(wl[n], ahi, acc[n]); }
            LDS_WAIT(); __builtin_amdgcn_s_barrier(); asm volatile("" ::: "memory");
            sx = sx == RT_NXD - 1 ? 0 : sx + 1;
        }
        ss += __shfl_xor(ss, 16); ss += __shfl_xor(ss, 32);
        if (kp == 1) {
#pragma unroll
            for (int n = 0; n < 5; ++n)
#pragma unroll
                for (int j = 0; j < 4; ++j) part[(rt * 21 + n * 4 + j) * 64 + l] = acc[n][j];
            part[(rt * 21 + 20) * 64 + l] = ss;
        }
        __syncthreads();
        if (kp == 0) {
#pragma unroll
            for (int n = 0; n < 5; ++n)
#pragma unroll
                for (int j = 0; j < 4; ++j) acc[n][j] += part[(rt * 21 + n * 4 + j) * 64 + l];
            ss += part[(rt * 21 + 20) * 64 + l];
            const float rstd = rsqrtf(ss * (1.f / DM) + RMS_EPS);
            LAS float* lg = lgb + rt * 16 * 80;
#pragma unroll
            for (int n = 0; n < 5; ++n)
#pragma unroll
                for (int j = 0; j < 4; ++j) { const int idx = 16 * n + 4 * q + j; if (idx < 72) { const float bias = idx < 8 ? a.in[21][idx] : a.in[23][idx - 8]; lg[r * 80 + idx] = acc[n][j] * rstd + bias; } }
            LDS_WAIT(); asm volatile("" ::: "memory");
            if (l < 16) {
                const LAS float* p = lg + l * 80;
                int gs = 0; float mx = p[0];
#pragma unroll
                for (int k = 1; k < 8; ++k) { const float v = p[k]; if (v > mx) { mx = v; gs = k; } }
                float den = 0.f;
#pragma unroll
                for (int k = 0; k < 8; ++k) den += expf(p[k] - mx);
                const float pgp = 1.f / den;
                const LAS float* el = p + 8 + gs * 8;
                int i0 = 0; float v0 = el[0];
#pragma unroll
                for (int k = 1; k < 8; ++k) { const float v = el[k]; if (v > v0) { v0 = v; i0 = k; } }
                int i1 = -1; float v1 = -3.0e38f;
#pragma unroll
                for (int k = 0; k < 8; ++k) { const float v = el[k]; if (k != i0 && v > v1) { v1 = v; i1 = k; } }
                const float e1 = expf(v1 - v0), w0 = pgp / (1.f + e1), w1 = pgp * e1 / (1.f + e1);
                const int tok = t0 + 16 * rt + l, ex0 = gs * 8 + i0, ex1 = gs * 8 + i1;
                const unsigned r0 = atomicAdd(&counts[ex0], 1u), r1 = atomicAdd(&counts[ex1], 1u);
                LIST[(size_t)ex0 * LISTCAP + r0] = make_uint4((unsigned)tok, (unsigned)(2 * tok), __float_as_uint(w0), __float_as_uint(rstd));
                LIST[(size_t)ex1 * LISTCAP + r1] = make_uint4((unsigned)tok, (unsigned)(2 * tok + 1), __float_as_uint(w1), __float_as_uint(rstd));
            }
        }
        VM_WAIT(); __syncthreads();
    }
}
DI void moe_tables(const Ctx& C, int ntn) {
    volatile LAS int* tab = (volatile LAS int*)(C.lds + TAB_OFF);
    if (C.tid < 64) {
        const unsigned* counts = (const unsigned*)(C.ws + WS_CTL) + CW_CNT;
        const int cnt = (int)__hip_atomic_load(counts + C.tid, RLX_AGENT); const int nblk = (cnt + 255) >> 8;
        int incl = nblk;
#pragma unroll
        for (int o = 1; o < 64; o <<= 1) { const int t = __shfl_up(incl, o); if (C.tid >= o) incl += t; }
        tab[C.tid + 1] = incl * ntn; if (C.tid == 0) tab[0] = 0;
        tab[80 + C.tid] = (incl - nblk) * 256; tab[160 + C.tid] = cnt;
    }
    __syncthreads();
}
struct FinRow { u32x2 hw[8]; unsigned p[8], q[8]; };
DI void fin_load(FinRow& R, const unsigned char* ws, int t, int lane) {
    const u32x2* hb = (const u32x2*)((const bf16_t*)(ws + WS_V) + (size_t)t * DM) + lane;
    const unsigned* y0 = (const unsigned*)(ws + WS_YB + (size_t)(2 * t) * DM) + lane; const unsigned* y1 = (const unsigned*)(ws + WS_YB + (size_t)(2 * t + 1) * DM) + lane;
#pragma unroll
    for (int j = 0; j < 8; ++j) { if (FIN_NT) { R.hw[j] = __builtin_nontemporal_load(hb + 64 * j); R.p[j] = __builtin_nontemporal_load(y0 + 64 * j); R.q[j] = __builtin_nontemporal_load(y1 + 64 * j); }
        else { R.hw[j] = hb[64 * j]; R.p[j] = y0[64 * j]; R.q[j] = y1[64 * j]; } }
}
DI void fin_finish(const FinRow& R, const float* gfin, float* orow, int lane) {
    constexpr float IS = 1.f / 16.f;
    f32x4 v[8]; float s = 0.f;
#pragma unroll
    for (int j = 0; j < 8; ++j) { const u32x2 hw = R.hw[j]; const int p = (int)R.p[j], q = (int)R.q[j];
        v[j] = (f32x4){bflo(hw.x) + IS * (__builtin_amdgcn_cvt_f32_fp8(p, 0) + __builtin_amdgcn_cvt_f32_fp8(q, 0)), bfhi(hw.x) + IS * (__builtin_amdgcn_cvt_f32_fp8(p, 1) + __builtin_amdgcn_cvt_f32_fp8(q, 1)),
                       bflo(hw.y) + IS * (__builtin_amdgcn_cvt_f32_fp8(p, 2) + __builtin_amdgcn_cvt_f32_fp8(q, 2)), bfhi(hw.y) + IS * (__builtin_amdgcn_cvt_f32_fp8(p, 3) + __builtin_amdgcn_cvt_f32_fp8(q, 3))};
        s += (v[j].x * v[j].x + v[j].y * v[j].y) + (v[j].z * v[j].z + v[j].w * v[j].w); }
    const float rstd = rsqrtf(wave_sum(s) * (1.f / DM) + RMS_EPS);
    const f32x4* gr = (const f32x4*)gfin + lane; f32x4* o = (f32x4*)orow + lane;
#pragma unroll
    for (int j = 0; j < 8; ++j) { const f32x4 gg = gr[64 * j]; const f32x4 r = {v[j].x * rstd * gg.x, v[j].y * rstd * gg.y, v[j].z * rstd * gg.z, v[j].w * rstd * gg.w};
        if (FIN_ST_NT) __builtin_nontemporal_store(r, o + 64 * j); else o[64 * j] = r; }
}
DI void final_phase(const Ctx& C, const Args& a, float* dst_override = nullptr) {
    float* out = dst_override ? dst_override : a.out;
    static_assert(NTOK % 2 == 0, "rows are taken in pairs");
    for (int t = 2 * C.gw; t < NTOK; t += 2 * C.NGW) {
        FinRow A, B; fin_load(A, C.ws, t, C.lane); fin_load(B, C.ws, t + 1, C.lane);
        fin_finish(A, a.in[27], out + (size_t)t * DM, C.lane); fin_finish(B, a.in[27], out + (size_t)(t + 1) * DM, C.lane);
    }
}
constexpr int N_PHASES = 11;
DI bool is_conv(const Ctx& C) { return NCONV && C.G == 256 && (C.vcu & 31) >= 32 - NCONV / 8; }
DI int gemm_index(const Ctx& C) { return (C.vcu >> 5) * (32 - NCONV / 8) + (C.vcu & 31); }
DI void meta_gemm_g(const Ctx& C) { Ctx M = C; M.vcu = (NCONV && C.G == 256) ? gemm_index(C) : C.vcu; meta_gemm(M); }
DI void phase1_conv(const Ctx& C, const Args& args) { const int ng = 32 - NCONV / 8; convert_stream(C, args, (C.vcu >> 5) * (NCONV / 8) + ((C.vcu & 31) - ng), NCONV, CONV_PAIRS); }
DI void phase1_gemm(const Ctx& C, const Args& args) {
    unsigned char* ws = C.ws;
    pg8::DenseOrder S;
    if (NCONV && C.G == 256) S.setup(ws + WS_A1, ws + WS_WIN, NTOK, INW, DM, DM, 256 - NCONV, (C.vcu & 31) * 8 + (C.vcu >> 5));
    else S.setup(ws + WS_A1, ws + WS_WIN, NTOK, INW, DM, DM, C.G, (int)blockIdx.x);
    pg8::EpiZ E{(bf16_t*)(ws + WS_ZP), (bf16_t*)(ws + WS_ZS), ws + WS_GP, ws + WS_GS};
    pg8::gemm_phase<pg8::EpiZ, pg8::DenseOrder, true, true>(C.lds, pg8::Gemm{DM, DM, DM}, S, E);
    meta_gemm_g(C);
    if (NCONV && C.G == 256 && CV_QFRAC) { __syncthreads(); convert_queue(C, args); VM_WAIT(); __syncthreads(); }
}
DI void phase1(const Ctx& C, const Args& args) { if (is_conv(C)) phase1_conv(C, args); else phase1_gemm(C, args); }
DI void phase2(const Ctx& C, const Args& args) { pool_diff(C); ssm_pass<false>(C, args); }
DI void phase3(const Ctx& C, const Args& args) {
    unsigned char* ws = C.ws;
    pg8::PoolOrder S; S.init(NTOK / 256, 4, C.G, (int)blockIdx.x); S.DD = (const char*)(ws + WS_DD); S.PWT = (const char*)(ws + WS_POOLW);
    pg8::EpiPool E{(bf16_t*)(ws + WS_PP), args.in[5]};
    pg8::gemm_phase<pg8::EpiPool, pg8::PoolOrder, true, true>(C.lds, pg8::Gemm{PW, 256, 256}, S, E);
    ssm_pass<true>(C, args);
}
DI void phase4(const Ctx& C, const Args& args) {
    unsigned char* ws = C.ws;
    pg8::DenseOrder S; S.setup(ws + WS_S0, ws + WS_WGLU, NTOK, SW, SW, SW, C.G, (int)blockIdx.x);
    pg8::EpiGlu E{(const bf16_t*)(ws + WS_S0), (bf16_t*)(ws + WS_SS), args.in[15]};
    pg8::gemm_phase<pg8::EpiGlu, pg8::DenseOrder, true, true>(C.lds, pg8::Gemm{SW, SW, SW}, S, E);
}
DI void phase5(const Ctx& C, const Args& args) {
    unsigned char* ws = C.ws;
    pg8::MergeOrder S; S.init(NTOK / 256, DM / 256, C.G, (int)blockIdx.x);
    S.A0 = (const char*)(ws + WS_PP); S.B0 = (const char*)(ws + WS_WBP); S.A1 = (const char*)(ws + WS_SS); S.B1 = (const char*)(ws + WS_WBS); S.tstepA = (size_t)256 * PW * 2; S.tstepB = (size_t)256 * PW * 2;
    pg8::EpiMerge E{ws + WS_GP, ws + WS_GS, (bf16_t*)(ws + WS_MP)};
    pg8::gemm_phase<pg8::EpiMerge, pg8::MergeOrder, true, true>(C.lds, pg8::Gemm{PW, PW, PW}, S, E);
}
DI void phase6(const Ctx& C, const Args& args) {
    unsigned char* ws = C.ws;
    pg8::DenseOrder S; S.setup(ws + WS_MP, ws + WS_WOUT, NTOK, DM, DM, DM, C.G, (int)blockIdx.x);
    pg8::EpiDelta E{(bf16_t*)(ws + WS_DL)};
#if SIDE_P56
    pg8::SideConv sd; sd.init(args.in[24], args.in[25], args.in[26], (bf16_t*)(ws + WS_WGU), (bf16_t*)(ws + WS_WD), (bf16_t*)(ws + WS_SCR), C.lds + XB_OFF, SIDE_N1 + 2 * SIDE_N5 + C.vcu, SIDE_TOTAL, C.G);
    pg8::gemm_phase<pg8::EpiDelta, pg8::DenseOrder, true, true, pg8::SideConv>(C.lds, pg8::Gemm{DM, DM, DM}, S, E, sd);
#else
    pg8::gemm_phase<pg8::EpiDelta, pg8::DenseOrder, true, true>(C.lds, pg8::Gemm{DM, DM, DM}, S, E);
#endif
}
DI void phase8(const Ctx& C, const Args& args) {
    unsigned char* ws = C.ws;
    __syncthreads();
    moe_tables(C, 4);
    pg8::MoeUpOrder S; S.tab = (const volatile LAS int*)(C.lds + TAB_OFF); S.ntn = 4; S.G = C.G; S.vcu = C.vcu; S.list = (const uint4*)(ws + WS_LIST);
    S.Abase = (const char*)(ws + WS_V); S.Bbase = (const char*)(ws + WS_WGU); S.bstep_e = (size_t)1024 * DM * 2; S.bstep_n = (size_t)256 * DM * 2; S.astep_row = 0; S.up = true;
    pg8::EpiMoeUp E{(bf16_t*)(ws + WS_HH)};
    pg8::gemm_phase<pg8::EpiMoeUp, pg8::MoeUpOrder, true, true>(C.lds, pg8::Gemm{DM, DM, DM}, S, E);
    convert_tail(C, args);
}
DI void phase9(const Ctx& C, const Args& args) {
    unsigned char* ws = C.ws;
    __syncthreads();
    moe_tables(C, 8);
    pg8::MoeDownOrder S; S.tab = (const volatile LAS int*)(C.lds + TAB_OFF); S.ntn = 8; S.G = C.G; S.vcu = C.vcu; S.list = (const uint4*)(ws + WS_LIST);
    S.Abase = (const char*)(ws + WS_HH); S.Bbase = (const char*)(ws + WS_WD); S.bstep_e = (size_t)DM * FF * 2; S.bstep_n = (size_t)256 * FF * 2; S.astep_row = (size_t)FF * 2; S.up = false;
    pg8::EpiMoeDown E{(bf16_t*)(ws + WS_YB)};
    pg8::gemm_phase<pg8::EpiMoeDown, pg8::MoeDownOrder, true, true>(C.lds, pg8::Gemm{FF, FF, FF}, S, E);
}
#ifndef PH_MASK
#define PH_MASK 0x7ff
#endif
#ifndef PROBE_DBL
#define PROBE_DBL 0
#endif
#ifndef OVERLAP_P0
#define OVERLAP_P0 1
#endif
__global__ void __launch_bounds__(NWAVES * 64, 2) mk_fwd(Args args) {
    extern __shared__ __attribute__((aligned(16))) unsigned char lds_raw[];
    Ctx C; C.lds = (LAS unsigned char*)lds_raw; C.ws = args.ws; C.tid = threadIdx.x; C.lane = C.tid & 63; C.wave = __builtin_amdgcn_readfirstlane(C.tid >> 6);
    C.G = gridDim.x; { const int bx = blockIdx.x; C.vcu = (C.G % 8 == 0) ? (bx % 8) * (C.G / 8) + bx / 8 : bx; }
    C.gw = C.wave * C.G + C.vcu; C.NGW = NWAVES * C.G;
    unsigned char* ws = args.ws;
    for (int u = C.tid; u < (LDS_BYTES - MISC_OFF) / 4; u += NWAVES * 64) ((LAS unsigned*)(C.lds + MISC_OFF))[u] = 0u;
    __syncthreads();
    const int lo = args.ph_lo, hi = args.ph_hi;
    XcdBarrier bar; bar.bar = (unsigned*)(ws + WS_CTL) + CW_BAR; bar.x = 0; bar.st = nullptr;
    if (hi - lo > 1) bar = xcd_barrier_post((unsigned*)(ws + WS_CTL) + CW_BAR, (volatile LAS unsigned*)(C.lds + MISC_OFF) + 8, gridDim.x);
#if NCONV && OVERLAP_P0
    XcdBarrier bar2; bar2.bar = (unsigned*)(ws + WS_CTL) + CW_BAR2; bar2.x = 0; bar2.st = nullptr; bar2.expected = 0;
    if (hi - lo > 1 && C.G == 256 && !is_conv(C)) bar2 = xcd_barrier_post((unsigned*)(ws + WS_CTL) + CW_BAR2, (volatile LAS unsigned*)(C.lds + MISC_OFF) + 10, 256 - NCONV);
#endif
#define IN(k) (((PH_MASK >> (k)) & 1) && lo <= (k) && (k) < hi)
#ifndef PROBE_BAR
#define PROBE_BAR 0
#endif
#define SEAM(k) do { if (IN(k) && IN((k) + 1)) { if (args.use_cg && (k) == 0) { cg::this_grid().sync(); } else xcd_barrier(bar); for (int pb_ = 0; pb_ < PROBE_BAR; ++pb_) xcd_barrier(bar); } } while (0)
#ifndef STAGGER
#define STAGGER 0
#endif
#ifndef STAGGER_MASK
#define STAGGER_MASK 0x362
#endif
#define RUN(k, call) do { if (IN(k)) { if (STAGGER && ((STAGGER_MASK >> (k)) & 1)) { for (int sg_ = 0; sg_ < (C.vcu & 7); ++sg_) __builtin_amdgcn_s_sleep(STAGGER); } call; if ((PROBE_DBL >> (k)) & 1) { xcd_barrier(bar); call; } } } while (0)
#if NCONV && OVERLAP_P0
    if (IN(0) && IN(1) && C.G == 256) {
        if (is_conv(C)) phase1_conv(C, args);
        else { Ctx P = C; const int gi = gemm_index(C); P.gw = C.wave * (256 - NCONV) + gi; P.NGW = NWAVES * (256 - NCONV);
               p0_prologue(P, args, 3); xcd_barrier(bar2); phase1_gemm(C, args); }
    } else
#endif
    { RUN(0, p0_prologue(C, args)); SEAM(0);
      RUN(1, phase1(C, args)); }
    SEAM(1);
    RUN(2, phase2(C, args)); SEAM(2);
    RUN(3, phase3(C, args)); SEAM(3);
    RUN(4, phase4(C, args)); SEAM(4);
    RUN(5, phase5(C, args)); SEAM(5);
    RUN(6, phase6(C, args)); SEAM(6);
#if (PROBE_DBL >> 7) & 1
    if (IN(7)) { router_phase(C, args); xcd_barrier(bar); if (blockIdx.x == 0 && C.tid < 64) ((unsigned*)(ws + WS_CTL) + CW_CNT)[C.tid] = 0u; xcd_barrier(bar); router_phase(C, args); } SEAM(7);
#else
    RUN(7, router_phase(C, args)); SEAM(7);
#endif
    RUN(8, phase8(C, args)); SEAM(8);
    RUN(9, phase9(C, args)); SEAM(9);
#if (PROBE_DBL >> 10) & 1
    if (IN(10)) { final_phase(C, args, (float*)(ws + WS_ZP)); xcd_barrier(bar); final_phase(C, args); }
#else
    RUN(10, final_phase(C, args));
#endif
#undef IN
#undef SEAM
#undef RUN
}

#ifdef MK_DEBUG
namespace dbg {
constexpr int DL = 16 + 768;
__global__ void __launch_bounds__(256) k_cmp(const void* opt, int is_bf16, int old_, int ocol0, const float* ref, int rld, int rcol0, int ncols, int kind, int transform, float tol, unsigned* res) {
    __shared__ float red[4];
    const int r = blockIdx.x, p = r;
    if (kind == 0 && p < 16) return;
    if (kind >= 2 && p >= 16) return;
    const size_t orow = kind == 2 ? (size_t)p : (p < 16 ? (size_t)(NTOK + p) : (size_t)(SEQ + p - 16));
    float e2 = 0.f, r2 = 0.f;
    for (int c = threadIdx.x; c < ncols; c += 256) {
        float rv = ref[(size_t)r * rld + rcol0 + c]; if (transform == 1) rv = 1.f / (1.f + expf(-rv));
        float ov = is_bf16 ? __uint_as_float(((unsigned)((const bf16_t*)opt)[orow * old_ + ocol0 + c]) << 16) : ((const float*)opt)[orow * old_ + ocol0 + c];
        const float d = ov - rv; e2 += d * d; r2 += rv * rv; }
    e2 = nv::block_sum_256(e2, red); r2 = nv::block_sum_256(r2, red);
    if (threadIdx.x == 0) { const bool bad = !(e2 <= tol * tol * r2 + 1e-20f); if (bad) atomicAdd(res, 1u); const float rel = sqrtf(e2 / (r2 + 1e-30f)); atomicMax(res + 1, __float_as_uint(rel == rel ? rel : 3.0e38f)); }
}
__global__ void __launch_bounds__(256) k_cmp_moe(const bf16_t* YB, const float* ref, float tol, unsigned* res) {
    __shared__ float red[4];
    const int r = blockIdx.x, p = r; if (p < 16) return; const size_t t = (size_t)(SEQ + p - 16);
    float e2 = 0.f, r2 = 0.f;
    for (int c = threadIdx.x; c < DM; c += 256) { const float rv = ref[(size_t)r * DM + c];
        const float ov = __uint_as_float(((unsigned)YB[(2 * t) * DM + c]) << 16) + __uint_as_float(((unsigned)YB[(2 * t + 1) * DM + c]) << 16);
        const float d = ov - rv; e2 += d * d; r2 += rv * rv; }
    e2 = nv::block_sum_256(e2, red); r2 = nv::block_sum_256(r2, red);
    if (threadIdx.x == 0) { const bool bad = !(e2 <= tol * tol * r2 + 1e-20f); if (bad) atomicAdd(res, 1u); const float rel = sqrtf(e2 / (r2 + 1e-30f)); atomicMax(res + 1, __float_as_uint(rel == rel ? rel : 3.0e38f)); }
}
__global__ void __launch_bounds__(256) k_cmp_wt(const bf16_t* WT, int ldt, const float* W, const float* W2, int ldw, int K, int mode, float tol, unsigned* res) {
    __shared__ float red[4];
    const int n = blockIdx.x; const float* src = W; int col = n;
    if (mode == 1) { const int blk = n >> 8, within = n & 255; col = blk * 128 + (within & 127); src = within >= 128 ? W2 : W; }
    float e2 = 0.f, r2 = 0.f;
    for (int k = threadIdx.x; k < K; k += 256) { const float rv = src[(size_t)k * ldw + col]; const float ov = __uint_as_float(((unsigned)WT[(size_t)n * ldt + k]) << 16); const float d = ov - rv; e2 += d * d; r2 += rv * rv; }
    e2 = nv::block_sum_256(e2, red); r2 = nv::block_sum_256(r2, red);
    if (threadIdx.x == 0) { const bool bad = !(e2 <= tol * tol * r2 + 1e-20f); if (bad) atomicAdd(res, 1u); const float rel = sqrtf(e2 / (r2 + 1e-30f)); atomicMax(res + 1, __float_as_uint(rel == rel ? rel : 3.0e38f)); }
}
__global__ void __launch_bounds__(256) k_finalize(float* out, size_t n, const unsigned* res, int nchecks, int mode, int which) {
    int first = -1;
    for (int k = 0; k < nchecks; ++k) { const unsigned allowed = (k >= 22) ? 60u : 0u; if (res[2 * k] > allowed) { first = k; break; } }
    float K = 0.f;
    if (mode == 0) { if (first < 0) return; K = (float)(first + 1); }
    else { const float rel = __uint_as_float(res[2 * which + 1]); K = 1.f + 10.f * fminf(rel, 2.f); }
    for (size_t i = (size_t)blockIdx.x * 256 + threadIdx.x; i < n; i += (size_t)gridDim.x * 256) out[i] = K;
}
}
#endif

#ifndef MK_LAUNCHES
#define MK_LAUNCHES 1
#endif
#ifndef MK_USE_CG
#define MK_USE_CG 0
#endif
#ifndef MK_DBG_MODE
#define MK_DBG_MODE 0
#endif
#ifndef MK_DBG_WHICH
#define MK_DBG_WHICH 0
#endif
extern "C" void kernel_launch(void* const* d_in, const int* in_sizes, int n_in, void* d_out, int out_size, void* d_ws, size_t ws_size, hipStream_t stream) {
    static int grid = 0;
    if (grid == 0) {
        if (n_in != 28 || out_size != NTOK * DM || ws_size < WS_END) { fprintf(stderr, "kernel_launch: unexpected problem (n_in %d out %d ws %zu)\n", n_in, out_size, ws_size); grid = -1; return; }
        int dev = 0, cus = 0, per_cu = 0;
        if (hipGetDevice(&dev) != hipSuccess || hipDeviceGetAttribute(&cus, hipDeviceAttributeMultiprocessorCount, dev) != hipSuccess) { grid = -1; return; }
        if (hipFuncSetAttribute((const void*)mk_fwd, hipFuncAttributeMaxDynamicSharedMemorySize, LDS_BYTES) != hipSuccess) { fprintf(stderr, "kernel_launch: hipFuncSetAttribute failed\n"); grid = -1; return; }
        if (hipOccupancyMaxActiveBlocksPerMultiprocessor(&per_cu, (const void*)mk_fwd, NWAVES * 64, LDS_BYTES) != hipSuccess || per_cu < 1) { fprintf(stderr, "kernel_launch: occupancy query says %d blocks per CU\n", per_cu); grid = -1; return; }
        (void)hipGetLastError();
        if (cus != 256) { fprintf(stderr, "kernel_launch: built for a 256-CU device (role split and unit counts), found %d CUs\n", cus); grid = -1; return; }
        grid = cus;
    }
    if (grid < 0) return;
    (void)hipMemsetAsync((char*)d_ws + WS_CTL, 0, CTL_ZERO_BYTES, stream);
    Args a{};
    for (int i = 0; i < 28; ++i) a.in[i] = (const float*)d_in[i];
    a.out = (float*)d_out; a.ws = (unsigned char*)d_ws; a.use_cg = MK_USE_CG; a.pad = 0;
#if MK_LAUNCHES == 1
    a.ph_lo = 0; a.ph_hi = N_PHASES;
    void* kargs[] = {&a};
#ifdef MK_PLAIN_LAUNCH
    (void)kargs; hipLaunchKernelGGL(mk_fwd, dim3(grid), dim3(NWAVES * 64), LDS_BYTES, stream, a); hipError_t e = hipPeekAtLastError();
#else
    hipError_t e = hipLaunchCooperativeKernel((const void*)mk_fwd, dim3(grid), dim3(NWAVES * 64), kargs, LDS_BYTES, stream);
#endif
    if (e != hipSuccess) fprintf(stderr, "kernel_launch: cooperative launch failed: %s (grid %d)\n", hipGetErrorString(e), grid);
#else
    a.use_cg = 0;
#ifdef MK_DEBUG
    const size_t R = dbg::DL; unsigned char* ws = (unsigned char*)d_ws;
    float* base = (float*)(ws + WS_DBG); size_t off = 0;
    auto take = [&](size_t nfloats) { float* p = base + off; off += (nfloats + 63) & ~(size_t)63; return p; };
    nv::Bufs B; B.nH = take(R * DM); B.nU = take(R * DM); B.nZ = take(R * 6144); B.nD = take(R * 1024); B.nP = take(R * 1024); B.nS0 = take(R * 1024); B.nT = take(R * 1024); B.nS = take(R * 1024);
    B.nYP = take(R * DM); B.nYS = take(R * DM); B.nV = take(R * DM); B.nMoe = take(R * DM); float* nOut = take(R * DM); B.eid = (int*)take(R * 2); B.gate = take(R * 2); B.logits = nullptr;
    if ((size_t)((char*)(base + off) - (char*)d_ws) > ws_size) { fprintf(stderr, "debug buffers do not fit\n"); return; }
    nv::Cfg c{1, 1, dbg::DL};
    nv::run(d_in, B, nOut, 0, c, stream);
    unsigned* res = (unsigned*)(ws + WS_CTL) + CW_DBG;
    const float* const* in = (const float* const*)d_in;
    int k = 0;
#define CMP(opt, isbf, old_, oc0, ref, rld, rc0, nc, kind, tr, tol) dbg::k_cmp<<<(unsigned)R, 256, 0, stream>>>((const void*)(opt), isbf, old_, oc0, ref, rld, rc0, nc, kind, tr, tol, res + 2 * (k++))
#define CWT(WT, ldt, W, W2, ldw, K, mode, nrows) dbg::k_cmp_wt<<<(unsigned)(nrows), 256, 0, stream>>>((const bf16_t*)(WT), ldt, W, W2, ldw, K, mode, 0.01f, res + 2 * (k++))
#endif
    for (int ph = 0; ph < N_PHASES; ++ph) {
        a.ph_lo = ph; a.ph_hi = ph + 1;
        hipLaunchKernelGGL(mk_fwd, dim3(grid), dim3(NWAVES * 64), LDS_BYTES, stream, a);
#ifdef MK_DEBUG
        if (ph == 0) {
            CMP(ws + WS_A1, 1, DM, 0, B.nU, DM, 0, DM, 0, 0, 0.01f);
            CMP(ws + WS_A1M, 1, DM, 0, B.nU, DM, 0, DM, 2, 0, 0.01f);
            CWT(ws + WS_WIN, DM, in[3], nullptr, INW, DM, 0, INW);
            CWT(ws + WS_POOLW + 2 * 65536 * 2, 256, in[4] + 2 * 65536, nullptr, 256, 256, 0, 256);
            CWT(ws + WS_WGLU, SW, in[14], nullptr, SW, SW, 0, SW);
            CWT(ws + WS_WBP, PW, in[16], nullptr, DM, PW, 0, DM);
            CWT(ws + WS_WBS, SW, in[17], nullptr, DM, SW, 0, DM);
            CWT(ws + WS_WOUT, DM, in[18], nullptr, DM, DM, 0, DM);
            CWT(ws + WS_WGU + (size_t)37 * 1024 * DM * 2, DM, in[24] + (size_t)37 * DM * FF, in[25] + (size_t)37 * DM * FF, FF, DM, 1, 1024);
            CWT(ws + WS_WD + (size_t)37 * DM * FF * 2, FF, in[26] + (size_t)37 * FF * DM, nullptr, DM, FF, 0, DM);
        }
        if (ph == 1) {
            CMP(ws + WS_ZP, 1, PW, 0, B.nZ, 6144, 0, 1024, 0, 0, 0.03f);
            CMP(ws + WS_ZP, 1, PW, 0, B.nZ, 6144, 0, 1024, 3, 0, 0.03f);
            CMP(ws + WS_ZS, 1, SW, 0, B.nZ, 6144, 1024, 1024, 0, 0, 0.03f);
            CMP(ws + WS_ZS, 1, SW, 0, B.nZ, 6144, 1024, 1024, 3, 0, 0.03f);
            CMP(ws + WS_GP, 1, DM, 0, B.nZ, 6144, 2048, 2048, 0, 1, 0.03f);
            CMP(ws + WS_GS, 1, DM, 0, B.nZ, 6144, 4096, 2048, 0, 1, 0.03f);
        }
        if (ph == 2) { CMP(ws + WS_DD, 1, PW, 0, B.nD, 1024, 0, 1024, 0, 0, 0.05f); }
        if (ph == 3) { CMP(ws + WS_PP, 1, PW, 0, B.nP, 1024, 0, 1024, 0, 0, 0.05f);
                       CMP(ws + WS_S0, 1, SW, 0, B.nS0, 1024, 0, 1024, 0, 0, 0.05f); }
        if (ph == 4) { CMP(ws + WS_SS, 1, SW, 0, B.nS, 1024, 0, 1024, 0, 0, 0.05f); }
        if (ph == 5) { CMP(ws + WS_MP, 1, DM, 0, B.nYP, DM, 0, DM, 0, 0, 0.06f); }
        if (ph == 7) { CMP(ws + WS_V, 1, DM, 0, B.nH, DM, 0, DM, 0, 0, 0.03f); }
        if (ph == 9) { dbg::k_cmp_moe<<<(unsigned)R, 256, 0, stream>>>((const bf16_t*)(ws + WS_YB), B.nMoe, 0.08f, res + 2 * (k++)); }
        if (ph == 10) { CMP(d_out, 0, DM, 0, nOut, DM, 0, DM, 0, 0, 0.03f); }
#endif
    }
#ifdef MK_DEBUG
#undef CMP
#undef CWT
    dbg::k_finalize<<<1024, 256, 0, stream>>>((float*)d_out, (size_t)NTOK * DM, res, k, MK_DBG_MODE, MK_DBG_WHICH);
#endif
#endif
}
```

```cpp
#include <hip/hip_runtime.h>
#include <hip/hip_cooperative_groups.h>
#include <cstdio>
#include <cstdint>
namespace cg = cooperative_groups;

#define GAS __attribute__((address_space(1)))
#define LAS __attribute__((address_space(3)))
typedef unsigned short bf16_t;
typedef short bf16x8 __attribute__((ext_vector_type(8)));
typedef float f32x4 __attribute__((ext_vector_type(4)));
typedef float f32x16 __attribute__((ext_vector_type(16)));
typedef float f32x2 __attribute__((ext_vector_type(2)));
typedef unsigned u32x4 __attribute__((ext_vector_type(4)));
typedef unsigned u32x2 __attribute__((ext_vector_type(2)));
typedef __bf16 bf16x2v __attribute__((ext_vector_type(2)));
#define DI __device__ __forceinline__
#define RLX_AGENT __ATOMIC_RELAXED, __HIP_MEMORY_SCOPE_AGENT
#define LDS_WAIT() asm volatile("s_waitcnt lgkmcnt(0)" ::: "memory")
#define VM_WAIT() asm volatile("s_waitcnt vmcnt(0)" ::: "memory")

DI unsigned pk2(float lo, float hi) { f32x2 v = {lo, hi}; bf16x2v r = __builtin_convertvector(v, bf16x2v); return __builtin_bit_cast(unsigned, r); }
DI float bflo(unsigned w) { return __uint_as_float(w << 16); }
DI float bfhi(unsigned w) { return __uint_as_float(w & 0xffff0000u); }
DI float fsigm(float x) { return __builtin_amdgcn_rcpf(1.f + __builtin_amdgcn_exp2f(-1.4426950408889634f * x)); }
DI float gelu_t(float x) { const float z = 1.5957691216057308f * (x + 0.044715f * x * x * x); return x * fsigm(z); }
DI float wave_sum(float v) {
#pragma unroll
    for (int o = 1; o < 64; o <<= 1) v += __shfl_xor(v, o);
    return v;
}

constexpr int DM = 2048, SEQ = 8192, NTOK = 16384, NMETA = 16, INW = 6144, PW = 1024, SW = 1024, FF = 512, NE = 64;
constexpr int NCH = 64, CHL = 128;
constexpr int LISTCAP = 16384;
constexpr int HH_ROWS = 49152;
constexpr float RMS_EPS = 1e-6f;
constexpr size_t MiB = 1u << 20;
constexpr size_t WS_CTL = 0, CTL_ZERO_BYTES = 1 * MiB;
constexpr size_t WS_LAM = 1 * MiB, WS_LAMP = WS_LAM + 65536, WS_BCAT = WS_LAM + 262144, WS_CCATT = WS_LAM + 524288, WS_WRH = WS_LAM + 786432, WS_WRL = WS_WRH + 393216,
                 WS_A1M = WS_WRL + 393216, WS_SCR = WS_A1M + 65536, WS_RSTD1 = WS_SCR + 65536, WS_IG = WS_RSTD1 + 65536, WS_E = 3 * MiB, WS_LIST = 8 * MiB;
constexpr size_t WS_WIN = 24 * MiB, WS_POOLW = 48 * MiB, WS_WGLU = 49 * MiB, WS_WBP = 51 * MiB, WS_WBS = 55 * MiB, WS_WOUT = 59 * MiB, WS_WGU = 68 * MiB, WS_WD = 324 * MiB;
constexpr size_t WS_A1 = 452 * MiB, WS_V = WS_A1;
constexpr size_t WS_ZP = 516 * MiB, WS_ZS = 549 * MiB, WS_DD = 582 * MiB, WS_PP = 614 * MiB, WS_S0 = 646 * MiB, WS_SS = 678 * MiB, WS_HH = 516 * MiB, WS_DL = WS_DD;
constexpr size_t WS_GP = 710 * MiB, WS_GS = 774 * MiB, WS_YB = 710 * MiB, WS_MP = 838 * MiB, WS_DBG = 902 * MiB, WS_END = 1024 * MiB;
static_assert(WS_IG + 8192 <= WS_E && WS_E + (size_t)64 * 64 * 64 * 16 <= WS_LIST && WS_LIST + (size_t)NE * LISTCAP * 16 <= WS_WIN, "small region");
static_assert(WS_HH + (size_t)HH_ROWS * FF * 2 <= WS_GP && WS_YB + (size_t)32768 * DM * 2 <= WS_MP, "overlays");
constexpr int CW_BAR = 4096;
constexpr int CW_BAR2 = 8192;
constexpr int CW_CNT = 16384;
constexpr int CW_DBG = 20480;
constexpr int CW_Q = 24576;

#define XB_TMO      128
#define XB_XCNT(j)  (256  + 64 * (j))
#define XB_XSUB(j)  (1280 + 64 * (j))
#define XB_XGEN(j)  (2304 + 64 * (j))
#define XB_TOP      3328
#define XB_TOPGEN   3392
#define XCD_BAR_WORDS 3456
#define XB_SPIN_CAP (1u << 18)
DI unsigned xb_ld(unsigned* p)              { return __hip_atomic_load(p, __ATOMIC_RELAXED, __HIP_MEMORY_SCOPE_AGENT); }
DI unsigned xb_add(unsigned* p, unsigned v) { return __hip_atomic_fetch_add(p, v, __ATOMIC_RELAXED, __HIP_MEMORY_SCOPE_AGENT); }
DI unsigned xb_xcc_id() { return (unsigned)__builtin_amdgcn_s_getreg((3 << 11) | 20) & 0xFu; }
#define XB_SPIN(cond, bar) do { unsigned _sp = 0; while (cond) { __builtin_amdgcn_s_sleep(1); \
    if ((++_sp & 255u) == 0u) { if (xb_ld(&(bar)[XB_TMO])) break; if (_sp > XB_SPIN_CAP) { atomicAdd(&(bar)[XB_TMO], 1u); break; } } } } while (0)
struct XcdBarrier { unsigned* bar; unsigned x; volatile LAS unsigned* st; unsigned expected; };
DI XcdBarrier xcd_barrier_post(unsigned* bar, volatile LAS unsigned* st, unsigned expected) {
    XcdBarrier b; b.bar = bar; b.x = xb_xcc_id(); b.st = st; b.expected = expected;
    if (threadIdx.x == 0) (void)xb_add(&bar[XB_XCNT(b.x)], 1u);
    return b;
}
DI void xcd_barrier_complete(unsigned* bar, unsigned x, unsigned& nloc, unsigned& nx, unsigned G) {
    unsigned sum, cnt, mine, sp = 0u;
    for (;;) {
        sum = 0u; cnt = 0u; mine = 0u;
#pragma unroll
        for (unsigned j = 0; j < 16; ++j) { const unsigned c = xb_ld(&bar[XB_XCNT(j)]); sum += c; cnt += (c > 0u) ? 1u : 0u; mine = (j == x) ? c : mine; }
        if (sum == G) break;
        __builtin_amdgcn_s_sleep(1);
        if ((++sp & 255u) == 0u) { if (xb_ld(&bar[XB_TMO])) break; if (sp > XB_SPIN_CAP) { atomicAdd(&bar[XB_TMO], 1u); break; } }
    }
    nloc = mine > 0u ? mine : 1u; nx = cnt > 0u ? cnt : 1u;
}
DI void xcd_barrier(const XcdBarrier& b) {
    asm volatile("s_waitcnt vmcnt(0)" ::: "memory");
    __syncthreads();
    if (threadIdx.x == 0) {
        unsigned* bar = b.bar;
        __builtin_amdgcn_s_waitcnt(0);
        unsigned nloc = b.st[0], nx = b.st[1];
        if (nloc == 0u) { xcd_barrier_complete(bar, b.x, nloc, nx, b.expected); b.st[0] = nloc; b.st[1] = nx; }
        const unsigned old = xb_add(&bar[XB_XSUB(b.x)], 1u);
        const unsigned gen = old / nloc;
        if (old + 1u == (gen + 1u) * nloc) {
            __builtin_amdgcn_fence(__ATOMIC_RELEASE, "agent");
            asm volatile("s_waitcnt vmcnt(0)" ::: "memory");
            const unsigned og = xb_add(&bar[XB_TOP], 1u);
            const unsigned tg = og / nx;
            if (og + 1u == (tg + 1u) * nx) xb_add(&bar[XB_TOPGEN], 1u);
            else XB_SPIN(xb_ld(&bar[XB_TOPGEN]) == tg, bar);
            __builtin_amdgcn_fence(__ATOMIC_ACQUIRE, "agent");
            xb_add(&bar[XB_XGEN(b.x)], 1u);
            asm volatile("s_waitcnt vmcnt(0)" ::: "memory");
        } else {
            XB_SPIN(xb_ld(&bar[XB_XGEN(b.x)]) == gen, bar);
            __builtin_amdgcn_fence(__ATOMIC_ACQUIRE, "agent");
            asm volatile("s_waitcnt vmcnt(0)" ::: "memory");
        }
    }
    __syncthreads();
}

namespace pg8 {
constexpr int BM = 256, BK = 64, HALF = 128, HTB = HALF * BK * 2, STAGE_BYTES = 8 * HTB, NXCD = 8, WGM = 8;
__host__ __device__ __forceinline__ int lds_byte(int r, int c) { const int st = (r >> 4) * 2 + (c >> 5), rr = r & 15, cc = c & 31, ob = rr * 64 + cc * 2; return st * 1024 + (ob ^ (((ob >> 9) & 1) << 5)); }
__host__ __device__ __forceinline__ void stage_rc(int b, int& R, int& C) { const int st = b / 1024, sb = b % 1024, swz = sb ^ (((sb >> 9) & 1) << 5); R = (st >> 1) * 16 + swz / 64; C = (st & 1) * 32 + (swz % 64) / 2; }
__host__ __device__ __forceinline__ int perm32(int rho) { const int n = rho >> 4, i = rho & 15; return 8 * (i >> 2) + 4 * n + (i & 3); }

struct Unit { const char* A; const char* B; int pm, pn, e, cnt; const uint4* list; };
struct Gemm { int lda, ldb, K; };

struct GridOrder {
    int nM, nN, nwg, G, c;
    DI void init(int nM_, int nN_, int G_, int c_) { nM = nM_; nN = nN_; nwg = nM * nN; G = G_; c = c_; }
    DI bool tile(int i, int& pm, int& pn) const {
        const long L = (long)i * G + c; if (L >= nwg) return false;
        int wgid = (int)L; { const int q = nwg / NXCD, r = nwg % NXCD, xcd = wgid % NXCD, off = wgid / NXCD; wgid = (xcd < r ? xcd * (q + 1) : r * (q + 1) + (xcd - r) * q) + off; }
        const int nig = WGM * nN, gid = wgid / nig, fm = gid * WGM, gsz = (nM - fm) < WGM ? (nM - fm) : WGM;
        pm = fm + ((wgid % nig) % gsz); pn = (wgid % nig) / gsz; return true;
    }
};
struct DenseOrder : GridOrder {
    static constexpr bool GATHER = false;
    const char* A; const char* Bt; size_t tstepA, tstepB;
    DI void setup(const void* A_, const void* Bt_, int M, int N, int lda, int ldb, int G_, int c_) { init(M / BM, N / BM, G_, c_); A = (const char*)A_; Bt = (const char*)Bt_; tstepA = (size_t)BM * lda * 2; tstepB = (size_t)BM * ldb * 2; }
    DI bool next(int i, Unit& u) const { int pm, pn; if (!tile(i, pm, pn)) return false; u.pm = pm; u.pn = pn; u.e = 0; u.cnt = 256; u.list = nullptr; u.A = A + (size_t)pm * tstepA; u.B = Bt + (size_t)pn * tstepB; return true; }
};

constexpr int SIDE_I_GU = 64 * 32 * 16, SIDE_I_DN = 64 * 8 * 64, SIDE_ITEMS = 2 * SIDE_I_GU + SIDE_I_DN;
struct SideNone { static constexpr bool ON = false; };
struct SideConv {
    static constexpr bool ON = true;
    const float *wg, *wu, *wd; bf16_t *WGU, *WD, *scratch; LAS unsigned char* xb;
    int next, end, stride;
    bf16_t* dst0; bf16_t* dst1; int ldt0, ldt1;
    DI void init(const float* wg_, const float* wu_, const float* wd_, bf16_t* WGU_, bf16_t* WD_, bf16_t* scratch_, LAS unsigned char* xb_, int begin, int end_, int stride_) {
        wg = wg_; wu = wu_; wd = wd_; WGU = WGU_; WD = WD_; scratch = scratch_; xb = xb_; next = begin; end = end_; stride = stride_; dst0 = scratch_; dst1 = scratch_; ldt0 = 0; ldt1 = 0; }
    template <int SLOT> DI void issue(int wid, int lane) {
#ifndef SIDE_PROBE
#define SIDE_PROBE 0
#endif
        int idx = next; bool valid = idx < end; if (valid) next += stride; else idx = 0;
        if (SIDE_PROBE == 2) idx = 0;
        const float* W; int ldw, k0, n0, ldt, drow0; bf16_t* WT;
        if (idx < 2 * SIDE_I_GU) { const int up = idx / SIDE_I_GU, q = idx % SIDE_I_GU, e = q >> 9, q2 = q & 511, kb = q2 >> 4, nb = q2 & 15; n0 = 32 * nb; k0 = 64 * kb;
            W = (up ? wu : wg) + (size_t)e * 2048 * 512; ldw = 512; WT = WGU + (size_t)e * 1024 * 2048; ldt = 2048; drow0 = (n0 >> 7) * 256 + (n0 & 127) + up * 128; }
        else { const int r = idx - 2 * SIDE_I_GU, e = r >> 9, q2 = r & 511, kb = q2 >> 6, nb = q2 & 63; n0 = 32 * nb; k0 = 64 * kb;
            W = wd + (size_t)e * 512 * 2048; ldw = 2048; WT = WD + (size_t)e * 2048 * 512; ldt = 512; drow0 = n0; }
        const float* src = W + (size_t)(k0 + 8 * wid + (lane >> 3)) * ldw + n0 + (lane & 7) * 4;
        __builtin_amdgcn_global_load_lds((const unsigned*)src, (LAS unsigned*)(xb + SLOT * 8192 + wid * 1024), 16, 0, 0);
        if (SIDE_PROBE == 1 || SIDE_PROBE == 2) valid = false;
        bf16_t* d = valid ? WT + (size_t)drow0 * ldt + k0 : scratch; const int l2 = valid ? ldt : 0;
        if (SLOT == 0) { dst0 = d; ldt0 = l2; } else { dst1 = d; ldt1 = l2; }
    }
    template <int SLOT> DI void read(int tid, f32x4& v) const {
        const LAS float* xf = (const LAS float*)(xb + SLOT * 8192) + (tid >> 5) * 128 + (tid & 31);
        v[0] = xf[0]; v[1] = xf[32]; v[2] = xf[64]; v[3] = xf[96];
    }
    template <int SLOT> DI void store(int tid, const f32x4& v) const {
        bf16_t* d = (SLOT == 0 ? dst0 : dst1) + (size_t)(tid & 31) * (SLOT == 0 ? ldt0 : ldt1) + 4 * (tid >> 5);
        u32x2 w; w.x = pk2(v[0], v[1]); w.y = pk2(v[2], v[3]); *(u32x2*)d = w;
    }
};

template <class Epi, class Sched, bool ALIGN_EPI = false, bool SP2 = true, class Side = SideNone>
__device__ __forceinline__ void gemm_phase(LAS unsigned char* lds, const Gemm g, const Sched& S, const Epi& E, Side side = Side()) {
    const int tid = threadIdx.x, wid = __builtin_amdgcn_readfirstlane(tid >> 6), lane = tid & 63, wr = wid >> 2, wc = wid & 3, fr = lane & 15, fq = lane >> 4;
    const int K = g.K, nt = K / BK;
    unsigned voffB[2], oA0[2], oA1[2], nA0[2], nA1[2]; int sR[2], sC[2];
    const size_t kstep = (size_t)(BK * 2);
    const unsigned hstepA = (unsigned)HALF * g.lda * 2u; const size_t hstepB = (size_t)HALF * g.ldb * 2;
#pragma unroll
    for (int i = 0; i < 2; ++i) { int R, C; stage_rc(tid * 16 + i * 8192, R, C); const int Rb = Epi::PERM ? ((R & ~31) + perm32(R & 31)) : R; sR[i] = R; sC[i] = C;
        voffB[i] = (unsigned)(Rb * g.ldb + C) * 2u; oA0[i] = (unsigned)(R * g.lda + C) * 2u; oA1[i] = oA0[i] + hstepA; nA0[i] = oA0[i]; nA1[i] = oA1[i]; }
    const unsigned ldsw = (unsigned)wid * 1024u;
    const int aoff = lds_byte(wr * 64 + fr, fq * 8), boff = lds_byte(wc * 32 + fr, fq * 8);
#define PG8_SA(b, h) (((b) * 2 + (h)) * HTB)
#define PG8_SB(b, h) ((4 + (b) * 2 + (h)) * HTB)
#define PG8_STAGE(bufoff, gbase, voff) do { _Pragma("unroll") for (int _i = 0; _i < 2; ++_i) \
        __builtin_amdgcn_global_load_lds((const unsigned*)((const char*)(gbase) + (voff)[_i]), (LAS unsigned*)(lds + (bufoff) + ldsw + _i * 8192), 16, 0, 0); } while (0)
#define PG8_LDA(dst, b, h) do { _Pragma("unroll") for (int m = 0; m < 4; ++m) _Pragma("unroll") for (int k = 0; k < 2; ++k) dst[m][k] = *(const LAS bf16x8*)(lds + PG8_SA(b, h) + aoff + m * 2048 + k * 1024); } while (0)
#define PG8_LDB(dst, b, h) do { _Pragma("unroll") for (int n = 0; n < 2; ++n) _Pragma("unroll") for (int k = 0; k < 2; ++k) dst[n][k] = *(const LAS bf16x8*)(lds + PG8_SB(b, h) + boff + n * 2048 + k * 1024); } while (0)
#define PG8_MMA(ai, bj, At, Bt) do { __builtin_amdgcn_s_setprio(1); _Pragma("unroll") for (int m = 0; m < 4; ++m) _Pragma("unroll") for (int n = 0; n < 2; ++n) _Pragma("unroll") for (int k = 0; k < 2; ++k) \
        acc[ai][bj][m][n] = __builtin_amdgcn_mfma_f32_16x16x32_bf16(Bt[n][k], At[m][k], acc[ai][bj][m][n], 0, 0, 0); __builtin_amdgcn_s_setprio(0); } while (0)
#define PG8_WAIT_V(n) asm volatile("s_waitcnt vmcnt(" #n ")" ::: "memory")
#define PG8_WAIT_L(n) asm volatile("s_waitcnt lgkmcnt(" #n ")" ::: "memory")
#define PG8_BAR __builtin_amdgcn_s_barrier()
#define PG8_SCHED __builtin_amdgcn_sched_barrier(0)
#define PG8_GOFF(u, d0, d1) do { _Pragma("unroll") for (int _i = 0; _i < 2; ++_i) { \
        const unsigned _t0 = (u).list[sR[_i]].x, _t1 = (u).list[HALF + sR[_i]].x; d0[_i] = (_t0 * (unsigned)g.lda + (unsigned)sC[_i]) * 2u; d1[_i] = (_t1 * (unsigned)g.lda + (unsigned)sC[_i]) * 2u; } } while (0)
    Unit cur, nxt; int ui = 0;
    if (!S.next(0, cur)) return;
    f32x4 acc[2][2][4][2];
#pragma unroll
    for (int a = 0; a < 2; ++a)
#pragma unroll
        for (int b = 0; b < 2; ++b)
#pragma unroll
            for (int m = 0; m < 4; ++m)
#pragma unroll
                for (int n = 0; n < 2; ++n) acc[a][b][m][n] = (f32x4){0.f, 0.f, 0.f, 0.f};
    bf16x8 At[4][2], B0[2][2], B1[2][2];
    const char* cA = cur.A; const char* cB = cur.B;
    if constexpr (Sched::GATHER) { PG8_GOFF(cur, oA0, oA1); }
    if constexpr (SP2) {
        PG8_STAGE(PG8_SB(0, 0), cB, voffB); PG8_STAGE(PG8_SB(0, 1), cB + hstepB, voffB); PG8_STAGE(PG8_SA(0, 0), cA, oA0); PG8_STAGE(PG8_SA(0, 1), cA, oA1);
        if (wr == 1) PG8_BAR;
        PG8_WAIT_V(2); PG8_BAR;
        PG8_STAGE(PG8_SB(1, 0), cB + kstep, voffB); PG8_STAGE(PG8_SA(1, 0), cA + kstep, oA0); PG8_STAGE(PG8_SB(1, 1), cB + hstepB + kstep, voffB);
        PG8_WAIT_V(6); PG8_BAR;
    } else {
        PG8_STAGE(PG8_SB(0, 0), cB, voffB); PG8_STAGE(PG8_SA(0, 0), cA, oA0); PG8_STAGE(PG8_SB(0, 1), cB + hstepB, voffB); PG8_STAGE(PG8_SA(0, 1), cA, oA1);
        if (wr == 1) PG8_BAR;
        PG8_WAIT_V(4); PG8_BAR;
        PG8_STAGE(PG8_SB(1, 0), cB + kstep, voffB); PG8_STAGE(PG8_SA(1, 0), cA + kstep, oA0); PG8_STAGE(PG8_SB(1, 1), cB + hstepB + kstep, voffB);
        PG8_WAIT_V(6); PG8_BAR;
    }
    for (;;) {
        const bool has_next = S.next(ui + 1, nxt);
        const char* nA = has_next ? nxt.A : cA; const char* nB = has_next ? nxt.B : cB;
        if constexpr (Sched::GATHER) { if (has_next) { PG8_GOFF(nxt, nA0, nA1); } else {
#pragma unroll
            for (int i = 0; i < 2; ++i) { nA0[i] = oA0[i]; nA1[i] = oA1[i]; } } }
#pragma nounroll
        for (int t = 0; t < nt; t += 2) {
            const bool last = (t == nt - 2);
            const char* a1 = cA + (size_t)(t + 1) * kstep;
            const char* a2 = last ? nA : cA + (size_t)(t + 2) * kstep; const char* b2 = last ? nB : cB + (size_t)(t + 2) * kstep;
            const char* a3 = a2 + kstep; const char* b3 = b2 + kstep;
            unsigned q0[2], q1[2];
#pragma unroll
            for (int i = 0; i < 2; ++i) { q0[i] = (Sched::GATHER && last) ? nA0[i] : oA0[i]; q1[i] = (Sched::GATHER && last) ? nA1[i] : oA1[i]; }
            if constexpr (SP2) {
            if constexpr (Side::ON) {
            f32x4 sv;
            PG8_LDB(B0, 0, 0); PG8_LDB(B1, 0, 1); PG8_SCHED; PG8_LDA(At, 0, 0); PG8_STAGE(PG8_SA(1, 1), a1, oA1); side.template read<0>(tid, sv);
            PG8_WAIT_V(9); PG8_WAIT_L(0); PG8_BAR; PG8_MMA(0, 0, At, B0); side.template store<0>(tid, sv); PG8_MMA(0, 1, At, B1); PG8_BAR; PG8_SCHED;
            PG8_LDA(At, 0, 1); PG8_STAGE(PG8_SB(0, 0), b2, voffB); PG8_STAGE(PG8_SB(0, 1), b2 + hstepB, voffB); PG8_STAGE(PG8_SA(0, 0), a2, q0);
            PG8_WAIT_V(9); PG8_WAIT_L(0); PG8_BAR; PG8_MMA(1, 0, At, B0); side.template issue<0>(wid, lane); PG8_MMA(1, 1, At, B1); PG8_BAR; PG8_SCHED;
            PG8_LDB(B0, 1, 0); PG8_LDB(B1, 1, 1); PG8_SCHED; PG8_LDA(At, 1, 0); PG8_STAGE(PG8_SA(0, 1), a2, q1); side.template read<1>(tid, sv);
            PG8_WAIT_V(9); PG8_WAIT_L(0); PG8_BAR; PG8_MMA(0, 0, At, B0); side.template store<1>(tid, sv); PG8_MMA(0, 1, At, B1); PG8_BAR; PG8_SCHED;
            PG8_LDA(At, 1, 1); PG8_STAGE(PG8_SB(1, 0), b3, voffB); PG8_STAGE(PG8_SB(1, 1), b3 + hstepB, voffB); PG8_STAGE(PG8_SA(1, 0), a3, q0);
            PG8_WAIT_V(9); PG8_WAIT_L(0); PG8_BAR; PG8_MMA(1, 0, At, B0); side.template issue<1>(wid, lane); PG8_MMA(1, 1, At, B1); PG8_BAR; PG8_SCHED;
            } else {
            PG8_LDB(B0, 0, 0); PG8_LDB(B1, 0, 1); PG8_SCHED; PG8_LDA(At, 0, 0); PG8_STAGE(PG8_SA(1, 1), a1, oA1);
            PG8_WAIT_V(8); PG8_WAIT_L(0); PG8_BAR; PG8_MMA(0, 0, At, B0); PG8_MMA(0, 1, At, B1); PG8_BAR; PG8_SCHED;
            PG8_LDA(At, 0, 1); PG8_STAGE(PG8_SB(0, 0), b2, voffB); PG8_STAGE(PG8_SB(0, 1), b2 + hstepB, voffB); PG8_STAGE(PG8_SA(0, 0), a2, q0);
            PG8_WAIT_V(8); PG8_WAIT_L(0); PG8_BAR; PG8_MMA(1, 0, At, B0); PG8_MMA(1, 1, At, B1); PG8_BAR; PG8_SCHED;
            PG8_LDB(B0, 1, 0); PG8_LDB(B1, 1, 1); PG8_SCHED; PG8_LDA(At, 1, 0); PG8_STAGE(PG8_SA(0, 1), a2, q1);
            PG8_WAIT_V(8); PG8_WAIT_L(0); PG8_BAR; PG8_MMA(0, 0, At, B0); PG8_MMA(0, 1, At, B1); PG8_BAR; PG8_SCHED;
            PG8_LDA(At, 1, 1); PG8_STAGE(PG8_SB(1, 0), b3, voffB); PG8_STAGE(PG8_SB(1, 1), b3 + hstepB, voffB); PG8_STAGE(PG8_SA(1, 0), a3, q0);
            PG8_WAIT_V(8); PG8_WAIT_L(0); PG8_BAR; PG8_MMA(1, 0, At, B0); PG8_MMA(1, 1, At, B1); PG8_BAR; PG8_SCHED;
            }
            } else {
            PG8_LDB(B0, 0, 0); PG8_SCHED; PG8_LDA(At, 0, 0); PG8_STAGE(PG8_SA(1, 1), a1, oA1);
            PG8_WAIT_L(8); PG8_BAR; PG8_WAIT_L(0); PG8_MMA(0, 0, At, B0); PG8_BAR; PG8_SCHED;
            PG8_LDB(B1, 0, 1); PG8_STAGE(PG8_SB(0, 0), b2, voffB);
            PG8_BAR; PG8_WAIT_L(0); PG8_MMA(0, 1, At, B1); PG8_BAR;
            PG8_LDA(At, 0, 1); PG8_STAGE(PG8_SA(0, 0), a2, q0);
            PG8_BAR; PG8_WAIT_L(0); PG8_MMA(1, 0, At, B0); PG8_BAR; PG8_SCHED;
            PG8_STAGE(PG8_SB(0, 1), b2 + hstepB, voffB);
            PG8_WAIT_V(6); PG8_BAR; PG8_MMA(1, 1, At, B1); PG8_BAR;
            PG8_LDB(B0, 1, 0); PG8_SCHED; PG8_LDA(At, 1, 0); PG8_STAGE(PG8_SA(0, 1), a2, q1);
            PG8_WAIT_L(8); PG8_BAR; PG8_WAIT_L(0); PG8_MMA(0, 0, At, B0); PG8_BAR; PG8_SCHED;
            PG8_LDB(B1, 1, 1); PG8_STAGE(PG8_SB(1, 0), b3, voffB);
            PG8_BAR; PG8_WAIT_L(0); PG8_MMA(0, 1, At, B1); PG8_BAR;
            PG8_LDA(At, 1, 1); PG8_STAGE(PG8_SA(1, 0), a3, q0);
            PG8_BAR; PG8_WAIT_L(0); PG8_MMA(1, 0, At, B0); PG8_BAR; PG8_SCHED;
            PG8_STAGE(PG8_SB(1, 1), b3 + hstepB, voffB);
            PG8_WAIT_V(6); PG8_BAR; PG8_MMA(1, 1, At, B1); PG8_BAR;
            }
        }
        if constexpr (ALIGN_EPI) { if (wr == 0) PG8_BAR; }
#ifndef PROBE_EPI2
#define PROBE_EPI2 0
#endif
        E(acc, cur, wr, wc, fr, fq);
        if (((PROBE_EPI2 >> Epi::EID) & 1) && Epi::IDEMPOTENT) { asm volatile("" ::: "memory"); E(acc, cur, wr, wc, fr, fq); }
        if (!has_next) break;
        if (!Epi::keep_acc(cur)) {
#pragma unroll
        for (int a = 0; a < 2; ++a)
#pragma unroll
            for (int b = 0; b < 2; ++b)
#pragma unroll
                for (int m = 0; m < 4; ++m)
#pragma unroll
                    for (int n = 0; n < 2; ++n) acc[a][b][m][n] = (f32x4){0.f, 0.f, 0.f, 0.f};
        }
        cur = nxt; cA = nA; cB = nB; ++ui;
        if constexpr (Sched::GATHER) {
#pragma unroll
            for (int i = 0; i < 2; ++i) { oA0[i] = nA0[i]; oA1[i] = nA1[i]; } }
        if constexpr (ALIGN_EPI) { if (wr == 1) PG8_BAR; }
    }
    PG8_WAIT_V(0);
    if constexpr (!ALIGN_EPI) { if (wr == 0) PG8_BAR; }
    PG8_BAR;
    if constexpr (Side::ON) { f32x4 s0, s1; side.template read<0>(tid, s0); side.template read<1>(tid, s1); PG8_WAIT_L(0); side.template store<0>(tid, s0); side.template store<1>(tid, s1); PG8_WAIT_V(0); PG8_BAR; }
#undef PG8_SA
#undef PG8_SB
#undef PG8_STAGE
#undef PG8_LDA
#undef PG8_LDB
#undef PG8_MMA
#undef PG8_WAIT_V
#undef PG8_WAIT_L
#undef PG8_BAR
#undef PG8_SCHED
#undef PG8_GOFF
}
}
#ifndef YB_FP8
#define YB_FP8 1
#endif
namespace pg8 {
#ifndef NT_STORES
#define NT_STORES 0
#endif
#if NT_STORES == 1
#define ST16(p, v) __builtin_nontemporal_store((v), (p))
#elif NT_STORES == 2
DI void st16_sc1(u32x4* p, const u32x4& v) { asm volatile("global_store_dwordx4 %0, %1, off sc1\n\ts_nop 1" :: "v"(p), "v"(v) : "memory"); }
#define ST16(p, v) st16_sc1((p), (v))
#else
#define ST16(p, v) (*(p) = (v))
#endif
typedef f32x4 Acc[2][2][4][2];
DI u32x4 pack8(const f32x4& v0, const f32x4& v1) { u32x4 w; w.x = pk2(v0[0], v0[1]); w.y = pk2(v0[2], v0[3]); w.z = pk2(v1[0], v1[1]); w.w = pk2(v1[2], v1[3]); return w; }
DI void unpack8(const u32x4& w, f32x4& v0, f32x4& v1) { v0 = (f32x4){bflo(w.x), bfhi(w.x), bflo(w.y), bfhi(w.y)}; v1 = (f32x4){bflo(w.z), bfhi(w.z), bflo(w.w), bfhi(w.w)}; }

DI unsigned pack_u8x4(const f32x4& g, float lo) { unsigned w = 0;
    w = __builtin_amdgcn_cvt_pk_u8_f32(fmaxf(__builtin_floorf(255.f * g[0] + 0.5f), lo), 0, w); w = __builtin_amdgcn_cvt_pk_u8_f32(fmaxf(__builtin_floorf(255.f * g[1] + 0.5f), lo), 1, w);
    w = __builtin_amdgcn_cvt_pk_u8_f32(fmaxf(__builtin_floorf(255.f * g[2] + 0.5f), lo), 2, w); w = __builtin_amdgcn_cvt_pk_u8_f32(fmaxf(__builtin_floorf(255.f * g[3] + 0.5f), lo), 3, w); return w; }
DI f32x4 unpack_u8x4(unsigned w) { return (f32x4){(float)(w & 0xffu), (float)((w >> 8) & 0xffu), (float)((w >> 16) & 0xffu), (float)(w >> 24)}; }
struct EpiZ {
    static DI bool keep_acc(const Unit&) { return false; }
    static constexpr bool PERM = true, IDEMPOTENT = true; static constexpr int EID = 0;
    bf16_t *ZP, *ZS; unsigned char *GP, *GS;
    DI void operator()(Acc& acc, const Unit& u, int wr, int wc, int fr, int fq) const {
        const int pn = u.pn; const int row0 = u.pm * BM + wr * 64 + fr;
        if (pn < 8) {
            bf16_t* base = pn < 4 ? ZP : ZS; const int col0 = (pn & 3) * 256 + wc * 32 + 8 * fq;
#pragma unroll
            for (int ai = 0; ai < 2; ++ai)
#pragma unroll
                for (int m = 0; m < 4; ++m) { bf16_t* rowp = base + (size_t)(row0 + ai * HALF + m * 16) * PW + col0;
#pragma unroll
                    for (int bj = 0; bj < 2; ++bj) ST16((u32x4*)(rowp + bj * HALF), pack8(acc[ai][bj][m][0], acc[ai][bj][m][1])); }
        } else {
            unsigned char* base = pn < 16 ? GP : GS; const float lo = pn < 16 ? 0.f : 1.f; const int col0 = (pn & 7) * 256 + wc * 32 + 8 * fq;
#pragma unroll
            for (int ai = 0; ai < 2; ++ai)
#pragma unroll
                for (int m = 0; m < 4; ++m) { unsigned char* rowp = base + (size_t)(row0 + ai * HALF + m * 16) * DM + col0;
#pragma unroll
                    for (int bj = 0; bj < 2; ++bj) { f32x4 v0 = acc[ai][bj][m][0], v1 = acc[ai][bj][m][1];
#pragma unroll
                        for (int j = 0; j < 4; ++j) { v0[j] = fsigm(v0[j]); v1[j] = fsigm(v1[j]); }
                        *(u32x2*)(rowp + bj * HALF) = (u32x2){pack_u8x4(v0, lo), pack_u8x4(v1, lo)}; } }
        }
    }
};
struct EpiPool {
    static DI bool keep_acc(const Unit&) { return false; }
    static constexpr bool PERM = true, IDEMPOTENT = true; static constexpr int EID = 1;
    bf16_t* PP; const float* scale;
    DI void operator()(Acc& acc, const Unit& u, int wr, int wc, int fr, int fq) const {
        const int row0 = u.pm * BM + wr * 64 + fr, col0 = u.pn * 256 + wc * 32 + 8 * fq;
        f32x4 sc[2][2];
#pragma unroll
        for (int bj = 0; bj < 2; ++bj) { sc[bj][0] = *(const f32x4*)(scale + col0 + bj * HALF); sc[bj][1] = *(const f32x4*)(scale + col0 + bj * HALF + 4); }
#pragma unroll
        for (int ai = 0; ai < 2; ++ai)
#pragma unroll
            for (int m = 0; m < 4; ++m) { bf16_t* rowp = PP + (size_t)(row0 + ai * HALF + m * 16) * PW + col0;
#pragma unroll
                for (int bj = 0; bj < 2; ++bj) *(u32x4*)(rowp + bj * HALF) = pack8(acc[ai][bj][m][0] * sc[bj][0], acc[ai][bj][m][1] * sc[bj][1]); }
    }
};
struct EpiGlu {
    static DI bool keep_acc(const Unit&) { return false; }
    static constexpr bool PERM = true, IDEMPOTENT = true; static constexpr int EID = 2;
    const bf16_t* S0; bf16_t* SS; const float* bias;
    DI void operator()(Acc& acc, const Unit& u, int wr, int wc, int fr, int fq) const {
        const int row0 = u.pm * BM + wr * 64 + fr, col0 = u.pn * 256 + wc * 32 + 8 * fq;
        f32x4 bv[2][2];
#pragma unroll
        for (int bj = 0; bj < 2; ++bj) { bv[bj][0] = *(const f32x4*)(bias + col0 + bj * HALF); bv[bj][1] = *(const f32x4*)(bias + col0 + bj * HALF + 4); }
#pragma unroll
        for (int ai = 0; ai < 2; ++ai) {
            u32x4 sw[4][2];
#pragma unroll
            for (int m = 0; m < 4; ++m)
#pragma unroll
                for (int bj = 0; bj < 2; ++bj) sw[m][bj] = *(const u32x4*)(S0 + (size_t)(row0 + ai * HALF + m * 16) * SW + col0 + bj * HALF);
#pragma unroll
            for (int m = 0; m < 4; ++m) { const size_t off = (size_t)(row0 + ai * HALF + m * 16) * SW + col0;
#pragma unroll
                for (int bj = 0; bj < 2; ++bj) { f32x4 s0, s1; unpack8(sw[m][bj], s0, s1);
                    f32x4 t0 = acc[ai][bj][m][0] + bv[bj][0], t1 = acc[ai][bj][m][1] + bv[bj][1];
#pragma unroll
                    for (int j = 0; j < 4; ++j) { t0[j] = s0[j] * fsigm(t0[j]); t1[j] = s1[j] * fsigm(t1[j]); }
                    *(u32x4*)(SS + off + bj * HALF) = pack8(t0, t1); } }
            asm volatile("" ::: "memory");
        }
    }
};
template <bool ADD> struct EpiGate {
    static DI bool keep_acc(const Unit&) { return false; }
    static constexpr bool PERM = true, IDEMPOTENT = !ADD; static constexpr int EID = 3;
    const bf16_t* G; bf16_t* MP;
    DI void operator()(Acc& acc, const Unit& u, int wr, int wc, int fr, int fq) const {
        const int row0 = u.pm * BM + wr * 64 + fr, col0 = u.pn * 256 + wc * 32 + 8 * fq;
#pragma unroll
        for (int ai = 0; ai < 2; ++ai)
#pragma unroll
            for (int m = 0; m < 4; ++m) { const size_t off = (size_t)(row0 + ai * HALF + m * 16) * DM + col0;
#pragma unroll
                for (int bj = 0; bj < 2; ++bj) { const u32x4 gw = *(const u32x4*)(G + off + bj * HALF); f32x4 g0, g1; unpack8(gw, g0, g1);
                    f32x4 t0 = acc[ai][bj][m][0] * g0, t1 = acc[ai][bj][m][1] * g1;
                    if (ADD) { const u32x4 pw = *(const u32x4*)(MP + off + bj * HALF); f32x4 p0, p1; unpack8(pw, p0, p1); t0 += p0; t1 += p1; }
                    *(u32x4*)(MP + off + bj * HALF) = pack8(t0, t1); } }
    }
};
struct EpiMerge {
    static DI bool keep_acc(const Unit& u) { return u.e == 0; }
    static constexpr bool PERM = true, IDEMPOTENT = false; static constexpr int EID = 8;
    const unsigned char* GP; const unsigned char* GS; bf16_t* MP;
    DI void operator()(Acc& acc, const Unit& u, int wr, int wc, int fr, int fq) const {
        const int row0 = u.pm * BM + wr * 64 + fr, col0 = u.pn * 256 + wc * 32 + 8 * fq;
        if (u.e == 0) {
#pragma unroll
            for (int ai = 0; ai < 2; ++ai) {
                u32x2 sw[4][2], pw[4][2];
#pragma unroll
                for (int m = 0; m < 4; ++m)
#pragma unroll
                    for (int bj = 0; bj < 2; ++bj) { const size_t off = (size_t)(row0 + ai * HALF + m * 16) * DM + col0 + bj * HALF; sw[m][bj] = *(const u32x2*)(GS + off); pw[m][bj] = *(const u32x2*)(GP + off); }
#pragma unroll
                for (int m = 0; m < 4; ++m)
#pragma unroll
                    for (int bj = 0; bj < 2; ++bj) { const f32x4 s0 = unpack_u8x4(sw[m][bj].x), s1 = unpack_u8x4(sw[m][bj].y), p0 = unpack_u8x4(pw[m][bj].x), p1 = unpack_u8x4(pw[m][bj].y);
#pragma unroll
                        for (int j = 0; j < 4; ++j) { acc[ai][bj][m][0][j] *= p0[j] * __builtin_amdgcn_rcpf(s0[j]); acc[ai][bj][m][1][j] *= p1[j] * __builtin_amdgcn_rcpf(s1[j]); } }
            }
        } else {
            constexpr float I255 = 1.f / 255.f;
#pragma unroll
            for (int ai = 0; ai < 2; ++ai) {
                u32x2 sw[4][2];
#pragma unroll
                for (int m = 0; m < 4; ++m)
#pragma unroll
                    for (int bj = 0; bj < 2; ++bj) sw[m][bj] = *(const u32x2*)(GS + (size_t)(row0 + ai * HALF + m * 16) * DM + col0 + bj * HALF);
#pragma unroll
                for (int m = 0; m < 4; ++m)
#pragma unroll
                    for (int bj = 0; bj < 2; ++bj) { const f32x4 s0 = unpack_u8x4(sw[m][bj].x) * I255, s1 = unpack_u8x4(sw[m][bj].y) * I255;
                        *(u32x4*)(MP + (size_t)(row0 + ai * HALF + m * 16) * DM + col0 + bj * HALF) = pack8(acc[ai][bj][m][0] * s0, acc[ai][bj][m][1] * s1); }
                asm volatile("" ::: "memory");
            }
        }
    }
};
struct MergeOrder : GridOrder {
    static constexpr bool GATHER = false;
    const char *A0, *B0, *A1, *B1; size_t tstepA, tstepB;
    DI bool next(int i, Unit& u) const { int pm, pn; if (!tile(i >> 1, pm, pn)) return false; const int h = i & 1; u.pm = pm; u.pn = pn; u.e = h; u.cnt = 256; u.list = nullptr;
        u.A = (h ? A1 : A0) + (size_t)pm * tstepA; u.B = (h ? B1 : B0) + (size_t)pn * tstepB; return true; }
};
struct EpiDelta {
    static DI bool keep_acc(const Unit&) { return false; }
    static constexpr bool PERM = true, IDEMPOTENT = true; static constexpr int EID = 4;
    bf16_t* DL;
    DI void operator()(Acc& acc, const Unit& u, int wr, int wc, int fr, int fq) const {
        const int row0 = u.pm * BM + wr * 64 + fr, col0 = u.pn * 256 + wc * 32 + 8 * fq;
#pragma unroll
        for (int ai = 0; ai < 2; ++ai)
#pragma unroll
            for (int m = 0; m < 4; ++m) { bf16_t* rowp = DL + (size_t)(row0 + ai * HALF + m * 16) * DM + col0;
#pragma unroll
                for (int bj = 0; bj < 2; ++bj) ST16((u32x4*)(rowp + bj * HALF), pack8(acc[ai][bj][m][0], acc[ai][bj][m][1])); }
    }
};
struct EpiH1 {
    static DI bool keep_acc(const Unit&) { return false; }
    static constexpr bool PERM = true, IDEMPOTENT = false; static constexpr int EID = 9;
    bf16_t* V; const float* rstd1; const float* ig;
    DI void operator()(Acc& acc, const Unit& u, int wr, int wc, int fr, int fq) const {
        const int row0 = u.pm * BM + wr * 64 + fr, col0 = u.pn * 256 + wc * 32 + 8 * fq;
        f32x4 g[2][2];
#pragma unroll
        for (int bj = 0; bj < 2; ++bj) { g[bj][0] = *(const f32x4*)(ig + col0 + bj * HALF); g[bj][1] = *(const f32x4*)(ig + col0 + bj * HALF + 4); }
#pragma unroll
        for (int ai = 0; ai < 2; ++ai) {
            u32x4 uw[4][2]; float inv[4];
#pragma unroll
            for (int m = 0; m < 4; ++m) { const int row = row0 + ai * HALF + m * 16; inv[m] = rstd1[row];
#pragma unroll
                for (int bj = 0; bj < 2; ++bj) uw[m][bj] = *(const u32x4*)(V + (size_t)row * DM + col0 + bj * HALF); }
#pragma unroll
            for (int m = 0; m < 4; ++m) { const float iv = __builtin_amdgcn_rcpf(inv[m]); bf16_t* rowp = V + (size_t)(row0 + ai * HALF + m * 16) * DM + col0;
#pragma unroll
                for (int bj = 0; bj < 2; ++bj) { f32x4 u0, u1; unpack8(uw[m][bj], u0, u1);
                    *(u32x4*)(rowp + bj * HALF) = pack8(u0 * g[bj][0] * iv + acc[ai][bj][m][0], u1 * g[bj][1] * iv + acc[ai][bj][m][1]); } }
            asm volatile("" ::: "memory");
        }
    }
};
struct EpiResid {
    static DI bool keep_acc(const Unit&) { return false; }
    static constexpr bool PERM = false, IDEMPOTENT = true; static constexpr int EID = 5;
    const float* X; float* H1;
    DI void operator()(Acc& acc, const Unit& u, int wr, int wc, int fr, int fq) const {
        const int row0 = u.pm * BM + wr * 64 + fr, col0 = u.pn * 256 + wc * 32 + 4 * fq;
#pragma unroll
        for (int ai = 0; ai < 2; ++ai)
#pragma unroll
            for (int m = 0; m < 4; ++m) { const size_t off = (size_t)(row0 + ai * HALF + m * 16) * DM + col0;
#pragma unroll
                for (int bj = 0; bj < 2; ++bj)
#pragma unroll
                    for (int n = 0; n < 2; ++n) { const f32x4 xv = *(const f32x4*)(X + off + bj * HALF + n * 16); *(f32x4*)(H1 + off + bj * HALF + n * 16) = xv + acc[ai][bj][m][n]; }
                asm volatile("" ::: "memory"); }
    }
};
struct EpiMoeUp {
    static DI bool keep_acc(const Unit&) { return false; }
    static constexpr bool PERM = true, IDEMPOTENT = true; static constexpr int EID = 6;
    bf16_t* HH;
    DI void operator()(Acc& acc, const Unit& u, int wr, int wc, int fr, int fq) const {
        const int col0 = u.pn * 128 + wc * 32 + 8 * fq;
        float rsv[2][4];
#pragma unroll
        for (int ai = 0; ai < 2; ++ai)
#pragma unroll
            for (int m = 0; m < 4; ++m) rsv[ai][m] = __uint_as_float(u.list[ai * HALF + wr * 64 + m * 16 + fr].w);
#pragma unroll
        for (int ai = 0; ai < 2; ++ai)
#pragma unroll
            for (int m = 0; m < 4; ++m) { const int r = ai * HALF + wr * 64 + m * 16 + fr; const float rs = rsv[ai][m];
                f32x4 g0 = acc[ai][0][m][0] * rs, g1 = acc[ai][0][m][1] * rs, u0 = acc[ai][1][m][0] * rs, u1 = acc[ai][1][m][1] * rs;
#pragma unroll
                for (int j = 0; j < 4; ++j) { g0[j] = g0[j] * fsigm(g0[j]) * u0[j]; g1[j] = g1[j] * fsigm(g1[j]) * u1[j]; }
                *(u32x4*)(HH + (size_t)(u.pm + r) * FF + col0) = pack8(g0, g1); }
    }
};
struct EpiMoeDown {
    static DI bool keep_acc(const Unit&) { return false; }
    static constexpr bool PERM = true, IDEMPOTENT = true; static constexpr int EID = 7;
    bf16_t* YB;
    DI void operator()(Acc& acc, const Unit& u, int wr, int wc, int fr, int fq) const {
        const int col0 = u.pn * 256 + wc * 32 + 8 * fq;
        unsigned dstv[2][4]; float wv[2][4];
#pragma unroll
        for (int ai = 0; ai < 2; ++ai)
#pragma unroll
            for (int m = 0; m < 4; ++m) { const uint4* le = u.list + (ai * HALF + wr * 64 + m * 16 + fr); dstv[ai][m] = le->y; wv[ai][m] = __uint_as_float(le->z); }
#pragma unroll
        for (int ai = 0; ai < 2; ++ai)
#pragma unroll
            for (int m = 0; m < 4; ++m) { const int r = ai * HALF + wr * 64 + m * 16 + fr;
#if YB_FP8
                if (r < u.cnt) { const float w = wv[ai][m] * 16.f; unsigned char* rowp = (unsigned char*)YB + (size_t)dstv[ai][m] * DM + col0;
#pragma unroll
                    for (int bj = 0; bj < 2; ++bj) { f32x4 a0 = acc[ai][bj][m][0] * w, a1 = acc[ai][bj][m][1] * w; int lo = 0, hi = 0;
#pragma unroll
                        for (int j = 0; j < 4; ++j) { a0[j] = __builtin_amdgcn_fmed3f(a0[j], -416.f, 416.f); a1[j] = __builtin_amdgcn_fmed3f(a1[j], -416.f, 416.f); }
                        lo = __builtin_amdgcn_cvt_pk_fp8_f32(a0[0], a0[1], lo, false); lo = __builtin_amdgcn_cvt_pk_fp8_f32(a0[2], a0[3], lo, true);
                        hi = __builtin_amdgcn_cvt_pk_fp8_f32(a1[0], a1[1], hi, false); hi = __builtin_amdgcn_cvt_pk_fp8_f32(a1[2], a1[3], hi, true);
                        *(u32x2*)(rowp + bj * HALF) = (u32x2){(unsigned)lo, (unsigned)hi}; } } }
#else
                if (r < u.cnt) { const float w = wv[ai][m]; bf16_t* rowp = YB + (size_t)dstv[ai][m] * DM + col0;
#pragma unroll
                    for (int bj = 0; bj < 2; ++bj) ST16((u32x4*)(rowp + bj * HALF), pack8(acc[ai][bj][m][0] * w, acc[ai][bj][m][1] * w)); } }
#endif
    }
};

struct MoeOrder {
    static constexpr bool GATHER_UP = true;
    const volatile LAS int* tab; int ntn, G, vcu; const uint4* list; const char* Abase; const char* Bbase; size_t bstep_e, bstep_n, astep_row; bool up;
    DI bool decode(int i, Unit& u) const {
        const int U = i * G + vcu; const int lane = threadIdx.x & 63;
        const int total = tab[64];
        if (U >= total) return false;
        const int ce = tab[lane + 1];
        const unsigned long long m = __ballot(ce > U);
        const int e = __builtin_amdgcn_readfirstlane((int)__builtin_ctzll(m));
        const int loc = U - tab[e]; const int mb = loc / ntn, nb = loc % ntn;
        const int cnt = tab[160 + e] - mb * 256;
        u.e = e; u.cnt = cnt < 256 ? cnt : 256; u.pn = nb; u.pm = tab[80 + e] + mb * 256; u.list = list + (size_t)e * LISTCAP + mb * 256;
        u.B = Bbase + (size_t)e * bstep_e + (size_t)nb * bstep_n;
        u.A = up ? Abase : Abase + (size_t)u.pm * astep_row;
        return true;
    }
};
struct MoeUpOrder : MoeOrder { static constexpr bool GATHER = true; DI bool next(int i, Unit& u) const { return decode(i, u); } };
struct MoeDownOrder : MoeOrder { static constexpr bool GATHER = false; DI bool next(int i, Unit& u) const { return decode(i, u); } };
struct PoolOrder : GridOrder {
    static constexpr bool GATHER = false;
    const char* DD; const char* PWT;
    DI bool next(int i, Unit& u) const { int pm, pn; if (!tile(i, pm, pn)) return false; u.pm = pm; u.pn = pn; u.e = 0; u.cnt = 256; u.list = nullptr;
        u.A = DD + ((size_t)pm * 256 * PW + (size_t)pn * 256) * 2; u.B = PWT + (size_t)pn * 65536 * 2; return true; }
};
}
constexpr int NWAVES = 8;
constexpr int RING_BYTES = 131072, XB_OFF = RING_BYTES, MISC_OFF = RING_BYTES + 16384, TAB_OFF = MISC_OFF + 256;
constexpr int LDS_BYTES = RING_BYTES + 2048 + 16384;
#ifndef SIDE_P1
#define SIDE_P1 0
#endif
#ifndef SIDE_P56
#define SIDE_P56 0
#endif
using pg8::SIDE_ITEMS;
constexpr int SIDE_N1 = SIDE_P1 ? 192 * 256 : 0, SIDE_N5 = SIDE_P56 ? 32 * 256 : 0, SIDE_N6 = SIDE_P56 ? 64 * 256 : 0;
#ifndef SIDE_PROBE
#define SIDE_PROBE 0
#endif
#ifndef CONV_PAIRS
#define CONV_PAIRS 49152
#endif
#ifndef NCONV
#define NCONV 64
#endif
#ifndef CV_QFRAC
#define CV_QFRAC 25
#endif
#define CV_GRAB 16
#define CV_STATIC (((2 * CONV_PAIRS) * (100 - CV_QFRAC) / 100) / 512 * 512)
#ifndef TAIL_IN_P8
#define TAIL_IN_P8 0
#endif
constexpr int SIDE_TOTAL = NCONV ? (TAIL_IN_P8 ? SIDE_ITEMS : 2 * CONV_PAIRS) : (SIDE_PROBE ? 0 : SIDE_N1 + 2 * SIDE_N5 + SIDE_N6);
static_assert(!TAIL_IN_P8 || 2 * CONV_PAIRS >= 2 * 64 * 32 * 16, "gate/up weights must be complete before P8");
struct Args { const float* in[28]; float* out; unsigned char* ws; int ph_lo, ph_hi, use_cg, pad; };

struct Ctx {
    LAS unsigned char* lds; unsigned char* ws; int tid, lane, wave, vcu, G, gw, NGW;
};

#define MFMA16(a, b, c) __builtin_amdgcn_mfma_f32_16x16x32_bf16((a), (b), (c), 0, 0, 0)
#define MFMA32(a, b, c) __builtin_amdgcn_mfma_f32_32x32x16_bf16((a), (b), (c), 0, 0, 0)

struct TrItem { const float* W; bf16_t* WT; const float* rs; int ldw, ldt; };
#ifndef RT_AUX
#define RT_AUX 0
#endif
#ifndef FIN_ST_NT
#define FIN_ST_NT 0
#endif
#ifndef FIN_NT
#define FIN_NT 0
#endif
#ifndef P0_NT
#define P0_NT 1
#endif
#ifndef CV_NT
#define CV_NT 1
#endif
template <bool NT = false> DI void tr_load(const TrItem& t, f32x4 (&v)[8], int lane) {
#pragma unroll
    for (int i = 0; i < 8; ++i) { const f32x4* p = (const f32x4*)(t.W + (size_t)(8 * i + (lane >> 3)) * t.ldw + 4 * (lane & 7)); v[i] = NT ? __builtin_nontemporal_load(p) : *p; }
}
template <bool NT = false> DI void tr_finish(const TrItem& t, const f32x4 (&v)[8], LAS float* scr, int lane) {
#pragma unroll
    for (int i = 0; i < 8; ++i) { LAS float* s = scr + (8 * i + (lane >> 3)) * 33 + 4 * (lane & 7); s[0] = v[i].x; s[1] = v[i].y; s[2] = v[i].z; s[3] = v[i].w; }
    LDS_WAIT(); asm volatile("" ::: "memory");
    const int c = lane & 7;
    f32x4 g0 = {1.f, 1.f, 1.f, 1.f}, g1 = g0; if (t.rs) { g0 = *(const f32x4*)(t.rs + 8 * c); g1 = *(const f32x4*)(t.rs + 8 * c + 4); }
#pragma unroll
    for (int j = 0; j < 4; ++j) { const int n = (lane >> 3) + 8 * j; const LAS float* s = scr + (8 * c) * 33 + n;
        u32x4 o; o.x = pk2(s[0 * 33] * g0.x, s[1 * 33] * g0.y); o.y = pk2(s[2 * 33] * g0.z, s[3 * 33] * g0.w); o.z = pk2(s[4 * 33] * g1.x, s[5 * 33] * g1.y); o.w = pk2(s[6 * 33] * g1.z, s[7 * 33] * g1.w);
        if (NT) __builtin_nontemporal_store(o, (u32x4*)(t.WT + (size_t)n * t.ldt + 8 * c)); else *(u32x4*)(t.WT + (size_t)n * t.ldt + 8 * c) = o; }
    LDS_WAIT(); asm volatile("" ::: "memory");
}
DI void norm_regs_bf16(const f32x4 (&v)[8], const float* g, bf16_t* orow, int lane, float* rstd_out) {
    const f32x4* gr = (const f32x4*)g + lane; float s = 0.f;
#pragma unroll
    for (int j = 0; j < 8; ++j) s += (v[j].x * v[j].x + v[j].y * v[j].y) + (v[j].z * v[j].z + v[j].w * v[j].w);
    const float rstd = rsqrtf(wave_sum(s) * (1.f / DM) + RMS_EPS);
    if (rstd_out && lane == 0) *rstd_out = rstd;
    u32x2* o8 = (u32x2*)orow + lane;
#pragma unroll
    for (int j = 0; j < 8; ++j) { const f32x4 gg = gr[64 * j]; u32x2 w; w.x = pk2(v[j].x * rstd * gg.x, v[j].y * rstd * gg.y); w.y = pk2(v[j].z * rstd * gg.z, v[j].w * rstd * gg.w); o8[64 * j] = w; }
}
DI void norm_row_bf16(const float* xrow, const float* g, bf16_t* orow, int lane, float* rstd_out = nullptr) {
    const f32x4* xr = (const f32x4*)xrow + lane; const f32x4* gr = (const f32x4*)g + lane;
    f32x4 v[8]; float s = 0.f;
#pragma unroll
    for (int j = 0; j < 8; ++j) { v[j] = xr[64 * j]; s += (v[j].x * v[j].x + v[j].y * v[j].y) + (v[j].z * v[j].z + v[j].w * v[j].w); }
    const float rstd = rsqrtf(wave_sum(s) * (1.f / DM) + RMS_EPS);
    if (rstd_out && lane == 0) *rstd_out = rstd;
    u32x2* o8 = (u32x2*)orow + lane;
#pragma unroll
    for (int j = 0; j < 8; ++j) { const f32x4 gg = gr[64 * j]; u32x2 w; w.x = pk2(v[j].x * rstd * gg.x, v[j].y * rstd * gg.y); w.y = pk2(v[j].z * rstd * gg.z, v[j].w * rstd * gg.w); o8[64 * j] = w; }
}
DI void p0_prologue(const Ctx& C, const Args& a, int part = 3) {
    unsigned char* ws = C.ws;
    LAS float* scr = (LAS float*)(C.lds + C.wave * 8448);
    LAS float* scrB = (LAS float*)(C.lds + (C.wave < 7 ? 67584 + C.wave * 8448 : XB_OFF));
    constexpr int I_IN = 32 * 192, I_PW = 4 * 32, I_GLU = 16 * 32, I_BR = 16 * 64, I_OUT = 32 * 64, I_GU = 64 * 32 * 16, I_DN = 64 * 8 * 64;
    constexpr int NSMALL = I_IN + I_PW + I_GLU + 2 * I_BR + I_OUT;
    constexpr int NITEMS = NSMALL + (2 * I_GU + I_DN - SIDE_TOTAL);
    auto decode = [&](int it, TrItem& t) {
        int r = it < NSMALL ? it : it + SIDE_TOTAL;
        const float* W; bf16_t* WT; int ldw, ldt, k0, n0, drow0; bool gu = false;
        if (r < I_IN) { const int kb = r / 192, nb = r % 192; W = a.in[3]; ldw = INW; WT = (bf16_t*)(ws + WS_WIN); ldt = DM; k0 = 64 * kb; n0 = 32 * nb; drow0 = n0; }
        else if ((r -= I_IN) < I_PW) { const int g = r / 32, q = r % 32, kb = q / 8, nb = q % 8; W = a.in[4] + (size_t)g * 65536; ldw = 256; WT = (bf16_t*)(ws + WS_POOLW) + (size_t)g * 65536; ldt = 256; k0 = 64 * kb; n0 = 32 * nb; drow0 = n0; }
        else if ((r -= I_PW) < I_GLU) { const int kb = r / 32, nb = r % 32; W = a.in[14]; ldw = SW; WT = (bf16_t*)(ws + WS_WGLU); ldt = SW; k0 = 64 * kb; n0 = 32 * nb; drow0 = n0; }
        else if ((r -= I_GLU) < I_BR) { const int kb = r / 64, nb = r % 64; W = a.in[16]; ldw = DM; WT = (bf16_t*)(ws + WS_WBP); ldt = PW; k0 = 64 * kb; n0 = 32 * nb; drow0 = n0; }
        else if ((r -= I_BR) < I_BR) { const int kb = r / 64, nb = r % 64; W = a.in[17]; ldw = DM; WT = (bf16_t*)(ws + WS_WBS); ldt = SW; k0 = 64 * kb; n0 = 32 * nb; drow0 = n0; }
        else if ((r -= I_BR) < I_OUT) { const int kb = r / 64, nb = r % 64; W = a.in[18]; ldw = DM; WT = (bf16_t*)(ws + WS_WOUT); ldt = DM; k0 = 64 * kb; n0 = 32 * nb; drow0 = n0; }
        else if ((r -= I_OUT) < 2 * I_GU) { const int up = r / I_GU, q = r % I_GU, e = q / 512, q2 = q % 512, kb = q2 / 16, nb = q2 % 16; n0 = 32 * nb; k0 = 64 * kb;
            W = a.in[24 + up] + (size_t)e * DM * FF; ldw = FF; WT = (bf16_t*)(ws + WS_WGU) + (size_t)e * 1024 * DM; ldt = DM; drow0 = (n0 >> 7) * 256 + (n0 & 127) + up * 128; gu = true; }
        else { r -= 2 * I_GU; const int e = r / 512, q2 = r % 512, kb = q2 / 64, nb = q2 % 64; W = a.in[26] + (size_t)e * FF * DM; ldw = DM; WT = (bf16_t*)(ws + WS_WD) + (size_t)e * DM * FF; ldt = FF; k0 = 64 * kb; n0 = 32 * nb; drow0 = n0; }
        t.W = W + (size_t)k0 * ldw + n0; t.WT = WT + (size_t)drow0 * ldt + k0; t.ldw = ldw; t.ldt = ldt; t.rs = gu ? a.in[19] + k0 : nullptr;
    };
    const int it_lo = (part & 1) ? 0 : I_IN, it_hi = (part & 2) ? NITEMS : I_IN;
    for (int it = it_lo + C.gw; it < it_hi; it += 2 * C.NGW) {
        TrItem t0, t1; f32x4 v0[8], v1[8];
        const bool two = it + C.NGW < it_hi;
        decode(it, t0); tr_load<(P0_NT != 0)>(t0, v0, C.lane);
        decode(two ? it + C.NGW : it, t1); if (!two) { t1.WT = (bf16_t*)(ws + WS_SCR); t1.ldt = 64; } tr_load<(P0_NT != 0)>(t1, v1, C.lane);
        tr_finish(t0, v0, scr, C.lane);
        tr_finish(t1, v1, scrB, C.lane);
    }
    if (part & 1) {
        for (int m = 2 * C.gw; m < NTOK; m += 2 * C.NGW) {
            const f32x4* x0 = (const f32x4*)(a.in[0] + (size_t)m * DM) + C.lane; const f32x4* x1 = x0 + DM / 4;
            f32x4 v0[8], v1[8];
#pragma unroll
            for (int j = 0; j < 8; ++j) { v0[j] = P0_NT ? __builtin_nontemporal_load(x0 + 64 * j) : x0[64 * j]; v1[j] = P0_NT ? __builtin_nontemporal_load(x1 + 64 * j) : x1[64 * j]; }
            norm_regs_bf16(v0, a.in[2], (bf16_t*)(ws + WS_A1) + (size_t)m * DM, C.lane, (float*)(ws + WS_RSTD1) + m);
            norm_regs_bf16(v1, a.in[2], (bf16_t*)(ws + WS_A1) + (size_t)(m + 1) * DM, C.lane, (float*)(ws + WS_RSTD1) + m + 1);
        }
        for (int m = C.gw; m < NMETA; m += C.NGW) norm_row_bf16(a.in[1] + (size_t)m * DM, a.in[2], (bf16_t*)(ws + WS_A1M) + (size_t)m * DM, C.lane);
        for (int i = C.gw * 64 + C.lane; i < DM; i += C.NGW * 64) ((float*)(ws + WS_IG))[i] = 1.f / a.in[2][i];
    }
    if (!(part & 2)) return;
    for (int it = C.gw; it < 80 * DM / 64; it += C.NGW) { const int idx = it * 64 + C.lane, j = idx / DM, k = idx % DM;
        float w = 0.f; if (j < 8) w = a.in[20][k * 8 + j]; else if (j < 72) w = a.in[22][k * 64 + (j - 8)];
        w *= a.in[19][k];
        const unsigned hi = pk2(w, 0.f) & 0xffffu; const float lo = w - __uint_as_float(hi << 16);
        ((bf16_t*)(ws + WS_WRH))[idx] = (bf16_t)hi; ((bf16_t*)(ws + WS_WRL))[idx] = (bf16_t)(pk2(lo, 0.f) & 0xffffu); }
    for (int g = C.gw; g < 64; g += C.NGW) { const int n = C.lane;
        const float ar = a.in[6][g * 64 + n], ai = a.in[7][g * 64 + n], dt = expf(a.in[8][g]);
        const float mag = expf(ar * dt); float sn, cs; sincosf(ai * dt, &sn, &cs);
        const float lr = mag * cs, li = mag * sn, den = ar * ar + ai * ai, nr = lr - 1.f;
        const float cr = (nr * ar + li * ai) / den, ci = (li * ar - nr * ai) / den;
        ((f32x2*)(ws + WS_LAM))[g * 64 + n] = (f32x2){lr, li};
        float pr = lr, pi = li;
#pragma unroll
        for (int s = 0; s < 7; ++s) { const float t = pr * pr - pi * pi; pi = 2.f * pr * pi; pr = t; }
        ((f32x2*)(ws + WS_LAMP))[g * 64 + n] = (f32x2){pr, pi};
        bf16_t* bc = (bf16_t*)(ws + WS_BCAT) + (size_t)g * 128 * 16; bf16_t* cc = (bf16_t*)(ws + WS_CCATT) + (size_t)g * 16 * 128;
        unsigned rp[8], ip[8];
#pragma unroll
        for (int h = 0; h < 16; h += 2) { const float b0r = a.in[9][(g * 64 + n) * 16 + h], b0i = a.in[10][(g * 64 + n) * 16 + h], b1r = a.in[9][(g * 64 + n) * 16 + h + 1], b1i = a.in[10][(g * 64 + n) * 16 + h + 1];
            rp[h / 2] = pk2(cr * b0r - ci * b0i, cr * b1r - ci * b1i); ip[h / 2] = pk2(cr * b0i + ci * b0r, cr * b1i + ci * b1r); }
        *(u32x4*)(bc + (size_t)n * 16) = (u32x4){rp[0], rp[1], rp[2], rp[3]}; *(u32x4*)(bc + (size_t)n * 16 + 8) = (u32x4){rp[4], rp[5], rp[6], rp[7]};
        *(u32x4*)(bc + (size_t)(64 + n) * 16) = (u32x4){ip[0], ip[1], ip[2], ip[3]}; *(u32x4*)(bc + (size_t)(64 + n) * 16 + 8) = (u32x4){ip[4], ip[5], ip[6], ip[7]};
#pragma unroll
        for (int h = 0; h < 16; ++h) { cc[h * 128 + n] = (bf16_t)(pk2(a.in[11][(g * 16 + h) * 64 + n], 0.f) & 0xffffu); cc[h * 128 + 64 + n] = (bf16_t)(pk2(-a.in[12][(g * 16 + h) * 64 + n], 0.f) & 0xffffu); }
    }
    for (int it = C.gw; it < NE * LISTCAP / 64; it += C.NGW) ((u32x4*)(ws + WS_LIST))[(size_t)it * 64 + C.lane] = (u32x4){0u, 0u, 0u, 0u};
}

struct CvItem { const float* W; bf16_t* WT; int ldw, ldt, gk; };
DI void cv_decode(const Args& a, unsigned char* ws, int idx, CvItem& t) {
    constexpr int I_GU = 64 * 32 * 16;
    if (idx < 2 * I_GU) { const int up = idx / I_GU, q = idx % I_GU, e = q >> 9, q2 = q & 511, kb = q2 >> 4, nb = q2 & 15, n0 = 32 * nb, k0 = 64 * kb;
        t.W = a.in[24 + up] + (size_t)e * DM * FF + (size_t)k0 * FF + n0; t.ldw = FF; t.ldt = DM; t.gk = k0;
        t.WT = (bf16_t*)(ws + WS_WGU) + (size_t)e * 1024 * DM + (size_t)((n0 >> 7) * 256 + (n0 & 127) + up * 128) * DM + k0; }
    else { const int r = idx - 2 * I_GU, e = r >> 9, q2 = r & 511, kb = q2 >> 6, nb = q2 & 63, n0 = 32 * nb, k0 = 64 * kb;
        t.W = a.in[26] + (size_t)e * FF * DM + (size_t)k0 * DM + n0; t.ldw = DM; t.ldt = FF; t.gk = -1;
        t.WT = (bf16_t*)(ws + WS_WD) + (size_t)e * DM * FF + (size_t)n0 * FF + k0; }
}
DI void cv_issue(const Ctx& C, const Args& a, int idx, LAS unsigned char* slot) {
    CvItem t; cv_decode(a, C.ws, idx, t);
    const int l = C.lane, w = C.wave;
    const float* src = t.W + (size_t)(8 * w + (l >> 3)) * t.ldw + 4 * ((l & 7) ^ w);
    __builtin_amdgcn_global_load_lds((const unsigned*)src, (LAS unsigned*)(slot + 1024 * w), 16, 0, 0);
}
DI void cv_consume(const Ctx& C, const Args& a, int idx, const LAS unsigned char* slot, const LAS float* gl) {
    CvItem t; cv_decode(a, C.ws, idx, t);
    const int l = C.lane, c = l & 7, n = 8 * (C.wave & 3) + (l >> 3);
    const LAS float* xf = (const LAS float*)slot + (8 * c) * 32 + (((n >> 2) ^ c) << 2) + (n & 3);
    float v[8];
#pragma unroll
    for (int i = 0; i < 8; ++i) v[i] = xf[i * 32];
    if (t.gk >= 0) { const f32x4 g0 = *(const LAS f32x4*)(gl + t.gk + 8 * c), g1 = *(const LAS f32x4*)(gl + t.gk + 8 * c + 4);
        v[0] *= g0.x; v[1] *= g0.y; v[2] *= g0.z; v[3] *= g0.w; v[4] *= g1.x; v[5] *= g1.y; v[6] *= g1.z; v[7] *= g1.w; }
    u32x4 o; o.x = pk2(v[0], v[1]); o.y = pk2(v[2], v[3]); o.z = pk2(v[4], v[5]); o.w = pk2(v[6], v[7]);
    *(u32x4*)(t.WT + (size_t)n * t.ldt + 8 * c) = o;
}
DI void expert_item(const Args& a, unsigned char* ws, int idx, TrItem& t) {
    constexpr int I_GU = 64 * 32 * 16;
    if (idx < 2 * I_GU) { const int up = idx / I_GU, q = idx % I_GU, e = q >> 9, q2 = q & 511, kb = q2 >> 4, nb = q2 & 15, n0 = 32 * nb, k0 = 64 * kb;
        t.W = a.in[24 + up] + (size_t)e * DM * FF + (size_t)k0 * FF + n0; t.ldw = FF; t.ldt = DM; t.rs = a.in[19] + k0;
        t.WT = (bf16_t*)(ws + WS_WGU) + (size_t)e * 1024 * DM + (size_t)((n0 >> 7) * 256 + (n0 & 127) + up * 128) * DM + k0; }
    else { const int r = idx - 2 * I_GU, e = r >> 9, q2 = r & 511, kb = q2 >> 6, nb = q2 & 63, n0 = 32 * nb, k0 = 64 * kb;
        t.W = a.in[26] + (size_t)e * FF * DM + (size_t)k0 * DM + n0; t.ldw = DM; t.ldt = FF; t.rs = nullptr;
        t.WT = (bf16_t*)(ws + WS_WD) + (size_t)e * DM * FF + (size_t)n0 * FF + k0; }
}
DI void cv_item(const Args& a, unsigned char* ws, int idx, int nitems, TrItem& t) {
    expert_item(a, ws, idx < nitems ? idx : 0, t);
    if (idx >= nitems) { t.WT = (bf16_t*)(ws + WS_SCR); t.ldt = 64; }
}
DI void convert_range(const Ctx& C, const Args& a, int start, int stride, int end) {
    const int cw = start, ncw = stride, nitems = end;
    LAS float* scr = (LAS float*)(C.lds + C.wave * 8448);
#define CV_LD(k, idx) do { cv_item(a, C.ws, (idx), nitems, t##k); tr_load<(CV_NT >= 1)>(t##k, v##k, C.lane); } while (0)
#define CV_FIN(k) tr_finish<(CV_NT >= 2)>(t##k, v##k, scr, C.lane)
    TrItem t0, t1, t2, t3; f32x4 v0[8], v1[8], v2[8], v3[8];
    CV_LD(0, cw); CV_LD(1, cw + ncw); CV_LD(2, cw + 2 * ncw);
    for (int it = cw; it < nitems; it += 4 * ncw) {
        CV_LD(3, it + 3 * ncw); CV_FIN(0); CV_LD(0, it + 4 * ncw); CV_FIN(1); CV_LD(1, it + 5 * ncw); CV_FIN(2); CV_LD(2, it + 6 * ncw); CV_FIN(3);
    }
#undef CV_LD
#undef CV_FIN
}
DI void convert_queue(const Ctx& C, const Args& a) {
    unsigned* Q = (unsigned*)(C.ws + WS_CTL) + CW_Q;
    for (;;) {
        unsigned k = 0; if (C.lane == 0) k = atomicAdd(Q, (unsigned)CV_GRAB);
        const int idx = CV_STATIC + (int)__builtin_amdgcn_readfirstlane(k);
        if (idx >= 2 * CONV_PAIRS) break;
        const int end = idx + CV_GRAB < 2 * CONV_PAIRS ? idx + CV_GRAB : 2 * CONV_PAIRS;
        convert_range(C, a, idx, 1, end);
    }
}
DI void convert_stream(const Ctx& C, const Args& a, int ci, int nconv, int npairs) {
    (void)npairs;
    convert_range(C, a, ci * NWAVES + C.wave, nconv * NWAVES, CV_STATIC);
    convert_queue(C, a);
    VM_WAIT(); __syncthreads();
}

DI void convert_tail(const Ctx& C, const Args& a) {
#if TAIL_IN_P8
    unsigned* Q = (unsigned*)(C.ws + WS_CTL) + CW_Q;
    LAS float* scr = (LAS float*)(C.lds + C.wave * 8448); LAS float* scrB = (LAS float*)(C.lds + (C.wave < 7 ? 67584 + C.wave * 8448 : XB_OFF));
    for (;;) {
        unsigned k = 0; if (C.lane == 0) k = atomicAdd(Q, 2u);
        const int idx = 2 * CONV_PAIRS + (int)__builtin_amdgcn_readfirstlane(k);
        if (idx >= SIDE_ITEMS) break;
        TrItem t0, t1; f32x4 v0[8], v1[8];
        cv_item(a, C.ws, idx, SIDE_ITEMS, t0); tr_load(t0, v0, C.lane);
        cv_item(a, C.ws, idx + 1, SIDE_ITEMS, t1); tr_load(t1, v1, C.lane);
        tr_finish(t0, v0, scr, C.lane); tr_finish(t1, v1, scrB, C.lane);
    }
    VM_WAIT();
#endif
}

DI void meta_gemm(const Ctx& C) {
    if (C.vcu >= 128) return;
    const int n0 = 16 * C.vcu, l = C.lane, r = l & 15, q = l >> 4;
    const bf16_t* ap = (const bf16_t*)(C.ws + WS_A1M) + (size_t)r * DM + C.wave * 256 + 8 * q;
    const bf16_t* wp = (const bf16_t*)(C.ws + WS_WIN) + (size_t)(n0 + r) * DM + C.wave * 256 + 8 * q;
    f32x4 acc = {0.f, 0.f, 0.f, 0.f};
#pragma unroll
    for (int ks = 0; ks < 8; ++ks) { const bf16x8 af = *(const bf16x8*)(ap + 32 * ks), wf = *(const bf16x8*)(wp + 32 * ks); acc = MFMA16(wf, af, acc); }
    LAS f32x4* red = (LAS f32x4*)(C.lds);
    red[C.wave * 64 + l] = acc;
    __syncthreads();
    if (C.wave == 0) {
#pragma unroll
        for (int w = 1; w < 8; ++w) acc += red[w * 64 + l];
        const int col = n0 + 4 * q; bf16_t* dst = (col < PW) ? (bf16_t*)(C.ws + WS_ZP) + (size_t)(NTOK + r) * PW + col : (bf16_t*)(C.ws + WS_ZS) + (size_t)(NTOK + r) * SW + (col - PW);
        u32x2 w; w.x = pk2(acc[0], acc[1]); w.y = pk2(acc[2], acc[3]); *(u32x2*)dst = w;
    }
}

DI int zrow(int b, int s) { return s >= 0 ? b * SEQ + s : NTOK + NMETA + s; }
DI void pool_diff(const Ctx& C) {
    const bf16_t* ZP = (const bf16_t*)(C.ws + WS_ZP); bf16_t* DD = (bf16_t*)(C.ws + WS_DD);
    for (int it = C.gw; it < 2048; it += C.NGW) {
        const int tb = it >> 1, hf = it & 1, b = tb >> 9, s0 = (tb & 511) * 16, c0 = hf * 512 + C.lane * 8, w = 2 << (c0 >> 8);
        const float inv = 1.f / (float)w;
        f32x4 a0 = {0.f, 0.f, 0.f, 0.f}, a1 = a0;
        for (int j = 1; j < w; ++j) { f32x4 v0, v1; pg8::unpack8(*(const u32x4*)(ZP + (size_t)zrow(b, s0 - j) * PW + c0), v0, v1); a0 += v0; a1 += v1; }
        for (int i = 0; i < 16; ++i) { const int s = s0 + i; f32x4 c0v, c1v, l0, l1;
            pg8::unpack8(*(const u32x4*)(ZP + (size_t)zrow(b, s) * PW + c0), c0v, c1v); a0 += c0v; a1 += c1v;
            *(u32x4*)(DD + (size_t)(b * SEQ + s) * PW + c0) = pg8::pack8(a0 * inv - c0v, a1 * inv - c1v);
            pg8::unpack8(*(const u32x4*)(ZP + (size_t)zrow(b, s - w + 1) * PW + c0), l0, l1); a0 -= l0; a1 -= l1; }
    }
}

template <bool PASS2> DI void ssm_pass(const Ctx& C, const Args& a) {
    const bf16_t* ZS = (const bf16_t*)(C.ws + WS_ZS); bf16_t* S0 = (bf16_t*)(C.ws + WS_S0);
    f32x4* Eb = (f32x4*)(C.ws + WS_E);
    const int l = C.lane, rr = l & 31, bb = (rr >> 2) & 1, jj = (rr & 3) + 4 * (rr >> 3), kofs = 8 * (l >> 5);
    LAS unsigned char* xs = C.lds + C.wave * 8704;
    for (int it = C.gw; it < 64 * NCH; it += C.NGW) {
        const int g = it & 63, c0 = (it >> 6) & 31, c = (it >> 11) ? 63 - c0 : c0;
        const f32x2 lamA = ((const f32x2*)(C.ws + WS_LAM))[g * 64 + (l & 31)], lamB = ((const f32x2*)(C.ws + WS_LAM))[g * 64 + 32 + (l & 31)];
        bf16x8 bfr[4];
#pragma unroll
        for (int ct = 0; ct < 4; ++ct) bfr[ct] = *(const bf16x8*)((const bf16_t*)(C.ws + WS_BCAT) + ((size_t)g * 128 + 32 * ct + (l & 31)) * 16 + kofs);
        float xAr = 0.f, xAi = 0.f, xBr = 0.f, xBi = 0.f;
        bf16x8 cfr[4]; f32x4 dsk = {0.f, 0.f, 0.f, 0.f};
        if constexpr (PASS2) {
#pragma unroll
            for (int ks = 0; ks < 4; ++ks) cfr[ks] = *(const bf16x8*)((const bf16_t*)(C.ws + WS_CCATT) + ((size_t)g * 16 + (l & 15)) * 128 + 32 * ks + 8 * (l >> 4));
            dsk = *(const f32x4*)(a.in[13] + g * 16 + 4 * (l >> 4));
            if (c > 0) {
                const f32x2 LA = ((const f32x2*)(C.ws + WS_LAMP))[g * 64 + (l & 31)], LB = ((const f32x2*)(C.ws + WS_LAMP))[g * 64 + 32 + (l & 31)];
                const f32x4* ep = Eb + ((size_t)g * NCH) * 64 + l;
                f32x4 t = ep[0];
                for (int j0 = 1; j0 < c; j0 += 8) {
                    f32x4 eb[8];
#pragma unroll
                    for (int i = 0; i < 8; ++i) { const int j = (j0 + i < c) ? j0 + i : c - 1; eb[i] = ep[(size_t)j * 64]; }
#pragma unroll
                    for (int i = 0; i < 8; ++i) if (j0 + i < c) { const f32x4 e = eb[i];
                        const float ar = LA.x * t.x - LA.y * t.y + e.x, ai = LA.x * t.y + LA.y * t.x + e.y, br = LB.x * t.z - LB.y * t.w + e.z, bi = LB.x * t.w + LB.y * t.z + e.w;
                        t = (f32x4){ar, ai, br, bi}; }
                }
                xAr = t.x; xAi = t.y; xBr = t.z; xBi = t.w;
            }
        }
        const int nsteps = (c == 0) ? 9 : 8;
        auto urow = [&](int st) { const bool m = (c == 0 && st == 0); const int sb = c * CHL + 16 * (st - (c == 0 ? 1 : 0)); return m ? NTOK + jj : bb * SEQ + sb + jj; };
        bf16x8 af0 = *(const bf16x8*)(ZS + (size_t)urow(0) * SW + g * 16 + kofs), af1 = *(const bf16x8*)(ZS + (size_t)urow(1) * SW + g * 16 + kofs);
        for (int st = 0; st < nsteps; ++st) {
            const bool meta = (c == 0 && st == 0);
            const int sbase = c * CHL + 16 * (st - (c == 0 ? 1 : 0));
            const bf16x8 af = af0; af0 = af1;
            { const int stn = st + 2 < nsteps ? st + 2 : nsteps - 1; af1 = *(const bf16x8*)(ZS + (size_t)urow(stn) * SW + g * 16 + kofs); }
            f32x16 z16;
#pragma unroll
            for (int i = 0; i < 16; ++i) z16[i] = 0.f;
            f32x16 q0 = MFMA32(af, bfr[0], z16), q1 = MFMA32(af, bfr[1], z16), q2 = MFMA32(af, bfr[2], z16), q3 = MFMA32(af, bfr[3], z16);
#pragma unroll
            for (int r = 0; r < 16; ++r) {
                const float nar = lamA.x * xAr - lamA.y * xAi + q0[r], nai = lamA.x * xAi + lamA.y * xAr + q2[r];
                const float nbr = lamB.x * xBr - lamB.y * xBi + q1[r], nbi = lamB.x * xBi + lamB.y * xBr + q3[r];
                xAr = nar; xAi = nai; xBr = nbr; xBi = nbi;
                if constexpr (PASS2) { q0[r] = nar; q1[r] = nbr; q2[r] = nai; q3[r] = nbi; }
            }
            if constexpr (PASS2) {
                if (!meta) {
#pragma unroll
                    for (int r = 0; r < 16; ++r) { LAS unsigned short* xr = (LAS unsigned short*)(xs + (16 * (l >> 5) + r) * 272) + (l & 31);
                        const unsigned wre = pk2(q0[r], q1[r]), wim = pk2(q2[r], q3[r]);
                        xr[0] = (unsigned short)(wre & 0xffffu); xr[32] = (unsigned short)(wre >> 16); xr[64] = (unsigned short)(wim & 0xffffu); xr[96] = (unsigned short)(wim >> 16); }
                    asm volatile("" ::: "memory");
#pragma unroll
                    for (int hb = 0; hb < 2; ++hb) {
                        f32x4 y = {0.f, 0.f, 0.f, 0.f};
#pragma unroll
                        for (int ks = 0; ks < 4; ++ks) { const bf16x8 xf = *(const LAS bf16x8*)(xs + (16 * hb + (l & 15)) * 272 + (32 * ks + 8 * (l >> 4)) * 2); y = MFMA16(cfr[ks], xf, y); }
                        const size_t orow = (size_t)hb * SEQ + sbase + (l & 15);
                        const u32x2 uw = *(const u32x2*)(ZS + orow * SW + g * 16 + 4 * (l >> 4));
                        const float s0 = y[0] + dsk[0] * bflo(uw.x), s1 = y[1] + dsk[1] * bfhi(uw.x), s2 = y[2] + dsk[2] * bflo(uw.y), s3 = y[3] + dsk[3] * bfhi(uw.y);
                        u32x2 ow; ow.x = pk2(gelu_t(s0), gelu_t(s1)); ow.y = pk2(gelu_t(s2), gelu_t(s3));
                        *(u32x2*)(S0 + orow * SW + g * 16 + 4 * (l >> 4)) = ow;
                    }
                    asm volatile("" ::: "memory");
                }
            }
        }
        if constexpr (!PASS2) Eb[((size_t)g * NCH + c) * 64 + l] = (f32x4){xAr, xAi, xBr, xBi};
    }
}

#ifndef H1_IN_EPI
#define H1_IN_EPI 1
#endif
constexpr int RT_XD = 8192, RT_NXD = 12, RT_WOFF = RT_NXD * RT_XD, RT_W = 20480, RT_WH = 0, RT_WL = 10240;
DI void rt_issue_xd(const Ctx& C, const bf16_t* U, int t0, int c, LAS unsigned char* stg) {
    const int l = C.lane, w = C.wave;
#pragma unroll
    for (int i = 0; i < 2; ++i) { const int j = 2 * w + i, row = 8 * j + (l >> 3), u = (l & 7) ^ (row & 7);
        __builtin_amdgcn_global_load_lds((const unsigned*)(U + (size_t)(t0 + row) * DM + 64 * c + 8 * u), (LAS unsigned*)(stg + 1024 * j), 16, 0, 0); }
}
DI void rt_issue_w(const Ctx& C, int c, LAS unsigned char* stg) {
    const int l = C.lane, w = C.wave - 4;
    const bf16_t* WRH = (const bf16_t*)(C.ws + WS_WRH); const bf16_t* WRL = (const bf16_t*)(C.ws + WS_WRL);
#pragma unroll
    for (int i = 0; i < 5; ++i) { const int j = 5 * w + i;
        const int jj = j < 10 ? j : j - 10, n = 8 * jj + (l >> 3), u = (l & 7) ^ (n & 7); const bf16_t* src = (j < 10 ? WRH : WRL) + (size_t)n * DM + 64 * c + 8 * u;
        __builtin_amdgcn_global_load_lds((const unsigned*)src, (LAS unsigned*)(stg + (j < 10 ? RT_WH : RT_WL) + 1024 * jj), 16, 0, 0); }
}
DI void router_phase(const Ctx& C, const Args& a) {
    const bf16_t* V = (const bf16_t*)(C.ws + WS_V);
    unsigned* counts = (unsigned*)(C.ws + WS_CTL) + CW_CNT; uint4* LIST = (uint4*)(C.ws + WS_LIST);
    const int l = C.lane, r = l & 15, q = l >> 4, rt = C.wave & 3, kp = C.wave >> 2;
    LAS float* part = (LAS float*)(C.lds);
    LAS float* lgb = (LAS float*)(C.lds + 32768);
    for (int tb = C.vcu; tb < NTOK / 64; tb += C.G) {
        const int t0 = tb * 64, row = 16 * rt + r;
        f32x4 acc[5];
#pragma unroll
        for (int n = 0; n < 5; ++n) acc[n] = (f32x4){0.f, 0.f, 0.f, 0.f};
        float ss = 0.f;
        if (C.wave < 4) {
#pragma unroll
            for (int s = 0; s < RT_NXD - 1; ++s) rt_issue_xd(C, V, t0, s, C.lds + s * RT_XD);
        } else rt_issue_w(C, 0, C.lds + RT_WOFF);
        int sx = 0;
        for (int c = 0; c < 32; ++c) {
            if (C.wave < 4) {
                if (c + RT_NXD - 1 < 32) { rt_issue_xd(C, V, t0, c + RT_NXD - 1, C.lds + (sx == 0 ? RT_NXD - 1 : sx - 1) * RT_XD);
                    asm volatile("s_waitcnt vmcnt(22)" ::: "memory"); }
                else asm volatile("s_waitcnt vmcnt(0)" ::: "memory");
            } else {
                if (c + 1 < 32) { rt_issue_w(C, c + 1, C.lds + RT_WOFF + ((c + 1) & 1) * RT_W); asm volatile("s_waitcnt vmcnt(5)" ::: "memory"); }
                else asm volatile("s_waitcnt vmcnt(0)" ::: "memory");
            }
            __builtin_amdgcn_s_barrier(); asm volatile("" ::: "memory");
            const LAS unsigned char* stg = C.lds + sx * RT_XD; const LAS unsigned char* wst = C.lds + RT_WOFF + (c & 1) * RT_W;
            const u32x4 uw = *(const LAS u32x4*)(stg + row * 128 + (((4 * kp + q) ^ (row & 7)) << 4));
            bf16x8 wh[5], wl[5];
#pragma unroll
            for (int n = 0; n < 5; ++n) { const int nn = 16 * n + r; const int off = nn * 128 + (((4 * kp + q) ^ (nn & 7)) << 4);
                wh[n] = *(const LAS bf16x8*)(wst + RT_WH + off); wl[n] = *(const LAS bf16x8*)(wst + RT_WL + off); }
            f32x4 h0, h1; pg8::unpack8(uw, h0, h1);
            ss += (h0.x * h0.x + h0.y * h0.y) + (h0.z * h0.z + h0.w * h0.w) + (h1.x * h1.x + h1.y * h1.y) + (h1.z * h1.z + h1.w * h1.w);
            const bf16x8 ah = __builtin_bit_cast(bf16x8, uw);
#pragma unroll
            for (int n = 0; n < 5; ++n) { acc[n] = MFMA16(wh[n], ah, acc[n]); acc[n] = MFMA16(wl[n], ah, acc[n]); }
            LDS_WAIT(); __builtin_amdgcn_s_barrier(); asm volatile("" ::: "memory");
            sx = sx == RT_NXD - 1 ? 0 : sx + 1;
        }
        ss += __shfl_xor(ss, 16); ss += __shfl_xor(ss, 32);
        if (kp == 1) {
#pragma unroll
            for (int n = 0; n < 5; ++n)
#pragma unroll
                for (int j = 0; j < 4; ++j) part[(rt * 21 + n * 4 + j) * 64 + l] = acc[n][j];
            part[(rt * 21 + 20) * 64 + l] = ss;
        }
        __syncthreads();
        if (kp == 0) {
#pragma unroll
            for (int n = 0; n < 5; ++n)
#pragma unroll
                for (int j = 0; j < 4; ++j) acc[n][j] += part[(rt * 21 + n * 4 + j) * 64 + l];
            ss += part[(rt * 21 + 20) * 64 + l];
            const float rstd = rsqrtf(ss * (1.f / DM) + RMS_EPS);
            LAS float* lg = lgb + rt * 16 * 80;
#pragma unroll
            for (int n = 0; n < 5; ++n)
#pragma unroll
                for (int j = 0; j < 4; ++j) { const int idx = 16 * n + 4 * q + j; if (idx < 72) { const float bias = idx < 8 ? a.in[21][idx] : a.in[23][idx - 8]; lg[r * 80 + idx] = acc[n][j] * rstd + bias; } }
            LDS_WAIT(); asm volatile("" ::: "memory");
            if (l < 16) {
                const LAS float* p = lg + l * 80;
                int gs = 0; float mx = p[0];
#pragma unroll
                for (int k = 1; k < 8; ++k) { const float v = p[k]; if (v > mx) { mx = v; gs = k; } }
                float den = 0.f;
#pragma unroll
                for (int k = 0; k < 8; ++k) den += expf(p[k] - mx);
                const float pgp = 1.f / den;
                const LAS float* el = p + 8 + gs * 8;
                int i0 = 0; float v0 = el[0];
#pragma unroll
                for (int k = 1; k < 8; ++k) { const float v = el[k]; if (v > v0) { v0 = v; i0 = k; } }
                int i1 = -1; float v1 = -3.0e38f;
#pragma unroll
                for (int k = 0; k < 8; ++k) { const float v = el[k]; if (k != i0 && v > v1) { v1 = v; i1 = k; } }
                const float e1 = expf(v1 - v0), w0 = pgp / (1.f + e1), w1 = pgp * e1 / (1.f + e1);
                const int tok = t0 + 16 * rt + l, ex0 = gs * 8 + i0, ex1 = gs * 8 + i1;
                const unsigned r0 = atomicAdd(&counts[ex0], 1u), r1 = atomicAdd(&counts[ex1], 1u);
                LIST[(size_t)ex0 * LISTCAP + r0] = make_uint4((unsigned)tok, (unsigned)(2 * tok), __float_as_uint(w0), __float_as_uint(rstd));
                LIST[(size_t)ex1 * LISTCAP + r1] = make_uint4((unsigned)tok, (unsigned)(2 * tok + 1), __float_as_uint(w1), __float_as_uint(rstd));
            }
        }
        VM_WAIT(); __syncthreads();
    }
}
DI void moe_tables(const Ctx& C, int ntn) {
    volatile LAS int* tab = (volatile LAS int*)(C.lds + TAB_OFF);
    if (C.tid < 64) {
        const unsigned* counts = (const unsigned*)(C.ws + WS_CTL) + CW_CNT;
        const int cnt = (int)__hip_atomic_load(counts + C.tid, RLX_AGENT); const int nblk = (cnt + 255) >> 8;
        int incl = nblk;
#pragma unroll
        for (int o = 1; o < 64; o <<= 1) { const int t = __shfl_up(incl, o); if (C.tid >= o) incl += t; }
        tab[C.tid + 1] = incl * ntn; if (C.tid == 0) tab[0] = 0;
        tab[80 + C.tid] = (incl - nblk) * 256; tab[160 + C.tid] = cnt;
    }
    __syncthreads();
}
struct FinRow { u32x2 hw[8]; unsigned p[8], q[8]; };
DI void fin_load(FinRow& R, const unsigned char* ws, int t, int lane) {
    const u32x2* hb = (const u32x2*)((const bf16_t*)(ws + WS_V) + (size_t)t * DM) + lane;
    const unsigned* y0 = (const unsigned*)(ws + WS_YB + (size_t)(2 * t) * DM) + lane; const unsigned* y1 = (const unsigned*)(ws + WS_YB + (size_t)(2 * t + 1) * DM) + lane;
#pragma unroll
    for (int j = 0; j < 8; ++j) { if (FIN_NT) { R.hw[j] = __builtin_nontemporal_load(hb + 64 * j); R.p[j] = __builtin_nontemporal_load(y0 + 64 * j); R.q[j] = __builtin_nontemporal_load(y1 + 64 * j); }
        else { R.hw[j] = hb[64 * j]; R.p[j] = y0[64 * j]; R.q[j] = y1[64 * j]; } }
}
DI void fin_finish(const FinRow& R, const float* gfin, float* orow, int lane) {
    constexpr float IS = 1.f / 16.f;
    f32x4 v[8]; float s = 0.f;
#pragma unroll
    for (int j = 0; j < 8; ++j) { const u32x2 hw = R.hw[j]; const int p = (int)R.p[j], q = (int)R.q[j];
        v[j] = (f32x4){bflo(hw.x) + IS * (__builtin_amdgcn_cvt_f32_fp8(p, 0) + __builtin_amdgcn_cvt_f32_fp8(q, 0)), bfhi(hw.x) + IS * (__builtin_amdgcn_cvt_f32_fp8(p, 1) + __builtin_amdgcn_cvt_f32_fp8(q, 1)),
                       bflo(hw.y) + IS * (__builtin_amdgcn_cvt_f32_fp8(p, 2) + __builtin_amdgcn_cvt_f32_fp8(q, 2)), bfhi(hw.y) + IS * (__builtin_amdgcn_cvt_f32_fp8(p, 3) + __builtin_amdgcn_cvt_f32_fp8(q, 3))};
        s += (v[j].x * v[j].x + v[j].y * v[j].y) + (v[j].z * v[j].z + v[j].w * v[j].w); }
    const float rstd = rsqrtf(wave_sum(s) * (1.f / DM) + RMS_EPS);
    const f32x4* gr = (const f32x4*)gfin + lane; f32x4* o = (f32x4*)orow + lane;
#pragma unroll
    for (int j = 0; j < 8; ++j) { const f32x4 gg = gr[64 * j]; const f32x4 r = {v[j].x * rstd * gg.x, v[j].y * rstd * gg.y, v[j].z * rstd * gg.z, v[j].w * rstd * gg.w};
        if (FIN_ST_NT) __builtin_nontemporal_store(r, o + 64 * j); else o[64 * j] = r; }
}
DI void final_phase(const Ctx& C, const Args& a, float* dst_override = nullptr) {
    float* out = dst_override ? dst_override : a.out;
    static_assert(NTOK % 2 == 0, "rows are taken in pairs");
    for (int t = 2 * C.gw; t < NTOK; t += 2 * C.NGW) {
        FinRow A, B; fin_load(A, C.ws, t, C.lane); fin_load(B, C.ws, t + 1, C.lane);
        fin_finish(A, a.in[27], out + (size_t)t * DM, C.lane); fin_finish(B, a.in[27], out + (size_t)(t + 1) * DM, C.lane);
    }
}
constexpr int N_PHASES = 11;
DI bool is_conv(const Ctx& C) { return NCONV && C.G == 256 && (C.vcu & 31) >= 32 - NCONV / 8; }
DI int gemm_index(const Ctx& C) { return (C.vcu >> 5) * (32 - NCONV / 8) + (C.vcu & 31); }
DI void meta_gemm_g(const Ctx& C) { Ctx M = C; M.vcu = (NCONV && C.G == 256) ? gemm_index(C) : C.vcu; meta_gemm(M); }
DI void phase1_conv(const Ctx& C, const Args& args) { const int ng = 32 - NCONV / 8; convert_stream(C, args, (C.vcu >> 5) * (NCONV / 8) + ((C.vcu & 31) - ng), NCONV, CONV_PAIRS); }
DI void phase1_gemm(const Ctx& C, const Args& args) {
    unsigned char* ws = C.ws;
    pg8::DenseOrder S;
    if (NCONV && C.G == 256) S.setup(ws + WS_A1, ws + WS_WIN, NTOK, INW, DM, DM, 256 - NCONV, (C.vcu & 31) * 8 + (C.vcu >> 5));
    else S.setup(ws + WS_A1, ws + WS_WIN, NTOK, INW, DM, DM, C.G, (int)blockIdx.x);
    pg8::EpiZ E{(bf16_t*)(ws + WS_ZP), (bf16_t*)(ws + WS_ZS), ws + WS_GP, ws + WS_GS};
    pg8::gemm_phase<pg8::EpiZ, pg8::DenseOrder, true, true>(C.lds, pg8::Gemm{DM, DM, DM}, S, E);
    meta_gemm_g(C);
    if (NCONV && C.G == 256 && CV_QFRAC) { __syncthreads(); convert_queue(C, args); VM_WAIT(); __syncthreads(); }
}
DI void phase1(const Ctx& C, const Args& args) { if (is_conv(C)) phase1_conv(C, args); else phase1_gemm(C, args); }
DI void phase2(const Ctx& C, const Args& args) { pool_diff(C); ssm_pass<false>(C, args); }
DI void phase3(const Ctx& C, const Args& args) {
    unsigned char* ws = C.ws;
    pg8::PoolOrder S; S.init(NTOK / 256, 4, C.G, (int)blockIdx.x); S.DD = (const char*)(ws + WS_DD); S.PWT = (const char*)(ws + WS_POOLW);
    pg8::EpiPool E{(bf16_t*)(ws + WS_PP), args.in[5]};
    pg8::gemm_phase<pg8::EpiPool, pg8::PoolOrder, true, true>(C.lds, pg8::Gemm{PW, 256, 256}, S, E);
    ssm_pass<true>(C, args);
}
DI void phase4(const Ctx& C, const Args& args) {
    unsigned char* ws = C.ws;
    pg8::DenseOrder S; S.setup(ws + WS_S0, ws + WS_WGLU, NTOK, SW, SW, SW, C.G, (int)blockIdx.x);
    pg8::EpiGlu E{(const bf16_t*)(ws + WS_S0), (bf16_t*)(ws + WS_SS), args.in[15]};
    pg8::gemm_phase<pg8::EpiGlu, pg8::DenseOrder, true, true>(C.lds, pg8::Gemm{SW, SW, SW}, S, E);
}
DI void phase5(const Ctx& C, const Args& args) {
    unsigned char* ws = C.ws;
    pg8::MergeOrder S; S.init(NTOK / 256, DM / 256, C.G, (int)blockIdx.x);
    S.A0 = (const char*)(ws + WS_PP); S.B0 = (const char*)(ws + WS_WBP); S.A1 = (const char*)(ws + WS_SS); S.B1 = (const char*)(ws + WS_WBS); S.tstepA = (size_t)256 * PW * 2; S.tstepB = (size_t)256 * PW * 2;
    pg8::EpiMerge E{ws + WS_GP, ws + WS_GS, (bf16_t*)(ws + WS_MP)};
    pg8::gemm_phase<pg8::EpiMerge, pg8::MergeOrder, true, true>(C.lds, pg8::Gemm{PW, PW, PW}, S, E);
}
DI void phase6(const Ctx& C, const Args& args) {
    unsigned char* ws = C.ws;
    pg8::DenseOrder S; S.setup(ws + WS_MP, ws + WS_WOUT, NTOK, DM, DM, DM, C.G, (int)blockIdx.x);
    pg8::EpiH1 E{(bf16_t*)(ws + WS_V), (const float*)(ws + WS_RSTD1), (const float*)(ws + WS_IG)};
#if SIDE_P56
    pg8::SideConv sd; sd.init(args.in[24], args.in[25], args.in[26], (bf16_t*)(ws + WS_WGU), (bf16_t*)(ws + WS_WD), (bf16_t*)(ws + WS_SCR), C.lds + XB_OFF, SIDE_N1 + 2 * SIDE_N5 + C.vcu, SIDE_TOTAL, C.G);
    pg8::gemm_phase<pg8::EpiH1, pg8::DenseOrder, true, true, pg8::SideConv>(C.lds, pg8::Gemm{DM, DM, DM}, S, E, sd);
#else
    pg8::gemm_phase<pg8::EpiH1, pg8::DenseOrder, true, true>(C.lds, pg8::Gemm{DM, DM, DM}, S, E);
#endif
}
DI void phase8(const Ctx& C, const Args& args) {
    unsigned char* ws = C.ws;
    __syncthreads();
    moe_tables(C, 4);
    pg8::MoeUpOrder S; S.tab = (const volatile LAS int*)(C.lds + TAB_OFF); S.ntn = 4; S.G = C.G; S.vcu = C.vcu; S.list = (const uint4*)(ws + WS_LIST);
    S.Abase = (const char*)(ws + WS_V); S.Bbase = (const char*)(ws + WS_WGU); S.bstep_e = (size_t)1024 * DM * 2; S.bstep_n = (size_t)256 * DM * 2; S.astep_row = 0; S.up = true;
    pg8::EpiMoeUp E{(bf16_t*)(ws + WS_HH)};
    pg8::gemm_phase<pg8::EpiMoeUp, pg8::MoeUpOrder, true, true>(C.lds, pg8::Gemm{DM, DM, DM}, S, E);
    convert_tail(C, args);
}
DI void phase9(const Ctx& C, const Args& args) {
    unsigned char* ws = C.ws;
    __syncthreads();
    moe_tables(C, 8);
    pg8::MoeDownOrder S; S.tab = (const volatile LAS int*)(C.lds + TAB_OFF); S.ntn = 8; S.G = C.G; S.vcu = C.vcu; S.list = (const uint4*)(ws + WS_LIST);
    S.Abase = (const char*)(ws + WS_HH); S.Bbase = (const char*)(ws + WS_WD); S.bstep_e = (size_t)DM * FF * 2; S.bstep_n = (size_t)256 * FF * 2; S.astep_row = (size_t)FF * 2; S.up = false;
    pg8::EpiMoeDown E{(bf16_t*)(ws + WS_YB)};
    pg8::gemm_phase<pg8::EpiMoeDown, pg8::MoeDownOrder, true, true>(C.lds, pg8::Gemm{FF, FF, FF}, S, E);
}
#ifndef PH_MASK
#define PH_MASK 0x7ff
#endif
#ifndef PROBE_DBL
#define PROBE_DBL 0
#endif
#ifndef OVERLAP_P0
#define OVERLAP_P0 1
#endif
__global__ void __launch_bounds__(NWAVES * 64, 2) mk_fwd(Args args) {
    extern __shared__ __attribute__((aligned(16))) unsigned char lds_raw[];
    Ctx C; C.lds = (LAS unsigned char*)lds_raw; C.ws = args.ws; C.tid = threadIdx.x; C.lane = C.tid & 63; C.wave = __builtin_amdgcn_readfirstlane(C.tid >> 6);
    C.G = gridDim.x; { const int bx = blockIdx.x; C.vcu = (C.G % 8 == 0) ? (bx % 8) * (C.G / 8) + bx / 8 : bx; }
    C.gw = C.wave * C.G + C.vcu; C.NGW = NWAVES * C.G;
    unsigned char* ws = args.ws;
    for (int u = C.tid; u < (LDS_BYTES - MISC_OFF) / 4; u += NWAVES * 64) ((LAS unsigned*)(C.lds + MISC_OFF))[u] = 0u;
    __syncthreads();
    const int lo = args.ph_lo, hi = args.ph_hi;
    XcdBarrier bar; bar.bar = (unsigned*)(ws + WS_CTL) + CW_BAR; bar.x = 0; bar.st = nullptr;
    if (hi - lo > 1) bar = xcd_barrier_post((unsigned*)(ws + WS_CTL) + CW_BAR, (volatile LAS unsigned*)(C.lds + MISC_OFF) + 8, gridDim.x);
#if NCONV && OVERLAP_P0
    XcdBarrier bar2; bar2.bar = (unsigned*)(ws + WS_CTL) + CW_BAR2; bar2.x = 0; bar2.st = nullptr; bar2.expected = 0;
    if (hi - lo > 1 && C.G == 256 && !is_conv(C)) bar2 = xcd_barrier_post((unsigned*)(ws + WS_CTL) + CW_BAR2, (volatile LAS unsigned*)(C.lds + MISC_OFF) + 10, 256 - NCONV);
#endif
#define IN(k) (((PH_MASK >> (k)) & 1) && lo <= (k) && (k) < hi)
#ifndef PROBE_BAR
#define PROBE_BAR 0
#endif
#define SEAM(k) do { if (IN(k) && IN((k) + 1)) { if (args.use_cg && (k) == 0) { cg::this_grid().sync(); } else xcd_barrier(bar); for (int pb_ = 0; pb_ < PROBE_BAR; ++pb_) xcd_barrier(bar); } } while (0)
#ifndef STAGGER
#define STAGGER 0
#endif
#ifndef STAGGER_MASK
#define STAGGER_MASK 0x362
#endif
#define RUN(k, call) do { if (IN(k)) { if (STAGGER && ((STAGGER_MASK >> (k)) & 1)) { for (int sg_ = 0; sg_ < (C.vcu & 7); ++sg_) __builtin_amdgcn_s_sleep(STAGGER); } call; if ((PROBE_DBL >> (k)) & 1) { xcd_barrier(bar); call; } } } while (0)
#if NCONV && OVERLAP_P0
    if (IN(0) && IN(1) && C.G == 256) {
        if (is_conv(C)) phase1_conv(C, args);
        else { Ctx P = C; const int gi = gemm_index(C); P.gw = C.wave * (256 - NCONV) + gi; P.NGW = NWAVES * (256 - NCONV);
               p0_prologue(P, args, 3); xcd_barrier(bar2); phase1_gemm(C, args); }
    } else
#endif
    { RUN(0, p0_prologue(C, args)); SEAM(0);
      RUN(1, phase1(C, args)); }
    SEAM(1);
    RUN(2, phase2(C, args)); SEAM(2);
    RUN(3, phase3(C, args)); SEAM(3);
    RUN(4, phase4(C, args)); SEAM(4);
    RUN(5, phase5(C, args)); SEAM(5);
    RUN(6, phase6(C, args)); SEAM(6);
#if (PROBE_DBL >> 7) & 1
    if (IN(7)) { router_phase(C, args); xcd_barrier(bar); if (blockIdx.x == 0 && C.tid < 64) ((unsigned*)(ws + WS_CTL) + CW_CNT)[C.tid] = 0u; xcd_barrier(bar); router_phase(C, args); } SEAM(7);
#else
    RUN(7, router_phase(C, args)); SEAM(7);
#endif
    RUN(8, phase8(C, args)); SEAM(8);
    RUN(9, phase9(C, args)); SEAM(9);
#if (PROBE_DBL >> 10) & 1
    if (IN(10)) { final_phase(C, args, (float*)(ws + WS_ZP)); xcd_barrier(bar); final_phase(C, args); }
#else
    RUN(10, final_phase(C, args));
#endif
#undef IN
#undef SEAM
#undef RUN
}

#ifdef MK_DEBUG
namespace dbg {
constexpr int DL = 16 + 768;
__global__ void __launch_bounds__(256) k_cmp(const void* opt, int is_bf16, int old_, int ocol0, const float* ref, int rld, int rcol0, int ncols, int kind, int transform, float tol, unsigned* res) {
    __shared__ float red[4];
    const int r = blockIdx.x, p = r;
    if (kind == 0 && p < 16) return;
    if (kind >= 2 && p >= 16) return;
    const size_t orow = kind == 2 ? (size_t)p : (p < 16 ? (size_t)(NTOK + p) : (size_t)(SEQ + p - 16));
    float e2 = 0.f, r2 = 0.f;
    for (int c = threadIdx.x; c < ncols; c += 256) {
        float rv = ref[(size_t)r * rld + rcol0 + c]; if (transform == 1) rv = 1.f / (1.f + expf(-rv));
        float ov = is_bf16 ? __uint_as_float(((unsigned)((const bf16_t*)opt)[orow * old_ + ocol0 + c]) << 16) : ((const float*)opt)[orow * old_ + ocol0 + c];
        const float d = ov - rv; e2 += d * d; r2 += rv * rv; }
    e2 = nv::block_sum_256(e2, red); r2 = nv::block_sum_256(r2, red);
    if (threadIdx.x == 0) { const bool bad = !(e2 <= tol * tol * r2 + 1e-20f); if (bad) atomicAdd(res, 1u); const float rel = sqrtf(e2 / (r2 + 1e-30f)); atomicMax(res + 1, __float_as_uint(rel == rel ? rel : 3.0e38f)); }
}
__global__ void __launch_bounds__(256) k_cmp_moe(const bf16_t* YB, const float* ref, float tol, unsigned* res) {
    __shared__ float red[4];
    const int r = blockIdx.x, p = r; if (p < 16) return; const size_t t = (size_t)(SEQ + p - 16);
    float e2 = 0.f, r2 = 0.f;
    for (int c = threadIdx.x; c < DM; c += 256) { const float rv = ref[(size_t)r * DM + c];
        const float ov = __uint_as_float(((unsigned)YB[(2 * t) * DM + c]) << 16) + __uint_as_float(((unsigned)YB[(2 * t + 1) * DM + c]) << 16);
        const float d = ov - rv; e2 += d * d; r2 += rv * rv; }
    e2 = nv::block_sum_256(e2, red); r2 = nv::block_sum_256(r2, red);
    if (threadIdx.x == 0) { const bool bad = !(e2 <= tol * tol * r2 + 1e-20f); if (bad) atomicAdd(res, 1u); const float rel = sqrtf(e2 / (r2 + 1e-30f)); atomicMax(res + 1, __float_as_uint(rel == rel ? rel : 3.0e38f)); }
}
__global__ void __launch_bounds__(256) k_cmp_wt(const bf16_t* WT, int ldt, const float* W, const float* W2, int ldw, int K, int mode, float tol, unsigned* res) {
    __shared__ float red[4];
    const int n = blockIdx.x; const float* src = W; int col = n;
    if (mode == 1) { const int blk = n >> 8, within = n & 255; col = blk * 128 + (within & 127); src = within >= 128 ? W2 : W; }
    float e2 = 0.f, r2 = 0.f;
    for (int k = threadIdx.x; k < K; k += 256) { const float rv = src[(size_t)k * ldw + col]; const float ov = __uint_as_float(((unsigned)WT[(size_t)n * ldt + k]) << 16); const float d = ov - rv; e2 += d * d; r2 += rv * rv; }
    e2 = nv::block_sum_256(e2, red); r2 = nv::block_sum_256(r2, red);
    if (threadIdx.x == 0) { const bool bad = !(e2 <= tol * tol * r2 + 1e-20f); if (bad) atomicAdd(res, 1u); const float rel = sqrtf(e2 / (r2 + 1e-30f)); atomicMax(res + 1, __float_as_uint(rel == rel ? rel : 3.0e38f)); }
}
__global__ void __launch_bounds__(256) k_finalize(float* out, size_t n, const unsigned* res, int nchecks, int mode, int which) {
    int first = -1;
    for (int k = 0; k < nchecks; ++k) { const unsigned allowed = (k >= 22) ? 60u : 0u; if (res[2 * k] > allowed) { first = k; break; } }
    float K = 0.f;
    if (mode == 0) { if (first < 0) return; K = (float)(first + 1); }
    else { const float rel = __uint_as_float(res[2 * which + 1]); K = 1.f + 10.f * fminf(rel, 2.f); }
    for (size_t i = (size_t)blockIdx.x * 256 + threadIdx.x; i < n; i += (size_t)gridDim.x * 256) out[i] = K;
}
}
#endif

#ifndef MK_LAUNCHES
#define MK_LAUNCHES 1
#endif
#ifndef MK_USE_CG
#define MK_USE_CG 0
#endif
#ifndef MK_DBG_MODE
#define MK_DBG_MODE 0
#endif
#ifndef MK_DBG_WHICH
#define MK_DBG_WHICH 0
#endif
extern "C" void kernel_launch(void* const* d_in, const int* in_sizes, int n_in, void* d_out, int out_size, void* d_ws, size_t ws_size, hipStream_t stream) {
    static int grid = 0;
    if (grid == 0) {
        if (n_in != 28 || out_size != NTOK * DM || ws_size < WS_END) { fprintf(stderr, "kernel_launch: unexpected problem (n_in %d out %d ws %zu)\n", n_in, out_size, ws_size); grid = -1; return; }
        int dev = 0, cus = 0, per_cu = 0;
        if (hipGetDevice(&dev) != hipSuccess || hipDeviceGetAttribute(&cus, hipDeviceAttributeMultiprocessorCount, dev) != hipSuccess) { grid = -1; return; }
        if (hipFuncSetAttribute((const void*)mk_fwd, hipFuncAttributeMaxDynamicSharedMemorySize, LDS_BYTES) != hipSuccess) { fprintf(stderr, "kernel_launch: hipFuncSetAttribute failed\n"); grid = -1; return; }
        if (hipOccupancyMaxActiveBlocksPerMultiprocessor(&per_cu, (const void*)mk_fwd, NWAVES * 64, LDS_BYTES) != hipSuccess || per_cu < 1) { fprintf(stderr, "kernel_launch: occupancy query says %d blocks per CU\n", per_cu); grid = -1; return; }
        (void)hipGetLastError();
        if (cus != 256) { fprintf(stderr, "kernel_launch: built for a 256-CU device (role split and unit counts), found %d CUs\n", cus); grid = -1; return; }
        grid = cus;
    }
    if (grid < 0) return;
    (void)hipMemsetAsync((char*)d_ws + WS_CTL, 0, CTL_ZERO_BYTES, stream);
    Args a{};
    for (int i = 0; i < 28; ++i) a.in[i] = (const float*)d_in[i];
    a.out = (float*)d_out; a.ws = (unsigned char*)d_ws; a.use_cg = MK_USE_CG; a.pad = 0;
#if MK_LAUNCHES == 1
    a.ph_lo = 0; a.ph_hi = N_PHASES;
    void* kargs[] = {&a};
#ifdef MK_PLAIN_LAUNCH
    (void)kargs; hipLaunchKernelGGL(mk_fwd, dim3(grid), dim3(NWAVES * 64), LDS_BYTES, stream, a); hipError_t e = hipPeekAtLastError();
#else
    hipError_t e = hipLaunchCooperativeKernel((const void*)mk_fwd, dim3(grid), dim3(NWAVES * 64), kargs, LDS_BYTES, stream);
#endif
    if (e != hipSuccess) fprintf(stderr, "kernel_launch: cooperative launch failed: %s (grid %d)\n", hipGetErrorString(e), grid);
#else
    a.use_cg = 0;
#ifdef MK_DEBUG
    const size_t R = dbg::DL; unsigned char* ws = (unsigned char*)d_ws;
    float* base = (float*)(ws + WS_DBG); size_t off = 0;
    auto take = [&](size_t nfloats) { float* p = base + off; off += (nfloats + 63) & ~(size_t)63; return p; };
    nv::Bufs B; B.nH = take(R * DM); B.nU = take(R * DM); B.nZ = take(R * 6144); B.nD = take(R * 1024); B.nP = take(R * 1024); B.nS0 = take(R * 1024); B.nT = take(R * 1024); B.nS = take(R * 1024);
    B.nYP = take(R * DM); B.nYS = take(R * DM); B.nV = take(R * DM); B.nMoe = take(R * DM); float* nOut = take(R * DM); B.eid = (int*)take(R * 2); B.gate = take(R * 2); B.logits = nullptr;
    if ((size_t)((char*)(base + off) - (char*)d_ws) > ws_size) { fprintf(stderr, "debug buffers do not fit\n"); return; }
    nv::Cfg c{1, 1, dbg::DL};
    nv::run(d_in, B, nOut, 0, c, stream);
    unsigned* res = (unsigned*)(ws + WS_CTL) + CW_DBG;
    const float* const* in = (const float* const*)d_in;
    int k = 0;
#define CMP(opt, isbf, old_, oc0, ref, rld, rc0, nc, kind, tr, tol) dbg::k_cmp<<<(unsigned)R, 256, 0, stream>>>((const void*)(opt), isbf, old_, oc0, ref, rld, rc0, nc, kind, tr, tol, res + 2 * (k++))
#define CWT(WT, ldt, W, W2, ldw, K, mode, nrows) dbg::k_cmp_wt<<<(unsigned)(nrows), 256, 0, stream>>>((const bf16_t*)(WT), ldt, W, W2, ldw, K, mode, 0.01f, res + 2 * (k++))
#endif
    for (int ph = 0; ph < N_PHASES; ++ph) {
        a.ph_lo = ph; a.ph_hi = ph + 1;
        hipLaunchKernelGGL(mk_fwd, dim3(grid), dim3(NWAVES * 64), LDS_BYTES, stream, a);
#ifdef MK_DEBUG
        if (ph == 0) {
            CMP(ws + WS_A1, 1, DM, 0, B.nU, DM, 0, DM, 0, 0, 0.01f);
            CMP(ws + WS_A1M, 1, DM, 0, B.nU, DM, 0, DM, 2, 0, 0.01f);
            CWT(ws + WS_WIN, DM, in[3], nullptr, INW, DM, 0, INW);
            CWT(ws + WS_POOLW + 2 * 65536 * 2, 256, in[4] + 2 * 65536, nullptr, 256, 256, 0, 256);
            CWT(ws + WS_WGLU, SW, in[14], nullptr, SW, SW, 0, SW);
            CWT(ws + WS_WBP, PW, in[16], nullptr, DM, PW, 0, DM);
            CWT(ws + WS_WBS, SW, in[17], nullptr, DM, SW, 0, DM);
            CWT(ws + WS_WOUT, DM, in[18], nullptr, DM, DM, 0, DM);
            CWT(ws + WS_WGU + (size_t)37 * 1024 * DM * 2, DM, in[24] + (size_t)37 * DM * FF, in[25] + (size_t)37 * DM * FF, FF, DM, 1, 1024);
            CWT(ws + WS_WD + (size_t)37 * DM * FF * 2, FF, in[26] + (size_t)37 * FF * DM, nullptr, DM, FF, 0, DM);
        }
        if (ph == 1) {
            CMP(ws + WS_ZP, 1, PW, 0, B.nZ, 6144, 0, 1024, 0, 0, 0.03f);
            CMP(ws + WS_ZP, 1, PW, 0, B.nZ, 6144, 0, 1024, 3, 0, 0.03f);
            CMP(ws + WS_ZS, 1, SW, 0, B.nZ, 6144, 1024, 1024, 0, 0, 0.03f);
            CMP(ws + WS_ZS, 1, SW, 0, B.nZ, 6144, 1024, 1024, 3, 0, 0.03f);
            CMP(ws + WS_GP, 1, DM, 0, B.nZ, 6144, 2048, 2048, 0, 1, 0.03f);
            CMP(ws + WS_GS, 1, DM, 0, B.nZ, 6144, 4096, 2048, 0, 1, 0.03f);
        }
        if (ph == 2) { CMP(ws + WS_DD, 1, PW, 0, B.nD, 1024, 0, 1024, 0, 0, 0.05f); }
        if (ph == 3) { CMP(ws + WS_PP, 1, PW, 0, B.nP, 1024, 0, 1024, 0, 0, 0.05f);
                       CMP(ws + WS_S0, 1, SW, 0, B.nS0, 1024, 0, 1024, 0, 0, 0.05f); }
        if (ph == 4) { CMP(ws + WS_SS, 1, SW, 0, B.nS, 1024, 0, 1024, 0, 0, 0.05f); }
        if (ph == 5) { CMP(ws + WS_MP, 1, DM, 0, B.nYP, DM, 0, DM, 0, 0, 0.06f); }
        if (ph == 7) { CMP(ws + WS_V, 1, DM, 0, B.nH, DM, 0, DM, 0, 0, 0.03f); }
        if (ph == 9) { dbg::k_cmp_moe<<<(unsigned)R, 256, 0, stream>>>((const bf16_t*)(ws + WS_YB), B.nMoe, 0.08f, res + 2 * (k++)); }
        if (ph == 10) { CMP(d_out, 0, DM, 0, nOut, DM, 0, DM, 0, 0, 0.03f); }
#endif
    }
#ifdef MK_DEBUG
#undef CMP
#undef CWT
    dbg::k_finalize<<<1024, 256, 0, stream>>>((float*)d_out, (size_t)NTOK * DM, res, k, MK_DBG_MODE, MK_DBG_WHICH);
#endif
#endif
}
```

```cpp
#include <hip/hip_runtime.h>
#include <hip/hip_cooperative_groups.h>
#include <cstdio>
#include <cstdint>
namespace cg = cooperative_groups;

#define GAS __attribute__((address_space(1)))
#define LAS __attribute__((address_space(3)))
typedef unsigned short bf16_t;
typedef short bf16x8 __attribute__((ext_vector_type(8)));
typedef float f32x4 __attribute__((ext_vector_type(4)));
typedef float f32x16 __attribute__((ext_vector_type(16)));
typedef float f32x2 __attribute__((ext_vector_type(2)));
typedef unsigned u32x4 __attribute__((ext_vector_type(4)));
typedef unsigned u32x2 __attribute__((ext_vector_type(2)));
typedef __bf16 bf16x2v __attribute__((ext_vector_type(2)));
#define DI __device__ __forceinline__
#define RLX_AGENT __ATOMIC_RELAXED, __HIP_MEMORY_SCOPE_AGENT
#define LDS_WAIT() asm volatile("s_waitcnt lgkmcnt(0)" ::: "memory")
#define VM_WAIT() asm volatile("s_waitcnt vmcnt(0)" ::: "memory")

DI unsigned pk2(float lo, float hi) { f32x2 v = {lo, hi}; bf16x2v r = __builtin_convertvector(v, bf16x2v); return __builtin_bit_cast(unsigned, r); }
DI float bflo(unsigned w) { return __uint_as_float(w << 16); }
DI float bfhi(unsigned w) { return __uint_as_float(w & 0xffff0000u); }
DI float fsigm(float x) { return __builtin_amdgcn_rcpf(1.f + __builtin_amdgcn_exp2f(-1.4426950408889634f * x)); }
DI float gelu_t(float x) { const float z = 1.5957691216057308f * (x + 0.044715f * x * x * x); return x * fsigm(z); }
DI float wave_sum(float v) {
#pragma unroll
    for (int o = 1; o < 64; o <<= 1) v += __shfl_xor(v, o);
    return v;
}

constexpr int DM = 2048, SEQ = 8192, NTOK = 16384, NMETA = 16, INW = 6144, PW = 1024, SW = 1024, FF = 512, NE = 64;
constexpr int NCH = 64, CHL = 128;
constexpr int LISTCAP = 16384;
constexpr int HH_ROWS = 49152;
constexpr float RMS_EPS = 1e-6f;
constexpr size_t MiB = 1u << 20;
constexpr size_t WS_CTL = 0, CTL_ZERO_BYTES = 1 * MiB;
constexpr size_t WS_LAM = 1 * MiB, WS_LAMP = WS_LAM + 65536, WS_BCAT = WS_LAM + 262144, WS_CCATT = WS_LAM + 524288, WS_WRH = WS_LAM + 786432, WS_WRL = WS_WRH + 393216,
                 WS_A1M = WS_WRL + 393216, WS_SCR = WS_A1M + 65536, WS_RSTD1 = WS_SCR + 65536, WS_IG = WS_RSTD1 + 65536, WS_E = 3 * MiB, WS_LIST = 8 * MiB;
constexpr size_t WS_WIN = 24 * MiB, WS_POOLW = 48 * MiB, WS_WGLU = 49 * MiB, WS_WBP = 51 * MiB, WS_WBS = 55 * MiB, WS_WOUT = 59 * MiB, WS_WGU = 68 * MiB, WS_WD = 324 * MiB;
constexpr size_t WS_A1 = 452 * MiB, WS_V = WS_A1;
constexpr size_t WS_ZP = 516 * MiB, WS_ZS = 549 * MiB, WS_DD = 582 * MiB, WS_PP = 614 * MiB, WS_S0 = 646 * MiB, WS_SS = 678 * MiB, WS_HH = 516 * MiB, WS_DL = WS_DD;
constexpr size_t WS_GP = 710 * MiB, WS_GS = 774 * MiB, WS_YB = 710 * MiB, WS_MP = 838 * MiB, WS_DBG = 902 * MiB, WS_END = 1024 * MiB;
static_assert(WS_IG + 8192 <= WS_E && WS_E + (size_t)64 * 64 * 64 * 16 <= WS_LIST && WS_LIST + (size_t)NE * LISTCAP * 16 <= WS_WIN, "small region");
static_assert(WS_HH + (size_t)HH_ROWS * FF * 2 <= WS_GP && WS_YB + (size_t)32768 * DM * 2 <= WS_MP, "overlays");
constexpr int CW_BAR = 4096;
constexpr int CW_BAR2 = 8192;
#ifndef CNT_STRIDE
#define CNT_STRIDE 32
#endif
constexpr int CW_CNT = 16384;
constexpr int CW_DBG = 20480;
constexpr int CW_Q = 24576;

#define XB_TMO      128
#define XB_XCNT(j)  (256  + 64 * (j))
#define XB_XSUB(j)  (1280 + 64 * (j))
#define XB_XGEN(j)  (2304 + 64 * (j))
#define XB_TOP      3328
#define XB_TOPGEN   3392
#define XCD_BAR_WORDS 3456
#define XB_SPIN_CAP (1u << 18)
DI unsigned xb_ld(unsigned* p)              { return __hip_atomic_load(p, __ATOMIC_RELAXED, __HIP_MEMORY_SCOPE_AGENT); }
DI unsigned xb_add(unsigned* p, unsigned v) { return __hip_atomic_fetch_add(p, v, __ATOMIC_RELAXED, __HIP_MEMORY_SCOPE_AGENT); }
DI unsigned xb_xcc_id() { return (unsigned)__builtin_amdgcn_s_getreg((3 << 11) | 20) & 0xFu; }
#define XB_SPIN(cond, bar) do { unsigned _sp = 0; while (cond) { __builtin_amdgcn_s_sleep(1); \
    if ((++_sp & 255u) == 0u) { if (xb_ld(&(bar)[XB_TMO])) break; if (_sp > XB_SPIN_CAP) { atomicAdd(&(bar)[XB_TMO], 1u); break; } } } } while (0)
struct XcdBarrier { unsigned* bar; unsigned x; volatile LAS unsigned* st; unsigned expected; };
DI XcdBarrier xcd_barrier_post(unsigned* bar, volatile LAS unsigned* st, unsigned expected) {
    XcdBarrier b; b.bar = bar; b.x = xb_xcc_id(); b.st = st; b.expected = expected;
    if (threadIdx.x == 0) (void)xb_add(&bar[XB_XCNT(b.x)], 1u);
    return b;
}
DI void xcd_barrier_complete(unsigned* bar, unsigned x, unsigned& nloc, unsigned& nx, unsigned G) {
    unsigned sum, cnt, mine, sp = 0u;
    for (;;) {
        sum = 0u; cnt = 0u; mine = 0u;
#pragma unroll
        for (unsigned j = 0; j < 16; ++j) { const unsigned c = xb_ld(&bar[XB_XCNT(j)]); sum += c; cnt += (c > 0u) ? 1u : 0u; mine = (j == x) ? c : mine; }
        if (sum == G) break;
        __builtin_amdgcn_s_sleep(1);
        if ((++sp & 255u) == 0u) { if (xb_ld(&bar[XB_TMO])) break; if (sp > XB_SPIN_CAP) { atomicAdd(&bar[XB_TMO], 1u); break; } }
    }
    nloc = mine > 0u ? mine : 1u; nx = cnt > 0u ? cnt : 1u;
}
DI void xcd_barrier(const XcdBarrier& b) {
    asm volatile("s_waitcnt vmcnt(0)" ::: "memory");
    __syncthreads();
    if (threadIdx.x == 0) {
        unsigned* bar = b.bar;
        __builtin_amdgcn_s_waitcnt(0);
        unsigned nloc = b.st[0], nx = b.st[1];
        if (nloc == 0u) { xcd_barrier_complete(bar, b.x, nloc, nx, b.expected); b.st[0] = nloc; b.st[1] = nx; }
        const unsigned old = xb_add(&bar[XB_XSUB(b.x)], 1u);
        const unsigned gen = old / nloc;
        if (old + 1u == (gen + 1u) * nloc) {
            __builtin_amdgcn_fence(__ATOMIC_RELEASE, "agent");
            asm volatile("s_waitcnt vmcnt(0)" ::: "memory");
            const unsigned og = xb_add(&bar[XB_TOP], 1u);
            const unsigned tg = og / nx;
            if (og + 1u == (tg + 1u) * nx) xb_add(&bar[XB_TOPGEN], 1u);
            else XB_SPIN(xb_ld(&bar[XB_TOPGEN]) == tg, bar);
            __builtin_amdgcn_fence(__ATOMIC_ACQUIRE, "agent");
            xb_add(&bar[XB_XGEN(b.x)], 1u);
            asm volatile("s_waitcnt vmcnt(0)" ::: "memory");
        } else {
            XB_SPIN(xb_ld(&bar[XB_XGEN(b.x)]) == gen, bar);
            __builtin_amdgcn_fence(__ATOMIC_ACQUIRE, "agent");
            asm volatile("s_waitcnt vmcnt(0)" ::: "memory");
        }
    }
    __syncthreads();
}

namespace pg8 {
constexpr int BM = 256, BK = 64, HALF = 128, HTB = HALF * BK * 2, STAGE_BYTES = 8 * HTB, NXCD = 8, WGM = 8;
__host__ __device__ __forceinline__ int lds_byte(int r, int c) { const int st = (r >> 4) * 2 + (c >> 5), rr = r & 15, cc = c & 31, ob = rr * 64 + cc * 2; return st * 1024 + (ob ^ (((ob >> 9) & 1) << 5)); }
__host__ __device__ __forceinline__ void stage_rc(int b, int& R, int& C) { const int st = b / 1024, sb = b % 1024, swz = sb ^ (((sb >> 9) & 1) << 5); R = (st >> 1) * 16 + swz / 64; C = (st & 1) * 32 + (swz % 64) / 2; }
__host__ __device__ __forceinline__ int perm32(int rho) { const int n = rho >> 4, i = rho & 15; return 8 * (i >> 2) + 4 * n + (i & 3); }

struct Unit { const char* A; const char* B; int pm, pn, e, cnt; const uint4* list; };
struct Gemm { int lda, ldb, K; };

struct GridOrder {
    int nM, nN, nwg, G, c;
    DI void init(int nM_, int nN_, int G_, int c_) { nM = nM_; nN = nN_; nwg = nM * nN; G = G_; c = c_; }
    DI bool tile(int i, int& pm, int& pn) const {
        const long L = (long)i * G + c; if (L >= nwg) return false;
        int wgid = (int)L; { const int q = nwg / NXCD, r = nwg % NXCD, xcd = wgid % NXCD, off = wgid / NXCD; wgid = (xcd < r ? xcd * (q + 1) : r * (q + 1) + (xcd - r) * q) + off; }
        const int nig = WGM * nN, gid = wgid / nig, fm = gid * WGM, gsz = (nM - fm) < WGM ? (nM - fm) : WGM;
        pm = fm + ((wgid % nig) % gsz); pn = (wgid % nig) / gsz; return true;
    }
};
struct DenseOrder : GridOrder {
    static constexpr bool GATHER = false;
    const char* A; const char* Bt; size_t tstepA, tstepB;
    DI void setup(const void* A_, const void* Bt_, int M, int N, int lda, int ldb, int G_, int c_) { init(M / BM, N / BM, G_, c_); A = (const char*)A_; Bt = (const char*)Bt_; tstepA = (size_t)BM * lda * 2; tstepB = (size_t)BM * ldb * 2; }
    DI bool next(int i, Unit& u) const { int pm, pn; if (!tile(i, pm, pn)) return false; u.pm = pm; u.pn = pn; u.e = 0; u.cnt = 256; u.list = nullptr; u.A = A + (size_t)pm * tstepA; u.B = Bt + (size_t)pn * tstepB; return true; }
};

constexpr int SIDE_I_GU = 64 * 32 * 16, SIDE_I_DN = 64 * 8 * 64, SIDE_ITEMS = 2 * SIDE_I_GU + SIDE_I_DN;
struct SideNone { static constexpr bool ON = false; };
struct SideConv {
    static constexpr bool ON = true;
    const float *wg, *wu, *wd; bf16_t *WGU, *WD, *scratch; LAS unsigned char* xb;
    int next, end, stride;
    bf16_t* dst0; bf16_t* dst1; int ldt0, ldt1;
    DI void init(const float* wg_, const float* wu_, const float* wd_, bf16_t* WGU_, bf16_t* WD_, bf16_t* scratch_, LAS unsigned char* xb_, int begin, int end_, int stride_) {
        wg = wg_; wu = wu_; wd = wd_; WGU = WGU_; WD = WD_; scratch = scratch_; xb = xb_; next = begin; end = end_; stride = stride_; dst0 = scratch_; dst1 = scratch_; ldt0 = 0; ldt1 = 0; }
    template <int SLOT> DI void issue(int wid, int lane) {
#ifndef SIDE_PROBE
#define SIDE_PROBE 0
#endif
        int idx = next; bool valid = idx < end; if (valid) next += stride; else idx = 0;
        if (SIDE_PROBE == 2) idx = 0;
        const float* W; int ldw, k0, n0, ldt, drow0; bf16_t* WT;
        if (idx < 2 * SIDE_I_GU) { const int up = idx / SIDE_I_GU, q = idx % SIDE_I_GU, e = q >> 9, q2 = q & 511, kb = q2 >> 4, nb = q2 & 15; n0 = 32 * nb; k0 = 64 * kb;
            W = (up ? wu : wg) + (size_t)e * 2048 * 512; ldw = 512; WT = WGU + (size_t)e * 1024 * 2048; ldt = 2048; drow0 = (n0 >> 7) * 256 + (n0 & 127) + up * 128; }
        else { const int r = idx - 2 * SIDE_I_GU, e = r >> 9, q2 = r & 511, kb = q2 >> 6, nb = q2 & 63; n0 = 32 * nb; k0 = 64 * kb;
            W = wd + (size_t)e * 512 * 2048; ldw = 2048; WT = WD + (size_t)e * 2048 * 512; ldt = 512; drow0 = n0; }
        const float* src = W + (size_t)(k0 + 8 * wid + (lane >> 3)) * ldw + n0 + (lane & 7) * 4;
        __builtin_amdgcn_global_load_lds((const unsigned*)src, (LAS unsigned*)(xb + SLOT * 8192 + wid * 1024), 16, 0, 0);
        if (SIDE_PROBE == 1 || SIDE_PROBE == 2) valid = false;
        bf16_t* d = valid ? WT + (size_t)drow0 * ldt + k0 : scratch; const int l2 = valid ? ldt : 0;
        if (SLOT == 0) { dst0 = d; ldt0 = l2; } else { dst1 = d; ldt1 = l2; }
    }
    template <int SLOT> DI void read(int tid, f32x4& v) const {
        const LAS float* xf = (const LAS float*)(xb + SLOT * 8192) + (tid >> 5) * 128 + (tid & 31);
        v[0] = xf[0]; v[1] = xf[32]; v[2] = xf[64]; v[3] = xf[96];
    }
    template <int SLOT> DI void store(int tid, const f32x4& v) const {
        bf16_t* d = (SLOT == 0 ? dst0 : dst1) + (size_t)(tid & 31) * (SLOT == 0 ? ldt0 : ldt1) + 4 * (tid >> 5);
        u32x2 w; w.x = pk2(v[0], v[1]); w.y = pk2(v[2], v[3]); *(u32x2*)d = w;
    }
};

template <class Epi, class Sched, bool ALIGN_EPI = false, bool SP2 = true, class Side = SideNone>
__device__ __forceinline__ void gemm_phase(LAS unsigned char* lds, const Gemm g, const Sched& S, const Epi& E, Side side = Side()) {
    const int tid = threadIdx.x, wid = __builtin_amdgcn_readfirstlane(tid >> 6), lane = tid & 63, wr = wid >> 2, wc = wid & 3, fr = lane & 15, fq = lane >> 4;
    const int K = g.K, nt = K / BK;
    unsigned voffB[2], oA0[2], oA1[2], nA0[2], nA1[2]; int sR[2], sC[2];
    const size_t kstep = (size_t)(BK * 2);
    const unsigned hstepA = (unsigned)HALF * g.lda * 2u; const size_t hstepB = (size_t)HALF * g.ldb * 2;
#pragma unroll
    for (int i = 0; i < 2; ++i) { int R, C; stage_rc(tid * 16 + i * 8192, R, C); const int Rb = Epi::PERM ? ((R & ~31) + perm32(R & 31)) : R; sR[i] = R; sC[i] = C;
        voffB[i] = (unsigned)(Rb * g.ldb + C) * 2u; oA0[i] = (unsigned)(R * g.lda + C) * 2u; oA1[i] = oA0[i] + hstepA; nA0[i] = oA0[i]; nA1[i] = oA1[i]; }
    const unsigned ldsw = (unsigned)wid * 1024u;
    const int aoff = lds_byte(wr * 64 + fr, fq * 8), boff = lds_byte(wc * 32 + fr, fq * 8);
#define PG8_SA(b, h) (((b) * 2 + (h)) * HTB)
#define PG8_SB(b, h) ((4 + (b) * 2 + (h)) * HTB)
#define PG8_STAGE(bufoff, gbase, voff) do { _Pragma("unroll") for (int _i = 0; _i < 2; ++_i) \
        __builtin_amdgcn_global_load_lds((const unsigned*)((const char*)(gbase) + (voff)[_i]), (LAS unsigned*)(lds + (bufoff) + ldsw + _i * 8192), 16, 0, 0); } while (0)
#define PG8_LDA(dst, b, h) do { _Pragma("unroll") for (int m = 0; m < 4; ++m) _Pragma("unroll") for (int k = 0; k < 2; ++k) dst[m][k] = *(const LAS bf16x8*)(lds + PG8_SA(b, h) + aoff + m * 2048 + k * 1024); } while (0)
#define PG8_LDB(dst, b, h) do { _Pragma("unroll") for (int n = 0; n < 2; ++n) _Pragma("unroll") for (int k = 0; k < 2; ++k) dst[n][k] = *(const LAS bf16x8*)(lds + PG8_SB(b, h) + boff + n * 2048 + k * 1024); } while (0)
#define PG8_MMA(ai, bj, At, Bt) do { __builtin_amdgcn_s_setprio(1); _Pragma("unroll") for (int m = 0; m < 4; ++m) _Pragma("unroll") for (int n = 0; n < 2; ++n) _Pragma("unroll") for (int k = 0; k < 2; ++k) \
        acc[ai][bj][m][n] = __builtin_amdgcn_mfma_f32_16x16x32_bf16(Bt[n][k], At[m][k], acc[ai][bj][m][n], 0, 0, 0); __builtin_amdgcn_s_setprio(0); } while (0)
#define PG8_WAIT_V(n) asm volatile("s_waitcnt vmcnt(" #n ")" ::: "memory")
#define PG8_WAIT_L(n) asm volatile("s_waitcnt lgkmcnt(" #n ")" ::: "memory")
#define PG8_BAR __builtin_amdgcn_s_barrier()
#define PG8_SCHED __builtin_amdgcn_sched_barrier(0)
#define PG8_GOFF(u, d0, d1) do { _Pragma("unroll") for (int _i = 0; _i < 2; ++_i) { \
        const unsigned _t0 = (u).list[sR[_i]].x, _t1 = (u).list[HALF + sR[_i]].x; d0[_i] = (_t0 * (unsigned)g.lda + (unsigned)sC[_i]) * 2u; d1[_i] = (_t1 * (unsigned)g.lda + (unsigned)sC[_i]) * 2u; } } while (0)
    Unit cur, nxt; int ui = 0;
    if (!S.next(0, cur)) return;
    f32x4 acc[2][2][4][2];
#pragma unroll
    for (int a = 0; a < 2; ++a)
#pragma unroll
        for (int b = 0; b < 2; ++b)
#pragma unroll
            for (int m = 0; m < 4; ++m)
#pragma unroll
                for (int n = 0; n < 2; ++n) acc[a][b][m][n] = (f32x4){0.f, 0.f, 0.f, 0.f};
    bf16x8 At[4][2], B0[2][2], B1[2][2];
    const char* cA = cur.A; const char* cB = cur.B;
    if constexpr (Sched::GATHER) { PG8_GOFF(cur, oA0, oA1); }
    if constexpr (SP2) {
        PG8_STAGE(PG8_SB(0, 0), cB, voffB); PG8_STAGE(PG8_SB(0, 1), cB + hstepB, voffB); PG8_STAGE(PG8_SA(0, 0), cA, oA0); PG8_STAGE(PG8_SA(0, 1), cA, oA1);
        if (wr == 1) PG8_BAR;
        PG8_WAIT_V(2); PG8_BAR;
        PG8_STAGE(PG8_SB(1, 0), cB + kstep, voffB); PG8_STAGE(PG8_SA(1, 0), cA + kstep, oA0); PG8_STAGE(PG8_SB(1, 1), cB + hstepB + kstep, voffB);
        PG8_WAIT_V(6); PG8_BAR;
    } else {
        PG8_STAGE(PG8_SB(0, 0), cB, voffB); PG8_STAGE(PG8_SA(0, 0), cA, oA0); PG8_STAGE(PG8_SB(0, 1), cB + hstepB, voffB); PG8_STAGE(PG8_SA(0, 1), cA, oA1);
        if (wr == 1) PG8_BAR;
        PG8_WAIT_V(4); PG8_BAR;
        PG8_STAGE(PG8_SB(1, 0), cB + kstep, voffB); PG8_STAGE(PG8_SA(1, 0), cA + kstep, oA0); PG8_STAGE(PG8_SB(1, 1), cB + hstepB + kstep, voffB);
        PG8_WAIT_V(6); PG8_BAR;
    }
    for (;;) {
        const bool has_next = S.next(ui + 1, nxt);
        const char* nA = has_next ? nxt.A : cA; const char* nB = has_next ? nxt.B : cB;
        if constexpr (Sched::GATHER) { if (has_next) { PG8_GOFF(nxt, nA0, nA1); } else {
#pragma unroll
            for (int i = 0; i < 2; ++i) { nA0[i] = oA0[i]; nA1[i] = oA1[i]; } } }
#pragma nounroll
        for (int t = 0; t < nt; t += 2) {
            const bool last = (t == nt - 2);
            const char* a1 = cA + (size_t)(t + 1) * kstep;
            const char* a2 = last ? nA : cA + (size_t)(t + 2) * kstep; const char* b2 = last ? nB : cB + (size_t)(t + 2) * kstep;
            const char* a3 = a2 + kstep; const char* b3 = b2 + kstep;
            unsigned q0[2], q1[2];
#pragma unroll
            for (int i = 0; i < 2; ++i) { q0[i] = (Sched::GATHER && last) ? nA0[i] : oA0[i]; q1[i] = (Sched::GATHER && last) ? nA1[i] : oA1[i]; }
            if constexpr (SP2) {
            if constexpr (Side::ON) {
            f32x4 sv;
            PG8_LDB(B0, 0, 0); PG8_LDB(B1, 0, 1); PG8_SCHED; PG8_LDA(At, 0, 0); PG8_STAGE(PG8_SA(1, 1), a1, oA1); side.template read<0>(tid, sv);
            PG8_WAIT_V(9); PG8_WAIT_L(0); PG8_BAR; PG8_MMA(0, 0, At, B0); side.template store<0>(tid, sv); PG8_MMA(0, 1, At, B1); PG8_BAR; PG8_SCHED;
            PG8_LDA(At, 0, 1); PG8_STAGE(PG8_SB(0, 0), b2, voffB); PG8_STAGE(PG8_SB(0, 1), b2 + hstepB, voffB); PG8_STAGE(PG8_SA(0, 0), a2, q0);
            PG8_WAIT_V(9); PG8_WAIT_L(0); PG8_BAR; PG8_MMA(1, 0, At, B0); side.template issue<0>(wid, lane); PG8_MMA(1, 1, At, B1); PG8_BAR; PG8_SCHED;
            PG8_LDB(B0, 1, 0); PG8_LDB(B1, 1, 1); PG8_SCHED; PG8_LDA(At, 1, 0); PG8_STAGE(PG8_SA(0, 1), a2, q1); side.template read<1>(tid, sv);
            PG8_WAIT_V(9); PG8_WAIT_L(0); PG8_BAR; PG8_MMA(0, 0, At, B0); side.template store<1>(tid, sv); PG8_MMA(0, 1, At, B1); PG8_BAR; PG8_SCHED;
            PG8_LDA(At, 1, 1); PG8_STAGE(PG8_SB(1, 0), b3, voffB); PG8_STAGE(PG8_SB(1, 1), b3 + hstepB, voffB); PG8_STAGE(PG8_SA(1, 0), a3, q0);
            PG8_WAIT_V(9); PG8_WAIT_L(0); PG8_BAR; PG8_MMA(1, 0, At, B0); side.template issue<1>(wid, lane); PG8_MMA(1, 1, At, B1); PG8_BAR; PG8_SCHED;
            } else {
            PG8_LDB(B0, 0, 0); PG8_LDB(B1, 0, 1); PG8_SCHED; PG8_LDA(At, 0, 0); PG8_STAGE(PG8_SA(1, 1), a1, oA1);
            PG8_WAIT_V(8); PG8_WAIT_L(0); PG8_BAR; PG8_MMA(0, 0, At, B0); PG8_MMA(0, 1, At, B1); PG8_BAR; PG8_SCHED;
            PG8_LDA(At, 0, 1); PG8_STAGE(PG8_SB(0, 0), b2, voffB); PG8_STAGE(PG8_SB(0, 1), b2 + hstepB, voffB); PG8_STAGE(PG8_SA(0, 0), a2, q0);
            PG8_WAIT_V(8); PG8_WAIT_L(0); PG8_BAR; PG8_MMA(1, 0, At, B0); PG8_MMA(1, 1, At, B1); PG8_BAR; PG8_SCHED;
            PG8_LDB(B0, 1, 0); PG8_LDB(B1, 1, 1); PG8_SCHED; PG8_LDA(At, 1, 0); PG8_STAGE(PG8_SA(0, 1), a2, q1);
            PG8_WAIT_V(8); PG8_WAIT_L(0); PG8_BAR; PG8_MMA(0, 0, At, B0); PG8_MMA(0, 1, At, B1); PG8_BAR; PG8_SCHED;
            PG8_LDA(At, 1, 1); PG8_STAGE(PG8_SB(1, 0), b3, voffB); PG8_STAGE(PG8_SB(1, 1), b3 + hstepB, voffB); PG8_STAGE(PG8_SA(1, 0), a3, q0);
            PG8_WAIT_V(8); PG8_WAIT_L(0); PG8_BAR; PG8_MMA(1, 0, At, B0); PG8_MMA(1, 1, At, B1); PG8_BAR; PG8_SCHED;
            }
            } else {
            PG8_LDB(B0, 0, 0); PG8_SCHED; PG8_LDA(At, 0, 0); PG8_STAGE(PG8_SA(1, 1), a1, oA1);
            PG8_WAIT_L(8); PG8_BAR; PG8_WAIT_L(0); PG8_MMA(0, 0, At, B0); PG8_BAR; PG8_SCHED;
            PG8_LDB(B1, 0, 1); PG8_STAGE(PG8_SB(0, 0), b2, voffB);
            PG8_BAR; PG8_WAIT_L(0); PG8_MMA(0, 1, At, B1); PG8_BAR;
            PG8_LDA(At, 0, 1); PG8_STAGE(PG8_SA(0, 0), a2, q0);
            PG8_BAR; PG8_WAIT_L(0); PG8_MMA(1, 0, At, B0); PG8_BAR; PG8_SCHED;
            PG8_STAGE(PG8_SB(0, 1), b2 + hstepB, voffB);
            PG8_WAIT_V(6); PG8_BAR; PG8_MMA(1, 1, At, B1); PG8_BAR;
            PG8_LDB(B0, 1, 0); PG8_SCHED; PG8_LDA(At, 1, 0); PG8_STAGE(PG8_SA(0, 1), a2, q1);
            PG8_WAIT_L(8); PG8_BAR; PG8_WAIT_L(0); PG8_MMA(0, 0, At, B0); PG8_BAR; PG8_SCHED;
            PG8_LDB(B1, 1, 1); PG8_STAGE(PG8_SB(1, 0), b3, voffB);
            PG8_BAR; PG8_WAIT_L(0); PG8_MMA(0, 1, At, B1); PG8_BAR;
            PG8_LDA(At, 1, 1); PG8_STAGE(PG8_SA(1, 0), a3, q0);
            PG8_BAR; PG8_WAIT_L(0); PG8_MMA(1, 0, At, B0); PG8_BAR; PG8_SCHED;
            PG8_STAGE(PG8_SB(1, 1), b3 + hstepB, voffB);
            PG8_WAIT_V(6); PG8_BAR; PG8_MMA(1, 1, At, B1); PG8_BAR;
            }
        }
        if constexpr (ALIGN_EPI) { if (wr == 0) PG8_BAR; }
#ifndef PROBE_EPI2
#define PROBE_EPI2 0
#endif
        E(acc, cur, wr, wc, fr, fq);
        if (((PROBE_EPI2 >> Epi::EID) & 1) && Epi::IDEMPOTENT) { asm volatile("" ::: "memory"); E(acc, cur, wr, wc, fr, fq); }
        if (!has_next) break;
        if (!Epi::keep_acc(cur)) {
#pragma unroll
        for (int a = 0; a < 2; ++a)
#pragma unroll
            for (int b = 0; b < 2; ++b)
#pragma unroll
                for (int m = 0; m < 4; ++m)
#pragma unroll
                    for (int n = 0; n < 2; ++n) acc[a][b][m][n] = (f32x4){0.f, 0.f, 0.f, 0.f};
        }
        cur = nxt; cA = nA; cB = nB; ++ui;
        if constexpr (Sched::GATHER) {
#pragma unroll
            for (int i = 0; i < 2; ++i) { oA0[i] = nA0[i]; oA1[i] = nA1[i]; } }
        if constexpr (ALIGN_EPI) { if (wr == 1) PG8_BAR; }
    }
    PG8_WAIT_V(0);
    if constexpr (!ALIGN_EPI) { if (wr == 0) PG8_BAR; }
    PG8_BAR;
    if constexpr (Side::ON) { f32x4 s0, s1; side.template read<0>(tid, s0); side.template read<1>(tid, s1); PG8_WAIT_L(0); side.template store<0>(tid, s0); side.template store<1>(tid, s1); PG8_WAIT_V(0); PG8_BAR; }
#undef PG8_SA
#undef PG8_SB
#undef PG8_STAGE
#undef PG8_LDA
#undef PG8_LDB
#undef PG8_MMA
#undef PG8_WAIT_V
#undef PG8_WAIT_L
#undef PG8_BAR
#undef PG8_SCHED
#undef PG8_GOFF
}
}
#ifndef YB_FP8
#define YB_FP8 1
#endif
namespace pg8 {
#ifndef NT_STORES
#define NT_STORES 0
#endif
#if NT_STORES == 1
#define ST16(p, v) __builtin_nontemporal_store((v), (p))
#elif NT_STORES == 2
DI void st16_sc1(u32x4* p, const u32x4& v) { asm volatile("global_store_dwordx4 %0, %1, off sc1\n\ts_nop 1" :: "v"(p), "v"(v) : "memory"); }
#define ST16(p, v) st16_sc1((p), (v))
#else
#define ST16(p, v) (*(p) = (v))
#endif
typedef f32x4 Acc[2][2][4][2];
DI u32x4 pack8(const f32x4& v0, const f32x4& v1) { u32x4 w; w.x = pk2(v0[0], v0[1]); w.y = pk2(v0[2], v0[3]); w.z = pk2(v1[0], v1[1]); w.w = pk2(v1[2], v1[3]); return w; }
DI void unpack8(const u32x4& w, f32x4& v0, f32x4& v1) { v0 = (f32x4){bflo(w.x), bfhi(w.x), bflo(w.y), bfhi(w.y)}; v1 = (f32x4){bflo(w.z), bfhi(w.z), bflo(w.w), bfhi(w.w)}; }

DI unsigned pack_u8x4(const f32x4& g, float lo) { unsigned w = 0;
    w = __builtin_amdgcn_cvt_pk_u8_f32(fmaxf(__builtin_floorf(255.f * g[0] + 0.5f), lo), 0, w); w = __builtin_amdgcn_cvt_pk_u8_f32(fmaxf(__builtin_floorf(255.f * g[1] + 0.5f), lo), 1, w);
    w = __builtin_amdgcn_cvt_pk_u8_f32(fmaxf(__builtin_floorf(255.f * g[2] + 0.5f), lo), 2, w); w = __builtin_amdgcn_cvt_pk_u8_f32(fmaxf(__builtin_floorf(255.f * g[3] + 0.5f), lo), 3, w); return w; }
DI f32x4 unpack_u8x4(unsigned w) { return (f32x4){(float)(w & 0xffu), (float)((w >> 8) & 0xffu), (float)((w >> 16) & 0xffu), (float)(w >> 24)}; }
struct EpiZ {
    static DI bool keep_acc(const Unit&) { return false; }
    static constexpr bool PERM = true, IDEMPOTENT = true; static constexpr int EID = 0;
    bf16_t *ZP, *ZS; unsigned char *GP, *GS;
    DI void operator()(Acc& acc, const Unit& u, int wr, int wc, int fr, int fq) const {
        const int pn = u.pn; const int row0 = u.pm * BM + wr * 64 + fr;
        if (pn < 8) {
            bf16_t* base = pn < 4 ? ZP : ZS; const int col0 = (pn & 3) * 256 + wc * 32 + 8 * fq;
#pragma unroll
            for (int ai = 0; ai < 2; ++ai)
#pragma unroll
                for (int m = 0; m < 4; ++m) { bf16_t* rowp = base + (size_t)(row0 + ai * HALF + m * 16) * PW + col0;
#pragma unroll
                    for (int bj = 0; bj < 2; ++bj) ST16((u32x4*)(rowp + bj * HALF), pack8(acc[ai][bj][m][0], acc[ai][bj][m][1])); }
        } else {
            unsigned char* base = pn < 16 ? GP : GS; const float lo = pn < 16 ? 0.f : 1.f; const int col0 = (pn & 7) * 256 + wc * 32 + 8 * fq;
#pragma unroll
            for (int ai = 0; ai < 2; ++ai)
#pragma unroll
                for (int m = 0; m < 4; ++m) { unsigned char* rowp = base + (size_t)(row0 + ai * HALF + m * 16) * DM + col0;
#pragma unroll
                    for (int bj = 0; bj < 2; ++bj) { f32x4 v0 = acc[ai][bj][m][0], v1 = acc[ai][bj][m][1];
#pragma unroll
                        for (int j = 0; j < 4; ++j) { v0[j] = fsigm(v0[j]); v1[j] = fsigm(v1[j]); }
                        *(u32x2*)(rowp + bj * HALF) = (u32x2){pack_u8x4(v0, lo), pack_u8x4(v1, lo)}; } }
        }
    }
};
struct EpiPool {
    static DI bool keep_acc(const Unit&) { return false; }
    static constexpr bool PERM = true, IDEMPOTENT = true; static constexpr int EID = 1;
    bf16_t* PP; const float* scale;
    DI void operator()(Acc& acc, const Unit& u, int wr, int wc, int fr, int fq) const {
        const int row0 = u.pm * BM + wr * 64 + fr, col0 = u.pn * 256 + wc * 32 + 8 * fq;
        f32x4 sc[2][2];
#pragma unroll
        for (int bj = 0; bj < 2; ++bj) { sc[bj][0] = *(const f32x4*)(scale + col0 + bj * HALF); sc[bj][1] = *(const f32x4*)(scale + col0 + bj * HALF + 4); }
#pragma unroll
        for (int ai = 0; ai < 2; ++ai)
#pragma unroll
            for (int m = 0; m < 4; ++m) { bf16_t* rowp = PP + (size_t)(row0 + ai * HALF + m * 16) * PW + col0;
#pragma unroll
                for (int bj = 0; bj < 2; ++bj) *(u32x4*)(rowp + bj * HALF) = pack8(acc[ai][bj][m][0] * sc[bj][0], acc[ai][bj][m][1] * sc[bj][1]); }
    }
};
struct EpiGlu {
    static DI bool keep_acc(const Unit&) { return false; }
    static constexpr bool PERM = true, IDEMPOTENT = true; static constexpr int EID = 2;
    const bf16_t* S0; bf16_t* SS; const float* bias;
    DI void operator()(Acc& acc, const Unit& u, int wr, int wc, int fr, int fq) const {
        const int row0 = u.pm * BM + wr * 64 + fr, col0 = u.pn * 256 + wc * 32 + 8 * fq;
        f32x4 bv[2][2];
#pragma unroll
        for (int bj = 0; bj < 2; ++bj) { bv[bj][0] = *(const f32x4*)(bias + col0 + bj * HALF); bv[bj][1] = *(const f32x4*)(bias + col0 + bj * HALF + 4); }
#pragma unroll
        for (int ai = 0; ai < 2; ++ai) {
            u32x4 sw[4][2];
#pragma unroll
            for (int m = 0; m < 4; ++m)
#pragma unroll
                for (int bj = 0; bj < 2; ++bj) sw[m][bj] = *(const u32x4*)(S0 + (size_t)(row0 + ai * HALF + m * 16) * SW + col0 + bj * HALF);
#pragma unroll
            for (int m = 0; m < 4; ++m) { const size_t off = (size_t)(row0 + ai * HALF + m * 16) * SW + col0;
#pragma unroll
                for (int bj = 0; bj < 2; ++bj) { f32x4 s0, s1; unpack8(sw[m][bj], s0, s1);
                    f32x4 t0 = acc[ai][bj][m][0] + bv[bj][0], t1 = acc[ai][bj][m][1] + bv[bj][1];
#pragma unroll
                    for (int j = 0; j < 4; ++j) { t0[j] = s0[j] * fsigm(t0[j]); t1[j] = s1[j] * fsigm(t1[j]); }
                    *(u32x4*)(SS + off + bj * HALF) = pack8(t0, t1); } }
            asm volatile("" ::: "memory");
        }
    }
};
template <bool ADD> struct EpiGate {
    static DI bool keep_acc(const Unit&) { return false; }
    static constexpr bool PERM = true, IDEMPOTENT = !ADD; static constexpr int EID = 3;
    const bf16_t* G; bf16_t* MP;
    DI void operator()(Acc& acc, const Unit& u, int wr, int wc, int fr, int fq) const {
        const int row0 = u.pm * BM + wr * 64 + fr, col0 = u.pn * 256 + wc * 32 + 8 * fq;
#pragma unroll
        for (int ai = 0; ai < 2; ++ai)
#pragma unroll
            for (int m = 0; m < 4; ++m) { const size_t off = (size_t)(row0 + ai * HALF + m * 16) * DM + col0;
#pragma unroll
                for (int bj = 0; bj < 2; ++bj) { const u32x4 gw = *(const u32x4*)(G + off + bj * HALF); f32x4 g0, g1; unpack8(gw, g0, g1);
                    f32x4 t0 = acc[ai][bj][m][0] * g0, t1 = acc[ai][bj][m][1] * g1;
                    if (ADD) { const u32x4 pw = *(const u32x4*)(MP + off + bj * HALF); f32x4 p0, p1; unpack8(pw, p0, p1); t0 += p0; t1 += p1; }
                    *(u32x4*)(MP + off + bj * HALF) = pack8(t0, t1); } }
    }
};
struct EpiMerge {
    static DI bool keep_acc(const Unit& u) { return u.e == 0; }
    static constexpr bool PERM = true, IDEMPOTENT = false; static constexpr int EID = 8;
    const unsigned char* GP; const unsigned char* GS; bf16_t* MP;
    DI void operator()(Acc& acc, const Unit& u, int wr, int wc, int fr, int fq) const {
        const int row0 = u.pm * BM + wr * 64 + fr, col0 = u.pn * 256 + wc * 32 + 8 * fq;
        if (u.e == 0) {
#pragma unroll
            for (int ai = 0; ai < 2; ++ai) {
                u32x2 sw[4][2], pw[4][2];
#pragma unroll
                for (int m = 0; m < 4; ++m)
#pragma unroll
                    for (int bj = 0; bj < 2; ++bj) { const size_t off = (size_t)(row0 + ai * HALF + m * 16) * DM + col0 + bj * HALF; sw[m][bj] = *(const u32x2*)(GS + off); pw[m][bj] = *(const u32x2*)(GP + off); }
#pragma unroll
                for (int m = 0; m < 4; ++m)
#pragma unroll
                    for (int bj = 0; bj < 2; ++bj) { const f32x4 s0 = unpack_u8x4(sw[m][bj].x), s1 = unpack_u8x4(sw[m][bj].y), p0 = unpack_u8x4(pw[m][bj].x), p1 = unpack_u8x4(pw[m][bj].y);
#pragma unroll
                        for (int j = 0; j < 4; ++j) { acc[ai][bj][m][0][j] *= p0[j] * __builtin_amdgcn_rcpf(s0[j]); acc[ai][bj][m][1][j] *= p1[j] * __builtin_amdgcn_rcpf(s1[j]); } }
            }
        } else {
            constexpr float I255 = 1.f / 255.f;
#pragma unroll
            for (int ai = 0; ai < 2; ++ai) {
                u32x2 sw[4][2];
#pragma unroll
                for (int m = 0; m < 4; ++m)
#pragma unroll
                    for (int bj = 0; bj < 2; ++bj) sw[m][bj] = *(const u32x2*)(GS + (size_t)(row0 + ai * HALF + m * 16) * DM + col0 + bj * HALF);
#pragma unroll
                for (int m = 0; m < 4; ++m)
#pragma unroll
                    for (int bj = 0; bj < 2; ++bj) { const f32x4 s0 = unpack_u8x4(sw[m][bj].x) * I255, s1 = unpack_u8x4(sw[m][bj].y) * I255;
                        *(u32x4*)(MP + (size_t)(row0 + ai * HALF + m * 16) * DM + col0 + bj * HALF) = pack8(acc[ai][bj][m][0] * s0, acc[ai][bj][m][1] * s1); }
                asm volatile("" ::: "memory");
            }
        }
    }
};
struct MergeOrder : GridOrder {
    static constexpr bool GATHER = false;
    const char *A0, *B0, *A1, *B1; size_t tstepA, tstepB;
    DI bool next(int i, Unit& u) const { int pm, pn; if (!tile(i >> 1, pm, pn)) return false; const int h = i & 1; u.pm = pm; u.pn = pn; u.e = h; u.cnt = 256; u.list = nullptr;
        u.A = (h ? A1 : A0) + (size_t)pm * tstepA; u.B = (h ? B1 : B0) + (size_t)pn * tstepB; return true; }
};
struct EpiDelta {
    static DI bool keep_acc(const Unit&) { return false; }
    static constexpr bool PERM = true, IDEMPOTENT = true; static constexpr int EID = 4;
    bf16_t* DL;
    DI void operator()(Acc& acc, const Unit& u, int wr, int wc, int fr, int fq) const {
        const int row0 = u.pm * BM + wr * 64 + fr, col0 = u.pn * 256 + wc * 32 + 8 * fq;
#pragma unroll
        for (int ai = 0; ai < 2; ++ai)
#pragma unroll
            for (int m = 0; m < 4; ++m) { bf16_t* rowp = DL + (size_t)(row0 + ai * HALF + m * 16) * DM + col0;
#pragma unroll
                for (int bj = 0; bj < 2; ++bj) ST16((u32x4*)(rowp + bj * HALF), pack8(acc[ai][bj][m][0], acc[ai][bj][m][1])); }
    }
};
struct EpiH1 {
    static DI bool keep_acc(const Unit&) { return false; }
    static constexpr bool PERM = true, IDEMPOTENT = false; static constexpr int EID = 9;
    bf16_t* V; const float* rstd1; const float* ig;
    DI void operator()(Acc& acc, const Unit& u, int wr, int wc, int fr, int fq) const {
        const int row0 = u.pm * BM + wr * 64 + fr, col0 = u.pn * 256 + wc * 32 + 8 * fq;
        f32x4 g[2][2];
#pragma unroll
        for (int bj = 0; bj < 2; ++bj) { g[bj][0] = *(const f32x4*)(ig + col0 + bj * HALF); g[bj][1] = *(const f32x4*)(ig + col0 + bj * HALF + 4); }
#pragma unroll
        for (int ai = 0; ai < 2; ++ai) {
            u32x4 uw[4][2]; float inv[4];
#pragma unroll
            for (int m = 0; m < 4; ++m) { const int row = row0 + ai * HALF + m * 16; inv[m] = rstd1[row];
#pragma unroll
                for (int bj = 0; bj < 2; ++bj) uw[m][bj] = *(const u32x4*)(V + (size_t)row * DM + col0 + bj * HALF); }
#pragma unroll
            for (int m = 0; m < 4; ++m) { const float iv = __builtin_amdgcn_rcpf(inv[m]); bf16_t* rowp = V + (size_t)(row0 + ai * HALF + m * 16) * DM + col0;
#pragma unroll
                for (int bj = 0; bj < 2; ++bj) { f32x4 u0, u1; unpack8(uw[m][bj], u0, u1);
                    *(u32x4*)(rowp + bj * HALF) = pack8(u0 * g[bj][0] * iv + acc[ai][bj][m][0], u1 * g[bj][1] * iv + acc[ai][bj][m][1]); } }
            asm volatile("" ::: "memory");
        }
    }
};
struct EpiResid {
    static DI bool keep_acc(const Unit&) { return false; }
    static constexpr bool PERM = false, IDEMPOTENT = true; static constexpr int EID = 5;
    const float* X; float* H1;
    DI void operator()(Acc& acc, const Unit& u, int wr, int wc, int fr, int fq) const {
        const int row0 = u.pm * BM + wr * 64 + fr, col0 = u.pn * 256 + wc * 32 + 4 * fq;
#pragma unroll
        for (int ai = 0; ai < 2; ++ai)
#pragma unroll
            for (int m = 0; m < 4; ++m) { const size_t off = (size_t)(row0 + ai * HALF + m * 16) * DM + col0;
#pragma unroll
                for (int bj = 0; bj < 2; ++bj)
#pragma unroll
                    for (int n = 0; n < 2; ++n) { const f32x4 xv = *(const f32x4*)(X + off + bj * HALF + n * 16); *(f32x4*)(H1 + off + bj * HALF + n * 16) = xv + acc[ai][bj][m][n]; }
                asm volatile("" ::: "memory"); }
    }
};
struct EpiMoeUp {
    static DI bool keep_acc(const Unit&) { return false; }
    static constexpr bool PERM = true, IDEMPOTENT = true; static constexpr int EID = 6;
    bf16_t* HH;
    DI void operator()(Acc& acc, const Unit& u, int wr, int wc, int fr, int fq) const {
        const int col0 = u.pn * 128 + wc * 32 + 8 * fq;
        float rsv[2][4];
#pragma unroll
        for (int ai = 0; ai < 2; ++ai)
#pragma unroll
            for (int m = 0; m < 4; ++m) rsv[ai][m] = __uint_as_float(u.list[ai * HALF + wr * 64 + m * 16 + fr].w);
#pragma unroll
        for (int ai = 0; ai < 2; ++ai)
#pragma unroll
            for (int m = 0; m < 4; ++m) { const int r = ai * HALF + wr * 64 + m * 16 + fr; const float rs = rsv[ai][m];
                f32x4 g0 = acc[ai][0][m][0] * rs, g1 = acc[ai][0][m][1] * rs, u0 = acc[ai][1][m][0] * rs, u1 = acc[ai][1][m][1] * rs;
#pragma unroll
                for (int j = 0; j < 4; ++j) { g0[j] = g0[j] * fsigm(g0[j]) * u0[j]; g1[j] = g1[j] * fsigm(g1[j]) * u1[j]; }
                *(u32x4*)(HH + (size_t)(u.pm + r) * FF + col0) = pack8(g0, g1); }
    }
};
struct EpiMoeDown {
    static DI bool keep_acc(const Unit&) { return false; }
    static constexpr bool PERM = true, IDEMPOTENT = true; static constexpr int EID = 7;
    bf16_t* YB;
    DI void operator()(Acc& acc, const Unit& u, int wr, int wc, int fr, int fq) const {
        const int col0 = u.pn * 256 + wc * 32 + 8 * fq;
        unsigned dstv[2][4]; float wv[2][4];
#pragma unroll
        for (int ai = 0; ai < 2; ++ai)
#pragma unroll
            for (int m = 0; m < 4; ++m) { const uint4* le = u.list + (ai * HALF + wr * 64 + m * 16 + fr); dstv[ai][m] = le->y; wv[ai][m] = __uint_as_float(le->z); }
#pragma unroll
        for (int ai = 0; ai < 2; ++ai)
#pragma unroll
            for (int m = 0; m < 4; ++m) { const int r = ai * HALF + wr * 64 + m * 16 + fr;
#if YB_FP8
                if (r < u.cnt) { const float w = wv[ai][m] * 16.f; unsigned char* rowp = (unsigned char*)YB + (size_t)dstv[ai][m] * DM + col0;
#pragma unroll
                    for (int bj = 0; bj < 2; ++bj) { f32x4 a0 = acc[ai][bj][m][0] * w, a1 = acc[ai][bj][m][1] * w; int lo = 0, hi = 0;
#pragma unroll
                        for (int j = 0; j < 4; ++j) { a0[j] = __builtin_amdgcn_fmed3f(a0[j], -416.f, 416.f); a1[j] = __builtin_amdgcn_fmed3f(a1[j], -416.f, 416.f); }
                        lo = __builtin_amdgcn_cvt_pk_fp8_f32(a0[0], a0[1], lo, false); lo = __builtin_amdgcn_cvt_pk_fp8_f32(a0[2], a0[3], lo, true);
                        hi = __builtin_amdgcn_cvt_pk_fp8_f32(a1[0], a1[1], hi, false); hi = __builtin_amdgcn_cvt_pk_fp8_f32(a1[2], a1[3], hi, true);
                        *(u32x2*)(rowp + bj * HALF) = (u32x2){(unsigned)lo, (unsigned)hi}; } } }
#else
                if (r < u.cnt) { const float w = wv[ai][m]; bf16_t* rowp = YB + (size_t)dstv[ai][m] * DM + col0;
#pragma unroll
                    for (int bj = 0; bj < 2; ++bj) ST16((u32x4*)(rowp + bj * HALF), pack8(acc[ai][bj][m][0] * w, acc[ai][bj][m][1] * w)); } }
#endif
    }
};

struct MoeOrder {
    static constexpr bool GATHER_UP = true;
    const volatile LAS int* tab; int ntn, G, vcu; const uint4* list; const char* Abase; const char* Bbase; size_t bstep_e, bstep_n, astep_row; bool up;
    DI bool decode(int i, Unit& u) const {
        const int U = i * G + vcu; const int lane = threadIdx.x & 63;
        const int total = tab[64];
        if (U >= total) return false;
        const int ce = tab[lane + 1];
        const unsigned long long m = __ballot(ce > U);
        const int e = __builtin_amdgcn_readfirstlane((int)__builtin_ctzll(m));
        const int loc = U - tab[e]; const int mb = loc / ntn, nb = loc % ntn;
        const int cnt = tab[160 + e] - mb * 256;
        u.e = e; u.cnt = cnt < 256 ? cnt : 256; u.pn = nb; u.pm = tab[80 + e] + mb * 256; u.list = list + (size_t)e * LISTCAP + mb * 256;
        u.B = Bbase + (size_t)e * bstep_e + (size_t)nb * bstep_n;
        u.A = up ? Abase : Abase + (size_t)u.pm * astep_row;
        return true;
    }
};
struct MoeUpOrder : MoeOrder { static constexpr bool GATHER = true; DI bool next(int i, Unit& u) const { return decode(i, u); } };
struct MoeDownOrder : MoeOrder { static constexpr bool GATHER = false; DI bool next(int i, Unit& u) const { return decode(i, u); } };
struct PoolOrder : GridOrder {
    static constexpr bool GATHER = false;
    const char* DD; const char* PWT;
    DI bool next(int i, Unit& u) const { int pm, pn; if (!tile(i, pm, pn)) return false; u.pm = pm; u.pn = pn; u.e = 0; u.cnt = 256; u.list = nullptr;
        u.A = DD + ((size_t)pm * 256 * PW + (size_t)pn * 256) * 2; u.B = PWT + (size_t)pn * 65536 * 2; return true; }
};
}
constexpr int NWAVES = 8;
constexpr int RING_BYTES = 131072, XB_OFF = RING_BYTES, MISC_OFF = RING_BYTES + 16384, TAB_OFF = MISC_OFF + 256;
constexpr int LDS_BYTES = RING_BYTES + 2048 + 16384;
#ifndef SIDE_P1
#define SIDE_P1 0
#endif
#ifndef SIDE_P56
#define SIDE_P56 0
#endif
using pg8::SIDE_ITEMS;
constexpr int SIDE_N1 = SIDE_P1 ? 192 * 256 : 0, SIDE_N5 = SIDE_P56 ? 32 * 256 : 0, SIDE_N6 = SIDE_P56 ? 64 * 256 : 0;
#ifndef SIDE_PROBE
#define SIDE_PROBE 0
#endif
#ifndef CONV_PAIRS
#define CONV_PAIRS 49152
#endif
#ifndef NCONV
#define NCONV 64
#endif
#ifndef CV_QFRAC
#define CV_QFRAC 25
#endif
#define CV_GRAB 16
#define CV_STATIC (((2 * CONV_PAIRS) * (100 - CV_QFRAC) / 100) / 512 * 512)
#ifndef TAIL_IN_P8
#define TAIL_IN_P8 0
#endif
constexpr int SIDE_TOTAL = NCONV ? (TAIL_IN_P8 ? SIDE_ITEMS : 2 * CONV_PAIRS) : (SIDE_PROBE ? 0 : SIDE_N1 + 2 * SIDE_N5 + SIDE_N6);
static_assert(!TAIL_IN_P8 || 2 * CONV_PAIRS >= 2 * 64 * 32 * 16, "gate/up weights must be complete before P8");
struct Args { const float* in[28]; float* out; unsigned char* ws; int ph_lo, ph_hi, use_cg, pad; };

struct Ctx {
    LAS unsigned char* lds; unsigned char* ws; int tid, lane, wave, vcu, G, gw, NGW;
};

#define MFMA16(a, b, c) __builtin_amdgcn_mfma_f32_16x16x32_bf16((a), (b), (c), 0, 0, 0)
#define MFMA32(a, b, c) __builtin_amdgcn_mfma_f32_32x32x16_bf16((a), (b), (c), 0, 0, 0)

struct TrItem { const float* W; bf16_t* WT; const float* rs; int ldw, ldt; };
#ifndef RT_AUX
#define RT_AUX 0
#endif
#ifndef FIN_ST_NT
#define FIN_ST_NT 0
#endif
#ifndef FIN_NT
#define FIN_NT 0
#endif
#ifndef P0_NT
#define P0_NT 1
#endif
#ifndef CV_NT
#define CV_NT 1
#endif
template <bool NT = false> DI void tr_load(const TrItem& t, f32x4 (&v)[8], int lane) {
#pragma unroll
    for (int i = 0; i < 8; ++i) { const f32x4* p = (const f32x4*)(t.W + (size_t)(8 * i + (lane >> 3)) * t.ldw + 4 * (lane & 7)); v[i] = NT ? __builtin_nontemporal_load(p) : *p; }
}
template <bool NT = false> DI void tr_finish(const TrItem& t, const f32x4 (&v)[8], LAS float* scr, int lane) {
#pragma unroll
    for (int i = 0; i < 8; ++i) { LAS float* s = scr + (8 * i + (lane >> 3)) * 33 + 4 * (lane & 7); s[0] = v[i].x; s[1] = v[i].y; s[2] = v[i].z; s[3] = v[i].w; }
    LDS_WAIT(); asm volatile("" ::: "memory");
    const int c = lane & 7;
    f32x4 g0 = {1.f, 1.f, 1.f, 1.f}, g1 = g0; if (t.rs) { g0 = *(const f32x4*)(t.rs + 8 * c); g1 = *(const f32x4*)(t.rs + 8 * c + 4); }
#pragma unroll
    for (int j = 0; j < 4; ++j) { const int n = (lane >> 3) + 8 * j; const LAS float* s = scr + (8 * c) * 33 + n;
        u32x4 o; o.x = pk2(s[0 * 33] * g0.x, s[1 * 33] * g0.y); o.y = pk2(s[2 * 33] * g0.z, s[3 * 33] * g0.w); o.z = pk2(s[4 * 33] * g1.x, s[5 * 33] * g1.y); o.w = pk2(s[6 * 33] * g1.z, s[7 * 33] * g1.w);
        if (NT) __builtin_nontemporal_store(o, (u32x4*)(t.WT + (size_t)n * t.ldt + 8 * c)); else *(u32x4*)(t.WT + (size_t)n * t.ldt + 8 * c) = o; }
    LDS_WAIT(); asm volatile("" ::: "memory");
}
DI void norm_regs_bf16(const f32x4 (&v)[8], const float* g, bf16_t* orow, int lane, float* rstd_out) {
    const f32x4* gr = (const f32x4*)g + lane; float s = 0.f;
#pragma unroll
    for (int j = 0; j < 8; ++j) s += (v[j].x * v[j].x + v[j].y * v[j].y) + (v[j].z * v[j].z + v[j].w * v[j].w);
    const float rstd = rsqrtf(wave_sum(s) * (1.f / DM) + RMS_EPS);
    if (rstd_out && lane == 0) *rstd_out = rstd;
    u32x2* o8 = (u32x2*)orow + lane;
#pragma unroll
    for (int j = 0; j < 8; ++j) { const f32x4 gg = gr[64 * j]; u32x2 w; w.x = pk2(v[j].x * rstd * gg.x, v[j].y * rstd * gg.y); w.y = pk2(v[j].z * rstd * gg.z, v[j].w * rstd * gg.w); o8[64 * j] = w; }
}
DI void norm_row_bf16(const float* xrow, const float* g, bf16_t* orow, int lane, float* rstd_out = nullptr) {
    const f32x4* xr = (const f32x4*)xrow + lane; const f32x4* gr = (const f32x4*)g + lane;
    f32x4 v[8]; float s = 0.f;
#pragma unroll
    for (int j = 0; j < 8; ++j) { v[j] = xr[64 * j]; s += (v[j].x * v[j].x + v[j].y * v[j].y) + (v[j].z * v[j].z + v[j].w * v[j].w); }
    const float rstd = rsqrtf(wave_sum(s) * (1.f / DM) + RMS_EPS);
    if (rstd_out && lane == 0) *rstd_out = rstd;
    u32x2* o8 = (u32x2*)orow + lane;
#pragma unroll
    for (int j = 0; j < 8; ++j) { const f32x4 gg = gr[64 * j]; u32x2 w; w.x = pk2(v[j].x * rstd * gg.x, v[j].y * rstd * gg.y); w.y = pk2(v[j].z * rstd * gg.z, v[j].w * rstd * gg.w); o8[64 * j] = w; }
}
DI void p0_prologue(const Ctx& C, const Args& a, int part = 3) {
    unsigned char* ws = C.ws;
    LAS float* scr = (LAS float*)(C.lds + C.wave * 8448);
    LAS float* scrB = (LAS float*)(C.lds + (C.wave < 7 ? 67584 + C.wave * 8448 : XB_OFF));
    constexpr int I_IN = 32 * 192, I_PW = 4 * 32, I_GLU = 16 * 32, I_BR = 16 * 64, I_OUT = 32 * 64, I_GU = 64 * 32 * 16, I_DN = 64 * 8 * 64;
    constexpr int NSMALL = I_IN + I_PW + I_GLU + 2 * I_BR + I_OUT;
    constexpr int NITEMS = NSMALL + (2 * I_GU + I_DN - SIDE_TOTAL);
    auto decode = [&](int it, TrItem& t) {
        int r = it < NSMALL ? it : it + SIDE_TOTAL;
        const float* W; bf16_t* WT; int ldw, ldt, k0, n0, drow0; bool gu = false;
        if (r < I_IN) { const int kb = r / 192, nb = r % 192; W = a.in[3]; ldw = INW; WT = (bf16_t*)(ws + WS_WIN); ldt = DM; k0 = 64 * kb; n0 = 32 * nb; drow0 = n0; }
        else if ((r -= I_IN) < I_PW) { const int g = r / 32, q = r % 32, kb = q / 8, nb = q % 8; W = a.in[4] + (size_t)g * 65536; ldw = 256; WT = (bf16_t*)(ws + WS_POOLW) + (size_t)g * 65536; ldt = 256; k0 = 64 * kb; n0 = 32 * nb; drow0 = n0; }
        else if ((r -= I_PW) < I_GLU) { const int kb = r / 32, nb = r % 32; W = a.in[14]; ldw = SW; WT = (bf16_t*)(ws + WS_WGLU); ldt = SW; k0 = 64 * kb; n0 = 32 * nb; drow0 = n0; }
        else if ((r -= I_GLU) < I_BR) { const int kb = r / 64, nb = r % 64; W = a.in[16]; ldw = DM; WT = (bf16_t*)(ws + WS_WBP); ldt = PW; k0 = 64 * kb; n0 = 32 * nb; drow0 = n0; }
        else if ((r -= I_BR) < I_BR) { const int kb = r / 64, nb = r % 64; W = a.in[17]; ldw = DM; WT = (bf16_t*)(ws + WS_WBS); ldt = SW; k0 = 64 * kb; n0 = 32 * nb; drow0 = n0; }
        else if ((r -= I_BR) < I_OUT) { const int kb = r / 64, nb = r % 64; W = a.in[18]; ldw = DM; WT = (bf16_t*)(ws + WS_WOUT); ldt = DM; k0 = 64 * kb; n0 = 32 * nb; drow0 = n0; }
        else if ((r -= I_OUT) < 2 * I_GU) { const int up = r / I_GU, q = r % I_GU, e = q / 512, q2 = q % 512, kb = q2 / 16, nb = q2 % 16; n0 = 32 * nb; k0 = 64 * kb;
            W = a.in[24 + up] + (size_t)e * DM * FF; ldw = FF; WT = (bf16_t*)(ws + WS_WGU) + (size_t)e * 1024 * DM; ldt = DM; drow0 = (n0 >> 7) * 256 + (n0 & 127) + up * 128; gu = true; }
        else { r -= 2 * I_GU; const int e = r / 512, q2 = r % 512, kb = q2 / 64, nb = q2 % 64; W = a.in[26] + (size_t)e * FF * DM; ldw = DM; WT = (bf16_t*)(ws + WS_WD) + (size_t)e * DM * FF; ldt = FF; k0 = 64 * kb; n0 = 32 * nb; drow0 = n0; }
        t.W = W + (size_t)k0 * ldw + n0; t.WT = WT + (size_t)drow0 * ldt + k0; t.ldw = ldw; t.ldt = ldt; t.rs = gu ? a.in[19] + k0 : nullptr;
    };
    const int it_lo = (part & 1) ? 0 : I_IN, it_hi = (part & 2) ? NITEMS : I_IN;
    for (int it = it_lo + C.gw; it < it_hi; it += 2 * C.NGW) {
        TrItem t0, t1; f32x4 v0[8], v1[8];
        const bool two = it + C.NGW < it_hi;
        decode(it, t0); tr_load<(P0_NT != 0)>(t0, v0, C.lane);
        decode(two ? it + C.NGW : it, t1); if (!two) { t1.WT = (bf16_t*)(ws + WS_SCR); t1.ldt = 64; } tr_load<(P0_NT != 0)>(t1, v1, C.lane);
        tr_finish(t0, v0, scr, C.lane);
        tr_finish(t1, v1, scrB, C.lane);
    }
    if (part & 1) {
        for (int m = 2 * C.gw; m < NTOK; m += 2 * C.NGW) {
            const f32x4* x0 = (const f32x4*)(a.in[0] + (size_t)m * DM) + C.lane; const f32x4* x1 = x0 + DM / 4;
            f32x4 v0[8], v1[8];
#pragma unroll
            for (int j = 0; j < 8; ++j) { v0[j] = P0_NT ? __builtin_nontemporal_load(x0 + 64 * j) : x0[64 * j]; v1[j] = P0_NT ? __builtin_nontemporal_load(x1 + 64 * j) : x1[64 * j]; }
            norm_regs_bf16(v0, a.in[2], (bf16_t*)(ws + WS_A1) + (size_t)m * DM, C.lane, (float*)(ws + WS_RSTD1) + m);
            norm_regs_bf16(v1, a.in[2], (bf16_t*)(ws + WS_A1) + (size_t)(m + 1) * DM, C.lane, (float*)(ws + WS_RSTD1) + m + 1);
        }
        for (int m = C.gw; m < NMETA; m += C.NGW) norm_row_bf16(a.in[1] + (size_t)m * DM, a.in[2], (bf16_t*)(ws + WS_A1M) + (size_t)m * DM, C.lane);
        for (int i = C.gw * 64 + C.lane; i < DM; i += C.NGW * 64) ((float*)(ws + WS_IG))[i] = 1.f / a.in[2][i];
    }
    if (!(part & 2)) return;
    for (int it = C.gw; it < 80 * DM / 64; it += C.NGW) { const int idx = it * 64 + C.lane, j = idx / DM, k = idx % DM;
        float w = 0.f; if (j < 8) w = a.in[20][k * 8 + j]; else if (j < 72) w = a.in[22][k * 64 + (j - 8)];
        w *= a.in[19][k];
        const unsigned hi = pk2(w, 0.f) & 0xffffu; const float lo = w - __uint_as_float(hi << 16);
        ((bf16_t*)(ws + WS_WRH))[idx] = (bf16_t)hi; ((bf16_t*)(ws + WS_WRL))[idx] = (bf16_t)(pk2(lo, 0.f) & 0xffffu); }
    for (int g = C.gw; g < 64; g += C.NGW) { const int n = C.lane;
        const float ar = a.in[6][g * 64 + n], ai = a.in[7][g * 64 + n], dt = expf(a.in[8][g]);
        const float mag = expf(ar * dt); float sn, cs; sincosf(ai * dt, &sn, &cs);
        const float lr = mag * cs, li = mag * sn, den = ar * ar + ai * ai, nr = lr - 1.f;
        const float cr = (nr * ar + li * ai) / den, ci = (li * ar - nr * ai) / den;
        ((f32x2*)(ws + WS_LAM))[g * 64 + n] = (f32x2){lr, li};
        float pr = lr, pi = li;
#pragma unroll
        for (int s = 0; s < 7; ++s) { const float t = pr * pr - pi * pi; pi = 2.f * pr * pi; pr = t; }
        ((f32x2*)(ws + WS_LAMP))[g * 64 + n] = (f32x2){pr, pi};
        bf16_t* bc = (bf16_t*)(ws + WS_BCAT) + (size_t)g * 128 * 16; bf16_t* cc = (bf16_t*)(ws + WS_CCATT) + (size_t)g * 16 * 128;
        unsigned rp[8], ip[8];
#pragma unroll
        for (int h = 0; h < 16; h += 2) { const float b0r = a.in[9][(g * 64 + n) * 16 + h], b0i = a.in[10][(g * 64 + n) * 16 + h], b1r = a.in[9][(g * 64 + n) * 16 + h + 1], b1i = a.in[10][(g * 64 + n) * 16 + h + 1];
            rp[h / 2] = pk2(cr * b0r - ci * b0i, cr * b1r - ci * b1i); ip[h / 2] = pk2(cr * b0i + ci * b0r, cr * b1i + ci * b1r); }
        *(u32x4*)(bc + (size_t)n * 16) = (u32x4){rp[0], rp[1], rp[2], rp[3]}; *(u32x4*)(bc + (size_t)n * 16 + 8) = (u32x4){rp[4], rp[5], rp[6], rp[7]};
        *(u32x4*)(bc + (size_t)(64 + n) * 16) = (u32x4){ip[0], ip[1], ip[2], ip[3]}; *(u32x4*)(bc + (size_t)(64 + n) * 16 + 8) = (u32x4){ip[4], ip[5], ip[6], ip[7]};
#pragma unroll
        for (int h = 0; h < 16; ++h) { cc[h * 128 + n] = (bf16_t)(pk2(a.in[11][(g * 16 + h) * 64 + n], 0.f) & 0xffffu); cc[h * 128 + 64 + n] = (bf16_t)(pk2(-a.in[12][(g * 16 + h) * 64 + n], 0.f) & 0xffffu); }
    }
    for (int it = C.gw; it < NE * LISTCAP / 64; it += C.NGW) ((u32x4*)(ws + WS_LIST))[(size_t)it * 64 + C.lane] = (u32x4){0u, 0u, 0u, 0u};
}

struct CvItem { const float* W; bf16_t* WT; int ldw, ldt, gk; };
DI void cv_decode(const Args& a, unsigned char* ws, int idx, CvItem& t) {
    constexpr int I_GU = 64 * 32 * 16;
    if (idx < 2 * I_GU) { const int up = idx / I_GU, q = idx % I_GU, e = q >> 9, q2 = q & 511, kb = q2 >> 4, nb = q2 & 15, n0 = 32 * nb, k0 = 64 * kb;
        t.W = a.in[24 + up] + (size_t)e * DM * FF + (size_t)k0 * FF + n0; t.ldw = FF; t.ldt = DM; t.gk = k0;
        t.WT = (bf16_t*)(ws + WS_WGU) + (size_t)e * 1024 * DM + (size_t)((n0 >> 7) * 256 + (n0 & 127) + up * 128) * DM + k0; }
    else { const int r = idx - 2 * I_GU, e = r >> 9, q2 = r & 511, kb = q2 >> 6, nb = q2 & 63, n0 = 32 * nb, k0 = 64 * kb;
        t.W = a.in[26] + (size_t)e * FF * DM + (size_t)k0 * DM + n0; t.ldw = DM; t.ldt = FF; t.gk = -1;
        t.WT = (bf16_t*)(ws + WS_WD) + (size_t)e * DM * FF + (size_t)n0 * FF + k0; }
}
DI void cv_issue(const Ctx& C, const Args& a, int idx, LAS unsigned char* slot) {
    CvItem t; cv_decode(a, C.ws, idx, t);
    const int l = C.lane, w = C.wave;
    const float* src = t.W + (size_t)(8 * w + (l >> 3)) * t.ldw + 4 * ((l & 7) ^ w);
    __builtin_amdgcn_global_load_lds((const unsigned*)src, (LAS unsigned*)(slot + 1024 * w), 16, 0, 0);
}
DI void cv_consume(const Ctx& C, const Args& a, int idx, const LAS unsigned char* slot, const LAS float* gl) {
    CvItem t; cv_decode(a, C.ws, idx, t);
    const int l = C.lane, c = l & 7, n = 8 * (C.wave & 3) + (l >> 3);
    const LAS float* xf = (const LAS float*)slot + (8 * c) * 32 + (((n >> 2) ^ c) << 2) + (n & 3);
    float v[8];
#pragma unroll
    for (int i = 0; i < 8; ++i) v[i] = xf[i * 32];
    if (t.gk >= 0) { const f32x4 g0 = *(const LAS f32x4*)(gl + t.gk + 8 * c), g1 = *(const LAS f32x4*)(gl + t.gk + 8 * c + 4);
        v[0] *= g0.x; v[1] *= g0.y; v[2] *= g0.z; v[3] *= g0.w; v[4] *= g1.x; v[5] *= g1.y; v[6] *= g1.z; v[7] *= g1.w; }
    u32x4 o; o.x = pk2(v[0], v[1]); o.y = pk2(v[2], v[3]); o.z = pk2(v[4], v[5]); o.w = pk2(v[6], v[7]);
    *(u32x4*)(t.WT + (size_t)n * t.ldt + 8 * c) = o;
}
DI void expert_item(const Args& a, unsigned char* ws, int idx, TrItem& t) {
    constexpr int I_GU = 64 * 32 * 16;
    if (idx < 2 * I_GU) { const int up = idx / I_GU, q = idx % I_GU, e = q >> 9, q2 = q & 511, kb = q2 >> 4, nb = q2 & 15, n0 = 32 * nb, k0 = 64 * kb;
        t.W = a.in[24 + up] + (size_t)e * DM * FF + (size_t)k0 * FF + n0; t.ldw = FF; t.ldt = DM; t.rs = a.in[19] + k0;
        t.WT = (bf16_t*)(ws + WS_WGU) + (size_t)e * 1024 * DM + (size_t)((n0 >> 7) * 256 + (n0 & 127) + up * 128) * DM + k0; }
    else { const int r = idx - 2 * I_GU, e = r >> 9, q2 = r & 511, kb = q2 >> 6, nb = q2 & 63, n0 = 32 * nb, k0 = 64 * kb;
        t.W = a.in[26] + (size_t)e * FF * DM + (size_t)k0 * DM + n0; t.ldw = DM; t.ldt = FF; t.rs = nullptr;
        t.WT = (bf16_t*)(ws + WS_WD) + (size_t)e * DM * FF + (size_t)n0 * FF + k0; }
}
DI void cv_item(const Args& a, unsigned char* ws, int idx, int nitems, TrItem& t) {
    expert_item(a, ws, idx < nitems ? idx : 0, t);
    if (idx >= nitems) { t.WT = (bf16_t*)(ws + WS_SCR); t.ldt = 64; }
}
DI void convert_range(const Ctx& C, const Args& a, int start, int stride, int end) {
    const int cw = start, ncw = stride, nitems = end;
    LAS float* scr = (LAS float*)(C.lds + C.wave * 8448);
#define CV_LD(k, idx) do { cv_item(a, C.ws, (idx), nitems, t##k); tr_load<(CV_NT >= 1)>(t##k, v##k, C.lane); } while (0)
#define CV_FIN(k) tr_finish<(CV_NT >= 2)>(t##k, v##k, scr, C.lane)
    TrItem t0, t1, t2, t3; f32x4 v0[8], v1[8], v2[8], v3[8];
    CV_LD(0, cw); CV_LD(1, cw + ncw); CV_LD(2, cw + 2 * ncw);
    for (int it = cw; it < nitems; it += 4 * ncw) {
        CV_LD(3, it + 3 * ncw); CV_FIN(0); CV_LD(0, it + 4 * ncw); CV_FIN(1); CV_LD(1, it + 5 * ncw); CV_FIN(2); CV_LD(2, it + 6 * ncw); CV_FIN(3);
    }
#undef CV_LD
#undef CV_FIN
}
DI void convert_queue(const Ctx& C, const Args& a) {
    unsigned* Q = (unsigned*)(C.ws + WS_CTL) + CW_Q;
    for (;;) {
        unsigned k = 0; if (C.lane == 0) k = atomicAdd(Q, (unsigned)CV_GRAB);
        const int idx = CV_STATIC + (int)__builtin_amdgcn_readfirstlane(k);
        if (idx >= 2 * CONV_PAIRS) break;
        const int end = idx + CV_GRAB < 2 * CONV_PAIRS ? idx + CV_GRAB : 2 * CONV_PAIRS;
        convert_range(C, a, idx, 1, end);
    }
}
DI void convert_stream(const Ctx& C, const Args& a, int ci, int nconv, int npairs) {
    (void)npairs;
    convert_range(C, a, ci * NWAVES + C.wave, nconv * NWAVES, CV_STATIC);
    convert_queue(C, a);
    VM_WAIT(); __syncthreads();
}

DI void convert_tail(const Ctx& C, const Args& a) {
#if TAIL_IN_P8
    unsigned* Q = (unsigned*)(C.ws + WS_CTL) + CW_Q;
    LAS float* scr = (LAS float*)(C.lds + C.wave * 8448); LAS float* scrB = (LAS float*)(C.lds + (C.wave < 7 ? 67584 + C.wave * 8448 : XB_OFF));
    for (;;) {
        unsigned k = 0; if (C.lane == 0) k = atomicAdd(Q, 2u);
        const int idx = 2 * CONV_PAIRS + (int)__builtin_amdgcn_readfirstlane(k);
        if (idx >= SIDE_ITEMS) break;
        TrItem t0, t1; f32x4 v0[8], v1[8];
        cv_item(a, C.ws, idx, SIDE_ITEMS, t0); tr_load(t0, v0, C.lane);
        cv_item(a, C.ws, idx + 1, SIDE_ITEMS, t1); tr_load(t1, v1, C.lane);
        tr_finish(t0, v0, scr, C.lane); tr_finish(t1, v1, scrB, C.lane);
    }
    VM_WAIT();
#endif
}

DI void meta_gemm(const Ctx& C) {
    if (C.vcu >= 128) return;
    const int n0 = 16 * C.vcu, l = C.lane, r = l & 15, q = l >> 4;
    const bf16_t* ap = (const bf16_t*)(C.ws + WS_A1M) + (size_t)r * DM + C.wave * 256 + 8 * q;
    const bf16_t* wp = (const bf16_t*)(C.ws + WS_WIN) + (size_t)(n0 + r) * DM + C.wave * 256 + 8 * q;
    f32x4 acc = {0.f, 0.f, 0.f, 0.f};
#pragma unroll
    for (int ks = 0; ks < 8; ++ks) { const bf16x8 af = *(const bf16x8*)(ap + 32 * ks), wf = *(const bf16x8*)(wp + 32 * ks); acc = MFMA16(wf, af, acc); }
    LAS f32x4* red = (LAS f32x4*)(C.lds);
    red[C.wave * 64 + l] = acc;
    __syncthreads();
    if (C.wave == 0) {
#pragma unroll
        for (int w = 1; w < 8; ++w) acc += red[w * 64 + l];
        const int col = n0 + 4 * q; bf16_t* dst = (col < PW) ? (bf16_t*)(C.ws + WS_ZP) + (size_t)(NTOK + r) * PW + col : (bf16_t*)(C.ws + WS_ZS) + (size_t)(NTOK + r) * SW + (col - PW);
        u32x2 w; w.x = pk2(acc[0], acc[1]); w.y = pk2(acc[2], acc[3]); *(u32x2*)dst = w;
    }
}

DI int zrow(int b, int s) { return s >= 0 ? b * SEQ + s : NTOK + NMETA + s; }
DI void pool_diff(const Ctx& C) {
    const bf16_t* ZP = (const bf16_t*)(C.ws + WS_ZP); bf16_t* DD = (bf16_t*)(C.ws + WS_DD);
    for (int it = C.gw; it < 2048; it += C.NGW) {
        const int tb = it >> 1, hf = it & 1, b = tb >> 9, s0 = (tb & 511) * 16, c0 = hf * 512 + C.lane * 8, w = 2 << (c0 >> 8);
        const float inv = 1.f / (float)w;
        f32x4 a0 = {0.f, 0.f, 0.f, 0.f}, a1 = a0;
        for (int j = 1; j < w; ++j) { f32x4 v0, v1; pg8::unpack8(*(const u32x4*)(ZP + (size_t)zrow(b, s0 - j) * PW + c0), v0, v1); a0 += v0; a1 += v1; }
        for (int i = 0; i < 16; ++i) { const int s = s0 + i; f32x4 c0v, c1v, l0, l1;
            pg8::unpack8(*(const u32x4*)(ZP + (size_t)zrow(b, s) * PW + c0), c0v, c1v); a0 += c0v; a1 += c1v;
            *(u32x4*)(DD + (size_t)(b * SEQ + s) * PW + c0) = pg8::pack8(a0 * inv - c0v, a1 * inv - c1v);
            pg8::unpack8(*(const u32x4*)(ZP + (size_t)zrow(b, s - w + 1) * PW + c0), l0, l1); a0 -= l0; a1 -= l1; }
    }
}

template <bool PASS2> DI void ssm_pass(const Ctx& C, const Args& a) {
    const bf16_t* ZS = (const bf16_t*)(C.ws + WS_ZS); bf16_t* S0 = (bf16_t*)(C.ws + WS_S0);
    f32x4* Eb = (f32x4*)(C.ws + WS_E);
    const int l = C.lane, rr = l & 31, bb = (rr >> 2) & 1, jj = (rr & 3) + 4 * (rr >> 3), kofs = 8 * (l >> 5);
    LAS unsigned char* xs = C.lds + C.wave * 8704;
    for (int it = C.gw; it < 64 * NCH; it += C.NGW) {
        const int g = it & 63, c0 = (it >> 6) & 31, c = (it >> 11) ? 63 - c0 : c0;
        const f32x2 lamA = ((const f32x2*)(C.ws + WS_LAM))[g * 64 + (l & 31)], lamB = ((const f32x2*)(C.ws + WS_LAM))[g * 64 + 32 + (l & 31)];
        bf16x8 bfr[4];
#pragma unroll
        for (int ct = 0; ct < 4; ++ct) bfr[ct] = *(const bf16x8*)((const bf16_t*)(C.ws + WS_BCAT) + ((size_t)g * 128 + 32 * ct + (l & 31)) * 16 + kofs);
        float xAr = 0.f, xAi = 0.f, xBr = 0.f, xBi = 0.f;
        bf16x8 cfr[4]; f32x4 dsk = {0.f, 0.f, 0.f, 0.f};
        if constexpr (PASS2) {
#pragma unroll
            for (int ks = 0; ks < 4; ++ks) cfr[ks] = *(const bf16x8*)((const bf16_t*)(C.ws + WS_CCATT) + ((size_t)g * 16 + (l & 15)) * 128 + 32 * ks + 8 * (l >> 4));
            dsk = *(const f32x4*)(a.in[13] + g * 16 + 4 * (l >> 4));
            if (c > 0) {
                const f32x2 LA = ((const f32x2*)(C.ws + WS_LAMP))[g * 64 + (l & 31)], LB = ((const f32x2*)(C.ws + WS_LAMP))[g * 64 + 32 + (l & 31)];
                const f32x4* ep = Eb + ((size_t)g * NCH) * 64 + l;
                f32x4 t = ep[0];
                for (int j0 = 1; j0 < c; j0 += 8) {
                    f32x4 eb[8];
#pragma unroll
                    for (int i = 0; i < 8; ++i) { const int j = (j0 + i < c) ? j0 + i : c - 1; eb[i] = ep[(size_t)j * 64]; }
#pragma unroll
                    for (int i = 0; i < 8; ++i) if (j0 + i < c) { const f32x4 e = eb[i];
                        const float ar = LA.x * t.x - LA.y * t.y + e.x, ai = LA.x * t.y + LA.y * t.x + e.y, br = LB.x * t.z - LB.y * t.w + e.z, bi = LB.x * t.w + LB.y * t.z + e.w;
                        t = (f32x4){ar, ai, br, bi}; }
                }
                xAr = t.x; xAi = t.y; xBr = t.z; xBi = t.w;
            }
        }
        const int nsteps = (c == 0) ? 9 : 8;
        auto urow = [&](int st) { const bool m = (c == 0 && st == 0); const int sb = c * CHL + 16 * (st - (c == 0 ? 1 : 0)); return m ? NTOK + jj : bb * SEQ + sb + jj; };
        bf16x8 af0 = *(const bf16x8*)(ZS + (size_t)urow(0) * SW + g * 16 + kofs), af1 = *(const bf16x8*)(ZS + (size_t)urow(1) * SW + g * 16 + kofs);
        for (int st = 0; st < nsteps; ++st) {
            const bool meta = (c == 0 && st == 0);
            const int sbase = c * CHL + 16 * (st - (c == 0 ? 1 : 0));
            const bf16x8 af = af0; af0 = af1;
            { const int stn = st + 2 < nsteps ? st + 2 : nsteps - 1; af1 = *(const bf16x8*)(ZS + (size_t)urow(stn) * SW + g * 16 + kofs); }
            f32x16 z16;
#pragma unroll
            for (int i = 0; i < 16; ++i) z16[i] = 0.f;
            f32x16 q0 = MFMA32(af, bfr[0], z16), q1 = MFMA32(af, bfr[1], z16), q2 = MFMA32(af, bfr[2], z16), q3 = MFMA32(af, bfr[3], z16);
#pragma unroll
            for (int r = 0; r < 16; ++r) {
                const float nar = lamA.x * xAr - lamA.y * xAi + q0[r], nai = lamA.x * xAi + lamA.y * xAr + q2[r];
                const float nbr = lamB.x * xBr - lamB.y * xBi + q1[r], nbi = lamB.x * xBi + lamB.y * xBr + q3[r];
                xAr = nar; xAi = nai; xBr = nbr; xBi = nbi;
                if constexpr (PASS2) { q0[r] = nar; q1[r] = nbr; q2[r] = nai; q3[r] = nbi; }
            }
            if constexpr (PASS2) {
                if (!meta) {
#pragma unroll
                    for (int r = 0; r < 16; ++r) { LAS unsigned short* xr = (LAS unsigned short*)(xs + (16 * (l >> 5) + r) * 272) + (l & 31);
                        const unsigned wre = pk2(q0[r], q1[r]), wim = pk2(q2[r], q3[r]);
                        xr[0] = (unsigned short)(wre & 0xffffu); xr[32] = (unsigned short)(wre >> 16); xr[64] = (unsigned short)(wim & 0xffffu); xr[96] = (unsigned short)(wim >> 16); }
                    asm volatile("" ::: "memory");
#pragma unroll
                    for (int hb = 0; hb < 2; ++hb) {
                        f32x4 y = {0.f, 0.f, 0.f, 0.f};
#pragma unroll
                        for (int ks = 0; ks < 4; ++ks) { const bf16x8 xf = *(const LAS bf16x8*)(xs + (16 * hb + (l & 15)) * 272 + (32 * ks + 8 * (l >> 4)) * 2); y = MFMA16(cfr[ks], xf, y); }
                        const size_t orow = (size_t)hb * SEQ + sbase + (l & 15);
                        const u32x2 uw = *(const u32x2*)(ZS + orow * SW + g * 16 + 4 * (l >> 4));
                        const float s0 = y[0] + dsk[0] * bflo(uw.x), s1 = y[1] + dsk[1] * bfhi(uw.x), s2 = y[2] + dsk[2] * bflo(uw.y), s3 = y[3] + dsk[3] * bfhi(uw.y);
                        u32x2 ow; ow.x = pk2(gelu_t(s0), gelu_t(s1)); ow.y = pk2(gelu_t(s2), gelu_t(s3));
                        *(u32x2*)(S0 + orow * SW + g * 16 + 4 * (l >> 4)) = ow;
                    }
                    asm volatile("" ::: "memory");
                }
            }
        }
        if constexpr (!PASS2) Eb[((size_t)g * NCH + c) * 64 + l] = (f32x4){xAr, xAi, xBr, xBi};
    }
}

#ifndef H1_IN_EPI
#define H1_IN_EPI 1
#endif
constexpr int RT_XD = 8192, RT_NXD = 8, RT_NW = 4, RT_WOFF = RT_NXD * RT_XD, RT_W = 20480, RT_WH = 0, RT_WL = 10240;
static_assert(RT_WOFF + RT_NW * RT_W <= MISC_OFF, "router rings");
DI void rt_issue_xd(const Ctx& C, const bf16_t* U, int t0, int c, LAS unsigned char* stg) {
    const int l = C.lane, w = C.wave;
#pragma unroll
    for (int i = 0; i < 2; ++i) { const int j = 2 * w + i, row = 8 * j + (l >> 3), u = (l & 7) ^ (row & 7);
        __builtin_amdgcn_global_load_lds((const unsigned*)(U + (size_t)(t0 + row) * DM + 64 * c + 8 * u), (LAS unsigned*)(stg + 1024 * j), 16, 0, 0); }
}
DI void rt_issue_w(const Ctx& C, int c, LAS unsigned char* stg) {
    const int l = C.lane, w = C.wave - 4;
    const bf16_t* WRH = (const bf16_t*)(C.ws + WS_WRH); const bf16_t* WRL = (const bf16_t*)(C.ws + WS_WRL);
#pragma unroll
    for (int i = 0; i < 5; ++i) { const int j = 5 * w + i;
        const int jj = j < 10 ? j : j - 10, n = 8 * jj + (l >> 3), u = (l & 7) ^ (n & 7); const bf16_t* src = (j < 10 ? WRH : WRL) + (size_t)n * DM + 64 * c + 8 * u;
        __builtin_amdgcn_global_load_lds((const unsigned*)src, (LAS unsigned*)(stg + (j < 10 ? RT_WH : RT_WL) + 1024 * jj), 16, 0, 0); }
}
DI void router_phase(const Ctx& C, const Args& a) {
    const bf16_t* V = (const bf16_t*)(C.ws + WS_V);
    unsigned* counts = (unsigned*)(C.ws + WS_CTL) + CW_CNT; uint4* LIST = (uint4*)(C.ws + WS_LIST);
    const int l = C.lane, r = l & 15, q = l >> 4, rt = C.wave & 3, kp = C.wave >> 2;
    LAS float* part = (LAS float*)(C.lds);
    LAS float* lgb = (LAS float*)(C.lds + 32768);
    for (int tb = C.vcu; tb < NTOK / 64; tb += C.G) {
        const int t0 = tb * 64, row = 16 * rt + r;
        f32x4 acc[5];
#pragma unroll
        for (int n = 0; n < 5; ++n) acc[n] = (f32x4){0.f, 0.f, 0.f, 0.f};
        float ss = 0.f;
        if (C.wave < 4) {
#pragma unroll
            for (int s = 0; s < RT_NXD - 1; ++s) rt_issue_xd(C, V, t0, s, C.lds + s * RT_XD);
        } else {
#pragma unroll
            for (int s = 0; s < RT_NW - 1; ++s) rt_issue_w(C, s, C.lds + RT_WOFF + s * RT_W);
        }
        for (int c = 0; c < 32; ++c) {
            if (C.wave < 4) {
                if (c + RT_NXD - 2 < 32) asm volatile("s_waitcnt vmcnt(12)" ::: "memory");
                else asm volatile("s_waitcnt vmcnt(0)" ::: "memory");
            } else {
                if (c + RT_NW - 2 < 32) asm volatile("s_waitcnt vmcnt(10)" ::: "memory");
                else asm volatile("s_waitcnt vmcnt(0)" ::: "memory");
            }
            LDS_WAIT(); __builtin_amdgcn_s_barrier(); asm volatile("" ::: "memory");
            if (C.wave < 4) { if (c + RT_NXD - 1 < 32) rt_issue_xd(C, V, t0, c + RT_NXD - 1, C.lds + ((c + RT_NXD - 1) & (RT_NXD - 1)) * RT_XD); }
            else { if (c + RT_NW - 1 < 32) rt_issue_w(C, c + RT_NW - 1, C.lds + RT_WOFF + ((c + RT_NW - 1) & (RT_NW - 1)) * RT_W); }
            const LAS unsigned char* stg = C.lds + (c & (RT_NXD - 1)) * RT_XD; const LAS unsigned char* wst = C.lds + RT_WOFF + (c & (RT_NW - 1)) * RT_W;
            const u32x4 uw = *(const LAS u32x4*)(stg + row * 128 + (((4 * kp + q) ^ (row & 7)) << 4));
            bf16x8 wh[5], wl[5];
#pragma unroll
            for (int n = 0; n < 5; ++n) { const int nn = 16 * n + r; const int off = nn * 128 + (((4 * kp + q) ^ (nn & 7)) << 4);
                wh[n] = *(const LAS bf16x8*)(wst + RT_WH + off); wl[n] = *(const LAS bf16x8*)(wst + RT_WL + off); }
            f32x4 h0, h1; pg8::unpack8(uw, h0, h1);
            ss += (h0.x * h0.x + h0.y * h0.y) + (h0.z * h0.z + h0.w * h0.w) + (h1.x * h1.x + h1.y * h1.y) + (h1.z * h1.z + h1.w * h1.w);
            const bf16x8 ah = __builtin_bit_cast(bf16x8, uw);
#pragma unroll
            for (int n = 0; n < 5; ++n) { acc[n] = MFMA16(wh[n], ah, acc[n]); acc[n] = MFMA16(wl[n], ah, acc[n]); }
        }
        LDS_WAIT(); __syncthreads();
        ss += __shfl_xor(ss, 16); ss += __shfl_xor(ss, 32);
        if (kp == 1) {
#pragma unroll
            for (int n = 0; n < 5; ++n)
#pragma unroll
                for (int j = 0; j < 4; ++j) part[(rt * 21 + n * 4 + j) * 64 + l] = acc[n][j];
            part[(rt * 21 + 20) * 64 + l] = ss;
        }
        __syncthreads();
        if (kp == 0) {
#pragma unroll
            for (int n = 0; n < 5; ++n)
#pragma unroll
                for (int j = 0; j < 4; ++j) acc[n][j] += part[(rt * 21 + n * 4 + j) * 64 + l];
            ss += part[(rt * 21 + 20) * 64 + l];
            const float rstd = rsqrtf(ss * (1.f / DM) + RMS_EPS);
            LAS float* lg = lgb + rt * 16 * 80;
#pragma unroll
            for (int n = 0; n < 5; ++n)
#pragma unroll
                for (int j = 0; j < 4; ++j) { const int idx = 16 * n + 4 * q + j; if (idx < 72) { const float bias = idx < 8 ? a.in[21][idx] : a.in[23][idx - 8]; lg[r * 80 + idx] = acc[n][j] * rstd + bias; } }
            LDS_WAIT(); asm volatile("" ::: "memory");
            if (l < 16) {
                const LAS float* p = lg + l * 80;
                int gs = 0; float mx = p[0];
#pragma unroll
                for (int k = 1; k < 8; ++k) { const float v = p[k]; if (v > mx) { mx = v; gs = k; } }
                float den = 0.f;
#pragma unroll
                for (int k = 0; k < 8; ++k) den += expf(p[k] - mx);
                const float pgp = 1.f / den;
                const LAS float* el = p + 8 + gs * 8;
                int i0 = 0; float v0 = el[0];
#pragma unroll
                for (int k = 1; k < 8; ++k) { const float v = el[k]; if (v > v0) { v0 = v; i0 = k; } }
                int i1 = -1; float v1 = -3.0e38f;
#pragma unroll
                for (int k = 0; k < 8; ++k) { const float v = el[k]; if (k != i0 && v > v1) { v1 = v; i1 = k; } }
                const float e1 = expf(v1 - v0), w0 = pgp / (1.f + e1), w1 = pgp * e1 / (1.f + e1);
                const int tok = t0 + 16 * rt + l, ex0 = gs * 8 + i0, ex1 = gs * 8 + i1;
                const unsigned r0 = atomicAdd(&counts[ex0 * CNT_STRIDE], 1u), r1 = atomicAdd(&counts[ex1 * CNT_STRIDE], 1u);
                LIST[(size_t)ex0 * LISTCAP + r0] = make_uint4((unsigned)tok, (unsigned)(2 * tok), __float_as_uint(w0), __float_as_uint(rstd));
                LIST[(size_t)ex1 * LISTCAP + r1] = make_uint4((unsigned)tok, (unsigned)(2 * tok + 1), __float_as_uint(w1), __float_as_uint(rstd));
            }
        }
        VM_WAIT(); __syncthreads();
    }
}
DI void moe_tables(const Ctx& C, int ntn) {
    volatile LAS int* tab = (volatile LAS int*)(C.lds + TAB_OFF);
    if (C.tid < 64) {
        const unsigned* counts = (const unsigned*)(C.ws + WS_CTL) + CW_CNT;
        const int cnt = (int)__hip_atomic_load(counts + C.tid * CNT_STRIDE, RLX_AGENT); const int nblk = (cnt + 255) >> 8;
        int incl = nblk;
#pragma unroll
        for (int o = 1; o < 64; o <<= 1) { const int t = __shfl_up(incl, o); if (C.tid >= o) incl += t; }
        tab[C.tid + 1] = incl * ntn; if (C.tid == 0) tab[0] = 0;
        tab[80 + C.tid] = (incl - nblk) * 256; tab[160 + C.tid] = cnt;
    }
    __syncthreads();
}
struct FinRow { u32x2 hw[8]; unsigned p[8], q[8]; };
DI void fin_load(FinRow& R, const unsigned char* ws, int t, int lane) {
    const u32x2* hb = (const u32x2*)((const bf16_t*)(ws + WS_V) + (size_t)t * DM) + lane;
    const unsigned* y0 = (const unsigned*)(ws + WS_YB + (size_t)(2 * t) * DM) + lane; const unsigned* y1 = (const unsigned*)(ws + WS_YB + (size_t)(2 * t + 1) * DM) + lane;
#pragma unroll
    for (int j = 0; j < 8; ++j) { if (FIN_NT) { R.hw[j] = __builtin_nontemporal_load(hb + 64 * j); R.p[j] = __builtin_nontemporal_load(y0 + 64 * j); R.q[j] = __builtin_nontemporal_load(y1 + 64 * j); }
        else { R.hw[j] = hb[64 * j]; R.p[j] = y0[64 * j]; R.q[j] = y1[64 * j]; } }
}
DI void fin_finish(const FinRow& R, const float* gfin, float* orow, int lane) {
    constexpr float IS = 1.f / 16.f;
    f32x4 v[8]; float s = 0.f;
#pragma unroll
    for (int j = 0; j < 8; ++j) { const u32x2 hw = R.hw[j]; const int p = (int)R.p[j], q = (int)R.q[j];
        v[j] = (f32x4){bflo(hw.x) + IS * (__builtin_amdgcn_cvt_f32_fp8(p, 0) + __builtin_amdgcn_cvt_f32_fp8(q, 0)), bfhi(hw.x) + IS * (__builtin_amdgcn_cvt_f32_fp8(p, 1) + __builtin_amdgcn_cvt_f32_fp8(q, 1)),
                       bflo(hw.y) + IS * (__builtin_amdgcn_cvt_f32_fp8(p, 2) + __builtin_amdgcn_cvt_f32_fp8(q, 2)), bfhi(hw.y) + IS * (__builtin_amdgcn_cvt_f32_fp8(p, 3) + __builtin_amdgcn_cvt_f32_fp8(q, 3))};
        s += (v[j].x * v[j].x + v[j].y * v[j].y) + (v[j].z * v[j].z + v[j].w * v[j].w); }
    const float rstd = rsqrtf(wave_sum(s) * (1.f / DM) + RMS_EPS);
    const f32x4* gr = (const f32x4*)gfin + lane; f32x4* o = (f32x4*)orow + lane;
#pragma unroll
    for (int j = 0; j < 8; ++j) { const f32x4 gg = gr[64 * j]; const f32x4 r = {v[j].x * rstd * gg.x, v[j].y * rstd * gg.y, v[j].z * rstd * gg.z, v[j].w * rstd * gg.w};
        if (FIN_ST_NT) __builtin_nontemporal_store(r, o + 64 * j); else o[64 * j] = r; }
}
DI void final_phase(const Ctx& C, const Args& a, float* dst_override = nullptr) {
    float* out = dst_override ? dst_override : a.out;
    static_assert(NTOK % 2 == 0, "rows are taken in pairs");
    for (int t = 2 * C.gw; t < NTOK; t += 2 * C.NGW) {
        FinRow A, B; fin_load(A, C.ws, t, C.lane); fin_load(B, C.ws, t + 1, C.lane);
        fin_finish(A, a.in[27], out + (size_t)t * DM, C.lane); fin_finish(B, a.in[27], out + (size_t)(t + 1) * DM, C.lane);
    }
}
constexpr int N_PHASES = 11;
DI bool is_conv(const Ctx& C) { return NCONV && C.G == 256 && (C.vcu & 31) >= 32 - NCONV / 8; }
DI int gemm_index(const Ctx& C) { return (C.vcu >> 5) * (32 - NCONV / 8) + (C.vcu & 31); }
DI void meta_gemm_g(const Ctx& C) { Ctx M = C; M.vcu = (NCONV && C.G == 256) ? gemm_index(C) : C.vcu; meta_gemm(M); }
DI void phase1_conv(const Ctx& C, const Args& args) { const int ng = 32 - NCONV / 8; convert_stream(C, args, (C.vcu >> 5) * (NCONV / 8) + ((C.vcu & 31) - ng), NCONV, CONV_PAIRS); }
DI void phase1_gemm(const Ctx& C, const Args& args) {
    unsigned char* ws = C.ws;
    pg8::DenseOrder S;
    if (NCONV && C.G == 256) S.setup(ws + WS_A1, ws + WS_WIN, NTOK, INW, DM, DM, 256 - NCONV, (C.vcu & 31) * 8 + (C.vcu >> 5));
    else S.setup(ws + WS_A1, ws + WS_WIN, NTOK, INW, DM, DM, C.G, (int)blockIdx.x);
    pg8::EpiZ E{(bf16_t*)(ws + WS_ZP), (bf16_t*)(ws + WS_ZS), ws + WS_GP, ws + WS_GS};
    pg8::gemm_phase<pg8::EpiZ, pg8::DenseOrder, true, true>(C.lds, pg8::Gemm{DM, DM, DM}, S, E);
    meta_gemm_g(C);
    if (NCONV && C.G == 256 && CV_QFRAC) { __syncthreads(); convert_queue(C, args); VM_WAIT(); __syncthreads(); }
}
DI void phase1(const Ctx& C, const Args& args) { if (is_conv(C)) phase1_conv(C, args); else phase1_gemm(C, args); }
DI void phase2(const Ctx& C, const Args& args) { pool_diff(C); ssm_pass<false>(C, args); }
DI void phase3(const Ctx& C, const Args& args) {
    unsigned char* ws = C.ws;
    pg8::PoolOrder S; S.init(NTOK / 256, 4, C.G, (int)blockIdx.x); S.DD = (const char*)(ws + WS_DD); S.PWT = (const char*)(ws + WS_POOLW);
    pg8::EpiPool E{(bf16_t*)(ws + WS_PP), args.in[5]};
    pg8::gemm_phase<pg8::EpiPool, pg8::PoolOrder, true, true>(C.lds, pg8::Gemm{PW, 256, 256}, S, E);
    ssm_pass<true>(C, args);
}
DI void phase4(const Ctx& C, const Args& args) {
    unsigned char* ws = C.ws;
    pg8::DenseOrder S; S.setup(ws + WS_S0, ws + WS_WGLU, NTOK, SW, SW, SW, C.G, (int)blockIdx.x);
    pg8::EpiGlu E{(const bf16_t*)(ws + WS_S0), (bf16_t*)(ws + WS_SS), args.in[15]};
    pg8::gemm_phase<pg8::EpiGlu, pg8::DenseOrder, true, true>(C.lds, pg8::Gemm{SW, SW, SW}, S, E);
}
DI void phase5(const Ctx& C, const Args& args) {
    unsigned char* ws = C.ws;
    pg8::MergeOrder S; S.init(NTOK / 256, DM / 256, C.G, (int)blockIdx.x);
    S.A0 = (const char*)(ws + WS_PP); S.B0 = (const char*)(ws + WS_WBP); S.A1 = (const char*)(ws + WS_SS); S.B1 = (const char*)(ws + WS_WBS); S.tstepA = (size_t)256 * PW * 2; S.tstepB = (size_t)256 * PW * 2;
    pg8::EpiMerge E{ws + WS_GP, ws + WS_GS, (bf16_t*)(ws + WS_MP)};
    pg8::gemm_phase<pg8::EpiMerge, pg8::MergeOrder, true, true>(C.lds, pg8::Gemm{PW, PW, PW}, S, E);
}
DI void phase6(const Ctx& C, const Args& args) {
    unsigned char* ws = C.ws;
    pg8::DenseOrder S; S.setup(ws + WS_MP, ws + WS_WOUT, NTOK, DM, DM, DM, C.G, (int)blockIdx.x);
    pg8::EpiH1 E{(bf16_t*)(ws + WS_V), (const float*)(ws + WS_RSTD1), (const float*)(ws + WS_IG)};
#if SIDE_P56
    pg8::SideConv sd; sd.init(args.in[24], args.in[25], args.in[26], (bf16_t*)(ws + WS_WGU), (bf16_t*)(ws + WS_WD), (bf16_t*)(ws + WS_SCR), C.lds + XB_OFF, SIDE_N1 + 2 * SIDE_N5 + C.vcu, SIDE_TOTAL, C.G);
    pg8::gemm_phase<pg8::EpiH1, pg8::DenseOrder, true, true, pg8::SideConv>(C.lds, pg8::Gemm{DM, DM, DM}, S, E, sd);
#else
    pg8::gemm_phase<pg8::EpiH1, pg8::DenseOrder, true, true>(C.lds, pg8::Gemm{DM, DM, DM}, S, E);
#endif
}
DI void phase8(const Ctx& C, const Args& args) {
    unsigned char* ws = C.ws;
    __syncthreads();
    moe_tables(C, 4);
    pg8::MoeUpOrder S; S.tab = (const volatile LAS int*)(C.lds + TAB_OFF); S.ntn = 4; S.G = C.G; S.vcu = C.vcu; S.list = (const uint4*)(ws + WS_LIST);
    S.Abase = (const char*)(ws + WS_V); S.Bbase = (const char*)(ws + WS_WGU); S.bstep_e = (size_t)1024 * DM * 2; S.bstep_n = (size_t)256 * DM * 2; S.astep_row = 0; S.up = true;
    pg8::EpiMoeUp E{(bf16_t*)(ws + WS_HH)};
    pg8::gemm_phase<pg8::EpiMoeUp, pg8::MoeUpOrder, true, true>(C.lds, pg8::Gemm{DM, DM, DM}, S, E);
    convert_tail(C, args);
}
DI void phase9(const Ctx& C, const Args& args) {
    unsigned char* ws = C.ws;
    __syncthreads();
    moe_tables(C, 8);
    pg8::MoeDownOrder S; S.tab = (const volatile LAS int*)(C.lds + TAB_OFF); S.ntn = 8; S.G = C.G; S.vcu = C.vcu; S.list = (const uint4*)(ws + WS_LIST);
    S.Abase = (const char*)(ws + WS_HH); S.Bbase = (const char*)(ws + WS_WD); S.bstep_e = (size_t)DM * FF * 2; S.bstep_n = (size_t)256 * FF * 2; S.astep_row = (size_t)FF * 2; S.up = false;
    pg8::EpiMoeDown E{(bf16_t*)(ws + WS_YB)};
    pg8::gemm_phase<pg8::EpiMoeDown, pg8::MoeDownOrder, true, true>(C.lds, pg8::Gemm{FF, FF, FF}, S, E);
}
#ifndef PH_MASK
#define PH_MASK 0x7ff
#endif
#ifndef PROBE_DBL
#define PROBE_DBL 0
#endif
#ifndef OVERLAP_P0
#define OVERLAP_P0 1
#endif
__global__ void __launch_bounds__(NWAVES * 64, 2) mk_fwd(Args args) {
    extern __shared__ __attribute__((aligned(16))) unsigned char lds_raw[];
    Ctx C; C.lds = (LAS unsigned char*)lds_raw; C.ws = args.ws; C.tid = threadIdx.x; C.lane = C.tid & 63; C.wave = __builtin_amdgcn_readfirstlane(C.tid >> 6);
    C.G = gridDim.x; { const int bx = blockIdx.x; C.vcu = (C.G % 8 == 0) ? (bx % 8) * (C.G / 8) + bx / 8 : bx; }
    C.gw = C.wave * C.G + C.vcu; C.NGW = NWAVES * C.G;
    unsigned char* ws = args.ws;
    for (int u = C.tid; u < (LDS_BYTES - MISC_OFF) / 4; u += NWAVES * 64) ((LAS unsigned*)(C.lds + MISC_OFF))[u] = 0u;
    __syncthreads();
    const int lo = args.ph_lo, hi = args.ph_hi;
    XcdBarrier bar; bar.bar = (unsigned*)(ws + WS_CTL) + CW_BAR; bar.x = 0; bar.st = nullptr;
    if (hi - lo > 1) bar = xcd_barrier_post((unsigned*)(ws + WS_CTL) + CW_BAR, (volatile LAS unsigned*)(C.lds + MISC_OFF) + 8, gridDim.x);
#if NCONV && OVERLAP_P0
    XcdBarrier bar2; bar2.bar = (unsigned*)(ws + WS_CTL) + CW_BAR2; bar2.x = 0; bar2.st = nullptr; bar2.expected = 0;
    if (hi - lo > 1 && C.G == 256 && !is_conv(C)) bar2 = xcd_barrier_post((unsigned*)(ws + WS_CTL) + CW_BAR2, (volatile LAS unsigned*)(C.lds + MISC_OFF) + 10, 256 - NCONV);
#endif
#define IN(k) (((PH_MASK >> (k)) & 1) && lo <= (k) && (k) < hi)
#ifndef PROBE_BAR
#define PROBE_BAR 0
#endif
#define SEAM(k) do { if (IN(k) && IN((k) + 1)) { if (args.use_cg && (k) == 0) { cg::this_grid().sync(); } else xcd_barrier(bar); for (int pb_ = 0; pb_ < PROBE_BAR; ++pb_) xcd_barrier(bar); } } while (0)
#ifndef STAGGER
#define STAGGER 0
#endif
#ifndef STAGGER_MASK
#define STAGGER_MASK 0x362
#endif
#define RUN(k, call) do { if (IN(k)) { if (STAGGER && ((STAGGER_MASK >> (k)) & 1)) { for (int sg_ = 0; sg_ < (C.vcu & 7); ++sg_) __builtin_amdgcn_s_sleep(STAGGER); } call; if ((PROBE_DBL >> (k)) & 1) { xcd_barrier(bar); call; } } } while (0)
#if NCONV && OVERLAP_P0
    if (IN(0) && IN(1) && C.G == 256) {
        if (is_conv(C)) phase1_conv(C, args);
        else { Ctx P = C; const int gi = gemm_index(C); P.gw = C.wave * (256 - NCONV) + gi; P.NGW = NWAVES * (256 - NCONV);
               p0_prologue(P, args, 3); xcd_barrier(bar2); phase1_gemm(C, args); }
    } else
#endif
    { RUN(0, p0_prologue(C, args)); SEAM(0);
      RUN(1, phase1(C, args)); }
    SEAM(1);
    RUN(2, phase2(C, args)); SEAM(2);
    RUN(3, phase3(C, args)); SEAM(3);
    RUN(4, phase4(C, args)); SEAM(4);
    RUN(5, phase5(C, args)); SEAM(5);
    RUN(6, phase6(C, args)); SEAM(6);
#if (PROBE_DBL >> 7) & 1
    if (IN(7)) { router_phase(C, args); xcd_barrier(bar); if (blockIdx.x == 0 && C.tid < 64) ((unsigned*)(ws + WS_CTL) + CW_CNT)[C.tid * CNT_STRIDE] = 0u; xcd_barrier(bar); router_phase(C, args); } SEAM(7);
#else
    RUN(7, router_phase(C, args)); SEAM(7);
#endif
    RUN(8, phase8(C, args)); SEAM(8);
    RUN(9, phase9(C, args)); SEAM(9);
#if (PROBE_DBL >> 10) & 1
    if (IN(10)) { final_phase(C, args, (float*)(ws + WS_ZP)); xcd_barrier(bar); final_phase(C, args); }
#else
    RUN(10, final_phase(C, args));
#endif
#undef IN
#undef SEAM
#undef RUN
}

#ifdef MK_DEBUG
namespace dbg {
constexpr int DL = 16 + 768;
__global__ void __launch_bounds__(256) k_cmp(const void* opt, int is_bf16, int old_, int ocol0, const float* ref, int rld, int rcol0, int ncols, int kind, int transform, float tol, unsigned* res) {
    __shared__ float red[4];
    const int r = blockIdx.x, p = r;
    if (kind == 0 && p < 16) return;
    if (kind >= 2 && p >= 16) return;
    const size_t orow = kind == 2 ? (size_t)p : (p < 16 ? (size_t)(NTOK + p) : (size_t)(SEQ + p - 16));
    float e2 = 0.f, r2 = 0.f;
    for (int c = threadIdx.x; c < ncols; c += 256) {
        float rv = ref[(size_t)r * rld + rcol0 + c]; if (transform == 1) rv = 1.f / (1.f + expf(-rv));
        float ov = is_bf16 ? __uint_as_float(((unsigned)((const bf16_t*)opt)[orow * old_ + ocol0 + c]) << 16) : ((const float*)opt)[orow * old_ + ocol0 + c];
        const float d = ov - rv; e2 += d * d; r2 += rv * rv; }
    e2 = nv::block_sum_256(e2, red); r2 = nv::block_sum_256(r2, red);
    if (threadIdx.x == 0) { const bool bad = !(e2 <= tol * tol * r2 + 1e-20f); if (bad) atomicAdd(res, 1u); const float rel = sqrtf(e2 / (r2 + 1e-30f)); atomicMax(res + 1, __float_as_uint(rel == rel ? rel : 3.0e38f)); }
}
__global__ void __launch_bounds__(256) k_cmp_moe(const bf16_t* YB, const float* ref, float tol, unsigned* res) {
    __shared__ float red[4];
    const int r = blockIdx.x, p = r; if (p < 16) return; const size_t t = (size_t)(SEQ + p - 16);
    float e2 = 0.f, r2 = 0.f;
    for (int c = threadIdx.x; c < DM; c += 256) { const float rv = ref[(size_t)r * DM + c];
        const float ov = __uint_as_float(((unsigned)YB[(2 * t) * DM + c]) << 16) + __uint_as_float(((unsigned)YB[(2 * t + 1) * DM + c]) << 16);
        const float d = ov - rv; e2 += d * d; r2 += rv * rv; }
    e2 = nv::block_sum_256(e2, red); r2 = nv::block_sum_256(r2, red);
    if (threadIdx.x == 0) { const bool bad = !(e2 <= tol * tol * r2 + 1e-20f); if (bad) atomicAdd(res, 1u); const float rel = sqrtf(e2 / (r2 + 1e-30f)); atomicMax(res + 1, __float_as_uint(rel == rel ? rel : 3.0e38f)); }
}
__global__ void __launch_bounds__(256) k_cmp_wt(const bf16_t* WT, int ldt, const float* W, const float* W2, int ldw, int K, int mode, float tol, unsigned* res) {
    __shared__ float red[4];
    const int n = blockIdx.x; const float* src = W; int col = n;
    if (mode == 1) { const int blk = n >> 8, within = n & 255; col = blk * 128 + (within & 127); src = within >= 128 ? W2 : W; }
    float e2 = 0.f, r2 = 0.f;
    for (int k = threadIdx.x; k < K; k += 256) { const float rv = src[(size_t)k * ldw + col]; const float ov = __uint_as_float(((unsigned)WT[(size_t)n * ldt + k]) << 16); const float d = ov - rv; e2 += d * d; r2 += rv * rv; }
    e2 = nv::block_sum_256(e2, red); r2 = nv::block_sum_256(r2, red);
    if (threadIdx.x == 0) { const bool bad = !(e2 <= tol * tol * r2 + 1e-20f); if (bad) atomicAdd(res, 1u); const float rel = sqrtf(e2 / (r2 + 1e-30f)); atomicMax(res + 1, __float_as_uint(rel == rel ? rel : 3.0e38f)); }
}
__global__ void __launch_bounds__(256) k_finalize(float* out, size_t n, const unsigned* res, int nchecks, int mode, int which) {
    int first = -1;
    for (int k = 0; k < nchecks; ++k) { const unsigned allowed = (k >= 22) ? 60u : 0u; if (res[2 * k] > allowed) { first = k; break; } }
    float K = 0.f;
    if (mode == 0) { if (first < 0) return; K = (float)(first + 1); }
    else { const float rel = __uint_as_float(res[2 * which + 1]); K = 1.f + 10.f * fminf(rel, 2.f); }
    for (size_t i = (size_t)blockIdx.x * 256 + threadIdx.x; i < n; i += (size_t)gridDim.x * 256) out[i] = K;
}
}
#endif

#ifndef MK_LAUNCHES
#define MK_LAUNCHES 1
#endif
#ifndef MK_USE_CG
#define MK_USE_CG 0
#endif
#ifndef MK_DBG_MODE
#define MK_DBG_MODE 0
#endif
#ifndef MK_DBG_WHICH
#define MK_DBG_WHICH 0
#endif
extern "C" void kernel_launch(void* const* d_in, const int* in_sizes, int n_in, void* d_out, int out_size, void* d_ws, size_t ws_size, hipStream_t stream) {
    static int grid = 0;
    if (grid == 0) {
        if (n_in != 28 || out_size != NTOK * DM || ws_size < WS_END) { fprintf(stderr, "kernel_launch: unexpected problem (n_in %d out %d ws %zu)\n", n_in, out_size, ws_size); grid = -1; return; }
        int dev = 0, cus = 0, per_cu = 0;
        if (hipGetDevice(&dev) != hipSuccess || hipDeviceGetAttribute(&cus, hipDeviceAttributeMultiprocessorCount, dev) != hipSuccess) { grid = -1; return; }
        if (hipFuncSetAttribute((const void*)mk_fwd, hipFuncAttributeMaxDynamicSharedMemorySize, LDS_BYTES) != hipSuccess) { fprintf(stderr, "kernel_launch: hipFuncSetAttribute failed\n"); grid = -1; return; }
        if (hipOccupancyMaxActiveBlocksPerMultiprocessor(&per_cu, (const void*)mk_fwd, NWAVES * 64, LDS_BYTES) != hipSuccess || per_cu < 1) { fprintf(stderr, "kernel_launch: occupancy query says %d blocks per CU\n", per_cu); grid = -1; return; }
        (void)hipGetLastError();
        if (cus != 256) { fprintf(stderr, "kernel_launch: built for a 256-CU device (role split and unit counts), found %d CUs\n", cus); grid = -1; return; }
        grid = cus;
    }
    if (grid < 0) return;
    (void)hipMemsetAsync((char*)d_ws + WS_CTL, 0, CTL_ZERO_BYTES, stream);
    Args a{};
    for (int i = 0; i < 28; ++i) a.in[i] = (const float*)d_in[i];
    a.out = (float*)d_out; a.ws = (unsigned char*)d_ws; a.use_cg = MK_USE_CG; a.pad = 0;
#if MK_LAUNCHES == 1
    a.ph_lo = 0; a.ph_hi = N_PHASES;
    void* kargs[] = {&a};
#ifdef MK_PLAIN_LAUNCH
    (void)kargs; hipLaunchKernelGGL(mk_fwd, dim3(grid), dim3(NWAVES * 64), LDS_BYTES, stream, a); hipError_t e = hipPeekAtLastError();
#else
    hipError_t e = hipLaunchCooperativeKernel((const void*)mk_fwd, dim3(grid), dim3(NWAVES * 64), kargs, LDS_BYTES, stream);
#endif
    if (e != hipSuccess) fprintf(stderr, "kernel_launch: cooperative launch failed: %s (grid %d)\n", hipGetErrorString(e), grid);
#else
    a.use_cg = 0;
#ifdef MK_DEBUG
    const size_t R = dbg::DL; unsigned char* ws = (unsigned char*)d_ws;
    float* base = (float*)(ws + WS_DBG); size_t off = 0;
    auto take = [&](size_t nfloats) { float* p = base + off; off += (nfloats + 63) & ~(size_t)63; return p; };
    nv::Bufs B; B.nH = take(R * DM); B.nU = take(R * DM); B.nZ = take(R * 6144); B.nD = take(R * 1024); B.nP = take(R * 1024); B.nS0 = take(R * 1024); B.nT = take(R * 1024); B.nS = take(R * 1024);
    B.nYP = take(R * DM); B.nYS = take(R * DM); B.nV = take(R * DM); B.nMoe = take(R * DM); float* nOut = take(R * DM); B.eid = (int*)take(R * 2); B.gate = take(R * 2); B.logits = nullptr;
    if ((size_t)((char*)(base + off) - (char*)d_ws) > ws_size) { fprintf(stderr, "debug buffers do not fit\n"); return; }
    nv::Cfg c{1, 1, dbg::DL};
    nv::run(d_in, B, nOut, 0, c, stream);
    unsigned* res = (unsigned*)(ws + WS_CTL) + CW_DBG;
    const float* const* in = (const float* const*)d_in;
    int k = 0;
#define CMP(opt, isbf, old_, oc0, ref, rld, rc0, nc, kind, tr, tol) dbg::k_cmp<<<(unsigned)R, 256, 0, stream>>>((const void*)(opt), isbf, old_, oc0, ref, rld, rc0, nc, kind, tr, tol, res + 2 * (k++))
#define CWT(WT, ldt, W, W2, ldw, K, mode, nrows) dbg::k_cmp_wt<<<(unsigned)(nrows), 256, 0, stream>>>((const bf16_t*)(WT), ldt, W, W2, ldw, K, mode, 0.01f, res + 2 * (k++))
#endif
    for (int ph = 0; ph < N_PHASES; ++ph) {
        a.ph_lo = ph; a.ph_hi = ph + 1;
        hipLaunchKernelGGL(mk_fwd, dim3(grid), dim3(NWAVES * 64), LDS_BYTES, stream, a);
#ifdef MK_DEBUG
        if (ph == 0) {
            CMP(ws + WS_A1, 1, DM, 0, B.nU, DM, 0, DM, 0, 0, 0.01f);
            CMP(ws + WS_A1M, 1, DM, 0, B.nU, DM, 0, DM, 2, 0, 0.01f);
            CWT(ws + WS_WIN, DM, in[3], nullptr, INW, DM, 0, INW);
            CWT(ws + WS_POOLW + 2 * 65536 * 2, 256, in[4] + 2 * 65536, nullptr, 256, 256, 0, 256);
            CWT(ws + WS_WGLU, SW, in[14], nullptr, SW, SW, 0, SW);
            CWT(ws + WS_WBP, PW, in[16], nullptr, DM, PW, 0, DM);
            CWT(ws + WS_WBS, SW, in[17], nullptr, DM, SW, 0, DM);
            CWT(ws + WS_WOUT, DM, in[18], nullptr, DM, DM, 0, DM);
            CWT(ws + WS_WGU + (size_t)37 * 1024 * DM * 2, DM, in[24] + (size_t)37 * DM * FF, in[25] + (size_t)37 * DM * FF, FF, DM, 1, 1024);
            CWT(ws + WS_WD + (size_t)37 * DM * FF * 2, FF, in[26] + (size_t)37 * FF * DM, nullptr, DM, FF, 0, DM);
        }
        if (ph == 1) {
            CMP(ws + WS_ZP, 1, PW, 0, B.nZ, 6144, 0, 1024, 0, 0, 0.03f);
            CMP(ws + WS_ZP, 1, PW, 0, B.nZ, 6144, 0, 1024, 3, 0, 0.03f);
            CMP(ws + WS_ZS, 1, SW, 0, B.nZ, 6144, 1024, 1024, 0, 0, 0.03f);
            CMP(ws + WS_ZS, 1, SW, 0, B.nZ, 6144, 1024, 1024, 3, 0, 0.03f);
            CMP(ws + WS_GP, 1, DM, 0, B.nZ, 6144, 2048, 2048, 0, 1, 0.03f);
            CMP(ws + WS_GS, 1, DM, 0, B.nZ, 6144, 4096, 2048, 0, 1, 0.03f);
        }
        if (ph == 2) { CMP(ws + WS_DD, 1, PW, 0, B.nD, 1024, 0, 1024, 0, 0, 0.05f); }
        if (ph == 3) { CMP(ws + WS_PP, 1, PW, 0, B.nP, 1024, 0, 1024, 0, 0, 0.05f);
                       CMP(ws + WS_S0, 1, SW, 0, B.nS0, 1024, 0, 1024, 0, 0, 0.05f); }
        if (ph == 4) { CMP(ws + WS_SS, 1, SW, 0, B.nS, 1024, 0, 1024, 0, 0, 0.05f); }
        if (ph == 5) { CMP(ws + WS_MP, 1, DM, 0, B.nYP, DM, 0, DM, 0, 0, 0.06f); }
        if (ph == 7) { CMP(ws + WS_V, 1, DM, 0, B.nH, DM, 0, DM, 0, 0, 0.03f); }
        if (ph == 9) { dbg::k_cmp_moe<<<(unsigned)R, 256, 0, stream>>>((const bf16_t*)(ws + WS_YB), B.nMoe, 0.08f, res + 2 * (k++)); }
        if (ph == 10) { CMP(d_out, 0, DM, 0, nOut, DM, 0, DM, 0, 0, 0.03f); }
#endif
    }
#ifdef MK_DEBUG
#undef CMP
#undef CWT
    dbg::k_finalize<<<1024, 256, 0, stream>>>((float*)d_out, (size_t)NTOK * DM, res, k, MK_DBG_MODE, MK_DBG_WHICH);
#endif
#endif
}
```

```cpp
#include <hip/hip_runtime.h>
#include <hip/hip_cooperative_groups.h>
#include <cstdio>
#include <cstdint>
namespace cg = cooperative_groups;

#define GAS __attribute__((address_space(1)))
#define LAS __attribute__((address_space(3)))
typedef unsigned short bf16_t;
typedef short bf16x8 __attribute__((ext_vector_type(8)));
typedef float f32x4 __attribute__((ext_vector_type(4)));
typedef float f32x16 __attribute__((ext_vector_type(16)));
typedef float f32x2 __attribute__((ext_vector_type(2)));
typedef unsigned u32x4 __attribute__((ext_vector_type(4)));
typedef unsigned u32x2 __attribute__((ext_vector_type(2)));
typedef __bf16 bf16x2v __attribute__((ext_vector_type(2)));
#define DI __device__ __forceinline__
#define RLX_AGENT __ATOMIC_RELAXED, __HIP_MEMORY_SCOPE_AGENT
#define LDS_WAIT() asm volatile("s_waitcnt lgkmcnt(0)" ::: "memory")
#define VM_WAIT() asm volatile("s_waitcnt vmcnt(0)" ::: "memory")

DI unsigned pk2(float lo, float hi) { f32x2 v = {lo, hi}; bf16x2v r = __builtin_convertvector(v, bf16x2v); return __builtin_bit_cast(unsigned, r); }
DI float bflo(unsigned w) { return __uint_as_float(w << 16); }
DI float bfhi(unsigned w) { return __uint_as_float(w & 0xffff0000u); }
DI float fsigm(float x) { return __builtin_amdgcn_rcpf(1.f + __builtin_amdgcn_exp2f(-1.4426950408889634f * x)); }
DI float gelu_t(float x) { const float z = 1.5957691216057308f * (x + 0.044715f * x * x * x); return x * fsigm(z); }
DI float wave_sum(float v) {
#pragma unroll
    for (int o = 1; o < 64; o <<= 1) v += __shfl_xor(v, o);
    return v;
}

constexpr int DM = 2048, SEQ = 8192, NTOK = 16384, NMETA = 16, INW = 6144, PW = 1024, SW = 1024, FF = 512, NE = 64;
constexpr int NCH = 64, CHL = 128;
constexpr int LISTCAP = 16384;
constexpr int HH_ROWS = 49152;
constexpr float RMS_EPS = 1e-6f;
constexpr size_t MiB = 1u << 20;
constexpr size_t WS_CTL = 0, CTL_ZERO_BYTES = 1 * MiB;
constexpr size_t WS_LAM = 1 * MiB, WS_LAMP = WS_LAM + 65536, WS_BCAT = WS_LAM + 262144, WS_CCATT = WS_LAM + 524288, WS_WRH = WS_LAM + 786432, WS_WRL = WS_WRH + 393216,
                 WS_A1M = WS_WRL + 393216, WS_SCR = WS_A1M + 65536, WS_RSTD1 = WS_SCR + 65536, WS_IG = WS_RSTD1 + 65536, WS_E = 3 * MiB, WS_LIST = 8 * MiB;
constexpr size_t WS_WIN = 24 * MiB, WS_POOLW = 48 * MiB, WS_WGLU = 49 * MiB, WS_WBP = 51 * MiB, WS_WBS = 55 * MiB, WS_WOUT = 59 * MiB, WS_WGU = 68 * MiB, WS_WD = 324 * MiB;
constexpr size_t WS_A1 = 452 * MiB, WS_V = WS_A1;
constexpr size_t WS_ZP = 516 * MiB, WS_ZS = 549 * MiB, WS_DD = 582 * MiB, WS_PP = 614 * MiB, WS_S0 = 646 * MiB, WS_SS = 678 * MiB, WS_HH = 516 * MiB, WS_DL = WS_DD;
constexpr size_t WS_GP = 710 * MiB, WS_GS = 774 * MiB, WS_YB = 710 * MiB, WS_MP = 838 * MiB, WS_DBG = 902 * MiB, WS_END = 1024 * MiB;
static_assert(WS_IG + 8192 <= WS_E && WS_E + (size_t)64 * 64 * 64 * 16 <= WS_LIST && WS_LIST + (size_t)NE * LISTCAP * 16 <= WS_WIN, "small region");
static_assert(WS_HH + (size_t)HH_ROWS * FF * 2 <= WS_GP && WS_YB + (size_t)32768 * DM * 2 <= WS_MP, "overlays");
constexpr int CW_BAR = 4096;
constexpr int CW_BAR2 = 8192;
#ifndef CNT_STRIDE
#define CNT_STRIDE 32
#endif
constexpr int CW_CNT = 16384;
constexpr int CW_DBG = 20480;
constexpr int CW_Q = 24576;

#define XB_TMO      128
#define XB_XCNT(j)  (256  + 64 * (j))
#define XB_XSUB(j)  (1280 + 64 * (j))
#define XB_XGEN(j)  (2304 + 64 * (j))
#define XB_TOP      3328
#define XB_TOPGEN   3392
#define XCD_BAR_WORDS 3456
#define XB_SPIN_CAP (1u << 18)
DI unsigned xb_ld(unsigned* p)              { return __hip_atomic_load(p, __ATOMIC_RELAXED, __HIP_MEMORY_SCOPE_AGENT); }
DI unsigned xb_add(unsigned* p, unsigned v) { return __hip_atomic_fetch_add(p, v, __ATOMIC_RELAXED, __HIP_MEMORY_SCOPE_AGENT); }
DI unsigned xb_xcc_id() { return (unsigned)__builtin_amdgcn_s_getreg((3 << 11) | 20) & 0xFu; }
#define XB_SPIN(cond, bar) do { unsigned _sp = 0; while (cond) { __builtin_amdgcn_s_sleep(1); \
    if ((++_sp & 255u) == 0u) { if (xb_ld(&(bar)[XB_TMO])) break; if (_sp > XB_SPIN_CAP) { atomicAdd(&(bar)[XB_TMO], 1u); break; } } } } while (0)
struct XcdBarrier { unsigned* bar; unsigned x; volatile LAS unsigned* st; unsigned expected; };
DI XcdBarrier xcd_barrier_post(unsigned* bar, volatile LAS unsigned* st, unsigned expected) {
    XcdBarrier b; b.bar = bar; b.x = xb_xcc_id(); b.st = st; b.expected = expected;
    if (threadIdx.x == 0) (void)xb_add(&bar[XB_XCNT(b.x)], 1u);
    return b;
}
DI void xcd_barrier_complete(unsigned* bar, unsigned x, unsigned& nloc, unsigned& nx, unsigned G) {
    unsigned sum, cnt, mine, sp = 0u;
    for (;;) {
        sum = 0u; cnt = 0u; mine = 0u;
#pragma unroll
        for (unsigned j = 0; j < 16; ++j) { const unsigned c = xb_ld(&bar[XB_XCNT(j)]); sum += c; cnt += (c > 0u) ? 1u : 0u; mine = (j == x) ? c : mine; }
        if (sum == G) break;
        __builtin_amdgcn_s_sleep(1);
        if ((++sp & 255u) == 0u) { if (xb_ld(&bar[XB_TMO])) break; if (sp > XB_SPIN_CAP) { atomicAdd(&bar[XB_TMO], 1u); break; } }
    }
    nloc = mine > 0u ? mine : 1u; nx = cnt > 0u ? cnt : 1u;
}
DI void xcd_barrier(const XcdBarrier& b) {
    asm volatile("s_waitcnt vmcnt(0)" ::: "memory");
    __syncthreads();
    if (threadIdx.x == 0) {
        unsigned* bar = b.bar;
        __builtin_amdgcn_s_waitcnt(0);
        unsigned nloc = b.st[0], nx = b.st[1];
        if (nloc == 0u) { xcd_barrier_complete(bar, b.x, nloc, nx, b.expected); b.st[0] = nloc; b.st[1] = nx; }
        const unsigned old = xb_add(&bar[XB_XSUB(b.x)], 1u);
        const unsigned gen = old / nloc;
        if (old + 1u == (gen + 1u) * nloc) {
            __builtin_amdgcn_fence(__ATOMIC_RELEASE, "agent");
            asm volatile("s_waitcnt vmcnt(0)" ::: "memory");
            const unsigned og = xb_add(&bar[XB_TOP], 1u);
            const unsigned tg = og / nx;
            if (og + 1u == (tg + 1u) * nx) xb_add(&bar[XB_TOPGEN], 1u);
            else XB_SPIN(xb_ld(&bar[XB_TOPGEN]) == tg, bar);
            __builtin_amdgcn_fence(__ATOMIC_ACQUIRE, "agent");
            xb_add(&bar[XB_XGEN(b.x)], 1u);
            asm volatile("s_waitcnt vmcnt(0)" ::: "memory");
        } else {
            XB_SPIN(xb_ld(&bar[XB_XGEN(b.x)]) == gen, bar);
            __builtin_amdgcn_fence(__ATOMIC_ACQUIRE, "agent");
            asm volatile("s_waitcnt vmcnt(0)" ::: "memory");
        }
    }
    __syncthreads();
}

namespace pg8 {
constexpr int BM = 256, BK = 64, HALF = 128, HTB = HALF * BK * 2, STAGE_BYTES = 8 * HTB, NXCD = 8, WGM = 8;
__host__ __device__ __forceinline__ int lds_byte(int r, int c) { const int st = (r >> 4) * 2 + (c >> 5), rr = r & 15, cc = c & 31, ob = rr * 64 + cc * 2; return st * 1024 + (ob ^ (((ob >> 9) & 1) << 5)); }
__host__ __device__ __forceinline__ void stage_rc(int b, int& R, int& C) { const int st = b / 1024, sb = b % 1024, swz = sb ^ (((sb >> 9) & 1) << 5); R = (st >> 1) * 16 + swz / 64; C = (st & 1) * 32 + (swz % 64) / 2; }
__host__ __device__ __forceinline__ int perm32(int rho) { const int n = rho >> 4, i = rho & 15; return 8 * (i >> 2) + 4 * n + (i & 3); }

struct Unit { const char* A; const char* B; int pm, pn, e, cnt; const uint4* list; };
struct Gemm { int lda, ldb, K; };

struct GridOrder {
    int nM, nN, nwg, G, c;
    DI void init(int nM_, int nN_, int G_, int c_) { nM = nM_; nN = nN_; nwg = nM * nN; G = G_; c = c_; }
    DI bool tile(int i, int& pm, int& pn) const {
        const long L = (long)i * G + c; if (L >= nwg) return false;
        int wgid = (int)L; { const int q = nwg / NXCD, r = nwg % NXCD, xcd = wgid % NXCD, off = wgid / NXCD; wgid = (xcd < r ? xcd * (q + 1) : r * (q + 1) + (xcd - r) * q) + off; }
        const int nig = WGM * nN, gid = wgid / nig, fm = gid * WGM, gsz = (nM - fm) < WGM ? (nM - fm) : WGM;
        pm = fm + ((wgid % nig) % gsz); pn = (wgid % nig) / gsz; return true;
    }
};
struct DenseOrder : GridOrder {
    static constexpr bool GATHER = false;
    const char* A; const char* Bt; size_t tstepA, tstepB;
    DI void setup(const void* A_, const void* Bt_, int M, int N, int lda, int ldb, int G_, int c_) { init(M / BM, N / BM, G_, c_); A = (const char*)A_; Bt = (const char*)Bt_; tstepA = (size_t)BM * lda * 2; tstepB = (size_t)BM * ldb * 2; }
    DI bool next(int i, Unit& u) const { int pm, pn; if (!tile(i, pm, pn)) return false; u.pm = pm; u.pn = pn; u.e = 0; u.cnt = 256; u.list = nullptr; u.A = A + (size_t)pm * tstepA; u.B = Bt + (size_t)pn * tstepB; return true; }
};

constexpr int SIDE_I_GU = 64 * 32 * 16, SIDE_I_DN = 64 * 8 * 64, SIDE_ITEMS = 2 * SIDE_I_GU + SIDE_I_DN;
struct SideNone { static constexpr bool ON = false; };
struct SideConv {
    static constexpr bool ON = true;
    const float *wg, *wu, *wd; bf16_t *WGU, *WD, *scratch; LAS unsigned char* xb;
    int next, end, stride;
    bf16_t* dst0; bf16_t* dst1; int ldt0, ldt1;
    DI void init(const float* wg_, const float* wu_, const float* wd_, bf16_t* WGU_, bf16_t* WD_, bf16_t* scratch_, LAS unsigned char* xb_, int begin, int end_, int stride_) {
        wg = wg_; wu = wu_; wd = wd_; WGU = WGU_; WD = WD_; scratch = scratch_; xb = xb_; next = begin; end = end_; stride = stride_; dst0 = scratch_; dst1 = scratch_; ldt0 = 0; ldt1 = 0; }
    template <int SLOT> DI void issue(int wid, int lane) {
#ifndef SIDE_PROBE
#define SIDE_PROBE 0
#endif
        int idx = next; bool valid = idx < end; if (valid) next += stride; else idx = 0;
        if (SIDE_PROBE == 2) idx = 0;
        const float* W; int ldw, k0, n0, ldt, drow0; bf16_t* WT;
        if (idx < 2 * SIDE_I_GU) { const int up = idx / SIDE_I_GU, q = idx % SIDE_I_GU, e = q >> 9, q2 = q & 511, kb = q2 >> 4, nb = q2 & 15; n0 = 32 * nb; k0 = 64 * kb;
            W = (up ? wu : wg) + (size_t)e * 2048 * 512; ldw = 512; WT = WGU + (size_t)e * 1024 * 2048; ldt = 2048; drow0 = (n0 >> 7) * 256 + (n0 & 127) + up * 128; }
        else { const int r = idx - 2 * SIDE_I_GU, e = r >> 9, q2 = r & 511, kb = q2 >> 6, nb = q2 & 63; n0 = 32 * nb; k0 = 64 * kb;
            W = wd + (size_t)e * 512 * 2048; ldw = 2048; WT = WD + (size_t)e * 2048 * 512; ldt = 512; drow0 = n0; }
        const float* src = W + (size_t)(k0 + 8 * wid + (lane >> 3)) * ldw + n0 + (lane & 7) * 4;
        __builtin_amdgcn_global_load_lds((const unsigned*)src, (LAS unsigned*)(xb + SLOT * 8192 + wid * 1024), 16, 0, 0);
        if (SIDE_PROBE == 1 || SIDE_PROBE == 2) valid = false;
        bf16_t* d = valid ? WT + (size_t)drow0 * ldt + k0 : scratch; const int l2 = valid ? ldt : 0;
        if (SLOT == 0) { dst0 = d; ldt0 = l2; } else { dst1 = d; ldt1 = l2; }
    }
    template <int SLOT> DI void read(int tid, f32x4& v) const {
        const LAS float* xf = (const LAS float*)(xb + SLOT * 8192) + (tid >> 5) * 128 + (tid & 31);
        v[0] = xf[0]; v[1] = xf[32]; v[2] = xf[64]; v[3] = xf[96];
    }
    template <int SLOT> DI void store(int tid, const f32x4& v) const {
        bf16_t* d = (SLOT == 0 ? dst0 : dst1) + (size_t)(tid & 31) * (SLOT == 0 ? ldt0 : ldt1) + 4 * (tid >> 5);
        u32x2 w; w.x = pk2(v[0], v[1]); w.y = pk2(v[2], v[3]); *(u32x2*)d = w;
    }
};

template <class Epi, class Sched, bool ALIGN_EPI = false, bool SP2 = true, class Side = SideNone>
__device__ __forceinline__ void gemm_phase(LAS unsigned char* lds, const Gemm g, const Sched& S, const Epi& E, Side side = Side()) {
    const int tid = threadIdx.x, wid = __builtin_amdgcn_readfirstlane(tid >> 6), lane = tid & 63, wr = wid >> 2, wc = wid & 3, fr = lane & 15, fq = lane >> 4;
    const int K = g.K, nt = K / BK;
    unsigned voffB[2], oA0[2], oA1[2], nA0[2], nA1[2]; int sR[2], sC[2];
    const size_t kstep = (size_t)(BK * 2);
    const unsigned hstepA = (unsigned)HALF * g.lda * 2u; const size_t hstepB = (size_t)HALF * g.ldb * 2;
#pragma unroll
    for (int i = 0; i < 2; ++i) { int R, C; stage_rc(tid * 16 + i * 8192, R, C); const int Rb = Epi::PERM ? ((R & ~31) + perm32(R & 31)) : R; sR[i] = R; sC[i] = C;
        voffB[i] = (unsigned)(Rb * g.ldb + C) * 2u; oA0[i] = (unsigned)(R * g.lda + C) * 2u; oA1[i] = oA0[i] + hstepA; nA0[i] = oA0[i]; nA1[i] = oA1[i]; }
    const unsigned ldsw = (unsigned)wid * 1024u;
    const int aoff = lds_byte(wr * 64 + fr, fq * 8), boff = lds_byte(wc * 32 + fr, fq * 8);
#define PG8_SA(b, h) (((b) * 2 + (h)) * HTB)
#define PG8_SB(b, h) ((4 + (b) * 2 + (h)) * HTB)
#define PG8_STAGE(bufoff, gbase, voff) do { _Pragma("unroll") for (int _i = 0; _i < 2; ++_i) \
        __builtin_amdgcn_global_load_lds((const unsigned*)((const char*)(gbase) + (voff)[_i]), (LAS unsigned*)(lds + (bufoff) + ldsw + _i * 8192), 16, 0, 0); } while (0)
#define PG8_LDA(dst, b, h) do { _Pragma("unroll") for (int m = 0; m < 4; ++m) _Pragma("unroll") for (int k = 0; k < 2; ++k) dst[m][k] = *(const LAS bf16x8*)(lds + PG8_SA(b, h) + aoff + m * 2048 + k * 1024); } while (0)
#define PG8_LDB(dst, b, h) do { _Pragma("unroll") for (int n = 0; n < 2; ++n) _Pragma("unroll") for (int k = 0; k < 2; ++k) dst[n][k] = *(const LAS bf16x8*)(lds + PG8_SB(b, h) + boff + n * 2048 + k * 1024); } while (0)
#define PG8_MMA(ai, bj, At, Bt) do { __builtin_amdgcn_s_setprio(1); _Pragma("unroll") for (int m = 0; m < 4; ++m) _Pragma("unroll") for (int n = 0; n < 2; ++n) _Pragma("unroll") for (int k = 0; k < 2; ++k) \
        acc[ai][bj][m][n] = __builtin_amdgcn_mfma_f32_16x16x32_bf16(Bt[n][k], At[m][k], acc[ai][bj][m][n], 0, 0, 0); __builtin_amdgcn_s_setprio(0); } while (0)
#define PG8_WAIT_V(n) asm volatile("s_waitcnt vmcnt(" #n ")" ::: "memory")
#define PG8_WAIT_L(n) asm volatile("s_waitcnt lgkmcnt(" #n ")" ::: "memory")
#define PG8_BAR __builtin_amdgcn_s_barrier()
#define PG8_SCHED __builtin_amdgcn_sched_barrier(0)
#define PG8_GOFF(u, d0, d1) do { _Pragma("unroll") for (int _i = 0; _i < 2; ++_i) { \
        const unsigned _t0 = (u).list[sR[_i]].x, _t1 = (u).list[HALF + sR[_i]].x; d0[_i] = (_t0 * (unsigned)g.lda + (unsigned)sC[_i]) * 2u; d1[_i] = (_t1 * (unsigned)g.lda + (unsigned)sC[_i]) * 2u; } } while (0)
    Unit cur, nxt; int ui = 0;
    if (!S.next(0, cur)) return;
    f32x4 acc[2][2][4][2];
#pragma unroll
    for (int a = 0; a < 2; ++a)
#pragma unroll
        for (int b = 0; b < 2; ++b)
#pragma unroll
            for (int m = 0; m < 4; ++m)
#pragma unroll
                for (int n = 0; n < 2; ++n) acc[a][b][m][n] = (f32x4){0.f, 0.f, 0.f, 0.f};
    bf16x8 At[4][2], B0[2][2], B1[2][2];
    const char* cA = cur.A; const char* cB = cur.B;
    if constexpr (Sched::GATHER) { PG8_GOFF(cur, oA0, oA1); }
    if constexpr (SP2) {
        PG8_STAGE(PG8_SB(0, 0), cB, voffB); PG8_STAGE(PG8_SB(0, 1), cB + hstepB, voffB); PG8_STAGE(PG8_SA(0, 0), cA, oA0); PG8_STAGE(PG8_SA(0, 1), cA, oA1);
        if (wr == 1) PG8_BAR;
        PG8_WAIT_V(2); PG8_BAR;
        PG8_STAGE(PG8_SB(1, 0), cB + kstep, voffB); PG8_STAGE(PG8_SA(1, 0), cA + kstep, oA0); PG8_STAGE(PG8_SB(1, 1), cB + hstepB + kstep, voffB);
        PG8_WAIT_V(6); PG8_BAR;
    } else {
        PG8_STAGE(PG8_SB(0, 0), cB, voffB); PG8_STAGE(PG8_SA(0, 0), cA, oA0); PG8_STAGE(PG8_SB(0, 1), cB + hstepB, voffB); PG8_STAGE(PG8_SA(0, 1), cA, oA1);
        if (wr == 1) PG8_BAR;
        PG8_WAIT_V(4); PG8_BAR;
        PG8_STAGE(PG8_SB(1, 0), cB + kstep, voffB); PG8_STAGE(PG8_SA(1, 0), cA + kstep, oA0); PG8_STAGE(PG8_SB(1, 1), cB + hstepB + kstep, voffB);
        PG8_WAIT_V(6); PG8_BAR;
    }
    for (;;) {
        const bool has_next = S.next(ui + 1, nxt);
        const char* nA = has_next ? nxt.A : cA; const char* nB = has_next ? nxt.B : cB;
        if constexpr (Sched::GATHER) { if (has_next) { PG8_GOFF(nxt, nA0, nA1); } else {
#pragma unroll
            for (int i = 0; i < 2; ++i) { nA0[i] = oA0[i]; nA1[i] = oA1[i]; } } }
#pragma nounroll
        for (int t = 0; t < nt; t += 2) {
            const bool last = (t == nt - 2);
            const char* a1 = cA + (size_t)(t + 1) * kstep;
            const char* a2 = last ? nA : cA + (size_t)(t + 2) * kstep; const char* b2 = last ? nB : cB + (size_t)(t + 2) * kstep;
            const char* a3 = a2 + kstep; const char* b3 = b2 + kstep;
            unsigned q0[2], q1[2];
#pragma unroll
            for (int i = 0; i < 2; ++i) { q0[i] = (Sched::GATHER && last) ? nA0[i] : oA0[i]; q1[i] = (Sched::GATHER && last) ? nA1[i] : oA1[i]; }
            if constexpr (SP2) {
            if constexpr (Side::ON) {
            f32x4 sv;
            PG8_LDB(B0, 0, 0); PG8_LDB(B1, 0, 1); PG8_SCHED; PG8_LDA(At, 0, 0); PG8_STAGE(PG8_SA(1, 1), a1, oA1); side.template read<0>(tid, sv);
            PG8_WAIT_V(9); PG8_WAIT_L(0); PG8_BAR; PG8_MMA(0, 0, At, B0); side.template store<0>(tid, sv); PG8_MMA(0, 1, At, B1); PG8_BAR; PG8_SCHED;
            PG8_LDA(At, 0, 1); PG8_STAGE(PG8_SB(0, 0), b2, voffB); PG8_STAGE(PG8_SB(0, 1), b2 + hstepB, voffB); PG8_STAGE(PG8_SA(0, 0), a2, q0);
            PG8_WAIT_V(9); PG8_WAIT_L(0); PG8_BAR; PG8_MMA(1, 0, At, B0); side.template issue<0>(wid, lane); PG8_MMA(1, 1, At, B1); PG8_BAR; PG8_SCHED;
            PG8_LDB(B0, 1, 0); PG8_LDB(B1, 1, 1); PG8_SCHED; PG8_LDA(At, 1, 0); PG8_STAGE(PG8_SA(0, 1), a2, q1); side.template read<1>(tid, sv);
            PG8_WAIT_V(9); PG8_WAIT_L(0); PG8_BAR; PG8_MMA(0, 0, At, B0); side.template store<1>(tid, sv); PG8_MMA(0, 1, At, B1); PG8_BAR; PG8_SCHED;
            PG8_LDA(At, 1, 1); PG8_STAGE(PG8_SB(1, 0), b3, voffB); PG8_STAGE(PG8_SB(1, 1), b3 + hstepB, voffB); PG8_STAGE(PG8_SA(1, 0), a3, q0);
            PG8_WAIT_V(9); PG8_WAIT_L(0); PG8_BAR; PG8_MMA(1, 0, At, B0); side.template issue<1>(wid, lane); PG8_MMA(1, 1, At, B1); PG8_BAR; PG8_SCHED;
            } else {
            PG8_LDB(B0, 0, 0); PG8_LDB(B1, 0, 1); PG8_SCHED; PG8_LDA(At, 0, 0); PG8_STAGE(PG8_SA(1, 1), a1, oA1);
            PG8_WAIT_V(8); PG8_WAIT_L(0); PG8_BAR; PG8_MMA(0, 0, At, B0); PG8_MMA(0, 1, At, B1); PG8_BAR; PG8_SCHED;
            PG8_LDA(At, 0, 1); PG8_STAGE(PG8_SB(0, 0), b2, voffB); PG8_STAGE(PG8_SB(0, 1), b2 + hstepB, voffB); PG8_STAGE(PG8_SA(0, 0), a2, q0);
            PG8_WAIT_V(8); PG8_WAIT_L(0); PG8_BAR; PG8_MMA(1, 0, At, B0); PG8_MMA(1, 1, At, B1); PG8_BAR; PG8_SCHED;
            PG8_LDB(B0, 1, 0); PG8_LDB(B1, 1, 1); PG8_SCHED; PG8_LDA(At, 1, 0); PG8_STAGE(PG8_SA(0, 1), a2, q1);
            PG8_WAIT_V(8); PG8_WAIT_L(0); PG8_BAR; PG8_MMA(0, 0, At, B0); PG8_MMA(0, 1, At, B1); PG8_BAR; PG8_SCHED;
            PG8_LDA(At, 1, 1); PG8_STAGE(PG8_SB(1, 0), b3, voffB); PG8_STAGE(PG8_SB(1, 1), b3 + hstepB, voffB); PG8_STAGE(PG8_SA(1, 0), a3, q0);
            PG8_WAIT_V(8); PG8_WAIT_L(0); PG8_BAR; PG8_MMA(1, 0, At, B0); PG8_MMA(1, 1, At, B1); PG8_BAR; PG8_SCHED;
            }
            } else {
            PG8_LDB(B0, 0, 0); PG8_SCHED; PG8_LDA(At, 0, 0); PG8_STAGE(PG8_SA(1, 1), a1, oA1);
            PG8_WAIT_L(8); PG8_BAR; PG8_WAIT_L(0); PG8_MMA(0, 0, At, B0); PG8_BAR; PG8_SCHED;
            PG8_LDB(B1, 0, 1); PG8_STAGE(PG8_SB(0, 0), b2, voffB);
            PG8_BAR; PG8_WAIT_L(0); PG8_MMA(0, 1, At, B1); PG8_BAR;
            PG8_LDA(At, 0, 1); PG8_STAGE(PG8_SA(0, 0), a2, q0);
            PG8_BAR; PG8_WAIT_L(0); PG8_MMA(1, 0, At, B0); PG8_BAR; PG8_SCHED;
            PG8_STAGE(PG8_SB(0, 1), b2 + hstepB, voffB);
            PG8_WAIT_V(6); PG8_BAR; PG8_MMA(1, 1, At, B1); PG8_BAR;
            PG8_LDB(B0, 1, 0); PG8_SCHED; PG8_LDA(At, 1, 0); PG8_STAGE(PG8_SA(0, 1), a2, q1);
            PG8_WAIT_L(8); PG8_BAR; PG8_WAIT_L(0); PG8_MMA(0, 0, At, B0); PG8_BAR; PG8_SCHED;
            PG8_LDB(B1, 1, 1); PG8_STAGE(PG8_SB(1, 0), b3, voffB);
            PG8_BAR; PG8_WAIT_L(0); PG8_MMA(0, 1, At, B1); PG8_BAR;
            PG8_LDA(At, 1, 1); PG8_STAGE(PG8_SA(1, 0), a3, q0);
            PG8_BAR; PG8_WAIT_L(0); PG8_MMA(1, 0, At, B0); PG8_BAR; PG8_SCHED;
            PG8_STAGE(PG8_SB(1, 1), b3 + hstepB, voffB);
            PG8_WAIT_V(6); PG8_BAR; PG8_MMA(1, 1, At, B1); PG8_BAR;
            }
        }
        if constexpr (ALIGN_EPI) { if (wr == 0) PG8_BAR; }
#ifndef PROBE_EPI2
#define PROBE_EPI2 0
#endif
        E(acc, cur, wr, wc, fr, fq);
        if (((PROBE_EPI2 >> Epi::EID) & 1) && Epi::IDEMPOTENT) { asm volatile("" ::: "memory"); E(acc, cur, wr, wc, fr, fq); }
        if (!has_next) break;
        if (!Epi::keep_acc(cur)) {
#pragma unroll
        for (int a = 0; a < 2; ++a)
#pragma unroll
            for (int b = 0; b < 2; ++b)
#pragma unroll
                for (int m = 0; m < 4; ++m)
#pragma unroll
                    for (int n = 0; n < 2; ++n) acc[a][b][m][n] = (f32x4){0.f, 0.f, 0.f, 0.f};
        }
        cur = nxt; cA = nA; cB = nB; ++ui;
        if constexpr (Sched::GATHER) {
#pragma unroll
            for (int i = 0; i < 2; ++i) { oA0[i] = nA0[i]; oA1[i] = nA1[i]; } }
        if constexpr (ALIGN_EPI) { if (wr == 1) PG8_BAR; }
    }
    PG8_WAIT_V(0);
    if constexpr (!ALIGN_EPI) { if (wr == 0) PG8_BAR; }
    PG8_BAR;
    if constexpr (Side::ON) { f32x4 s0, s1; side.template read<0>(tid, s0); side.template read<1>(tid, s1); PG8_WAIT_L(0); side.template store<0>(tid, s0); side.template store<1>(tid, s1); PG8_WAIT_V(0); PG8_BAR; }
#undef PG8_SA
#undef PG8_SB
#undef PG8_STAGE
#undef PG8_LDA
#undef PG8_LDB
#undef PG8_MMA
#undef PG8_WAIT_V
#undef PG8_WAIT_L
#undef PG8_BAR
#undef PG8_SCHED
#undef PG8_GOFF
}
}
#ifndef YB_FP8
#define YB_FP8 1
#endif
namespace pg8 {
#ifndef NT_STORES
#define NT_STORES 0
#endif
#if NT_STORES == 1
#define ST16(p, v) __builtin_nontemporal_store((v), (p))
#elif NT_STORES == 2
DI void st16_sc1(u32x4* p, const u32x4& v) { asm volatile("global_store_dwordx4 %0, %1, off sc1\n\ts_nop 1" :: "v"(p), "v"(v) : "memory"); }
#define ST16(p, v) st16_sc1((p), (v))
#else
#define ST16(p, v) (*(p) = (v))
#endif
typedef f32x4 Acc[2][2][4][2];
DI u32x4 pack8(const f32x4& v0, const f32x4& v1) { u32x4 w; w.x = pk2(v0[0], v0[1]); w.y = pk2(v0[2], v0[3]); w.z = pk2(v1[0], v1[1]); w.w = pk2(v1[2], v1[3]); return w; }
DI void unpack8(const u32x4& w, f32x4& v0, f32x4& v1) { v0 = (f32x4){bflo(w.x), bfhi(w.x), bflo(w.y), bfhi(w.y)}; v1 = (f32x4){bflo(w.z), bfhi(w.z), bflo(w.w), bfhi(w.w)}; }

DI unsigned pack_u8x4(const f32x4& g, float lo) { unsigned w = 0;
    w = __builtin_amdgcn_cvt_pk_u8_f32(fmaxf(__builtin_floorf(255.f * g[0] + 0.5f), lo), 0, w); w = __builtin_amdgcn_cvt_pk_u8_f32(fmaxf(__builtin_floorf(255.f * g[1] + 0.5f), lo), 1, w);
    w = __builtin_amdgcn_cvt_pk_u8_f32(fmaxf(__builtin_floorf(255.f * g[2] + 0.5f), lo), 2, w); w = __builtin_amdgcn_cvt_pk_u8_f32(fmaxf(__builtin_floorf(255.f * g[3] + 0.5f), lo), 3, w); return w; }
DI f32x4 unpack_u8x4(unsigned w) { return (f32x4){(float)(w & 0xffu), (float)((w >> 8) & 0xffu), (float)((w >> 16) & 0xffu), (float)(w >> 24)}; }
struct EpiZ {
    static DI bool keep_acc(const Unit&) { return false; }
    static constexpr bool PERM = true, IDEMPOTENT = true; static constexpr int EID = 0;
    bf16_t *ZP, *ZS; unsigned char *GP, *GS;
    DI void operator()(Acc& acc, const Unit& u, int wr, int wc, int fr, int fq) const {
        const int pn = u.pn; const int row0 = u.pm * BM + wr * 64 + fr;
        if (pn < 8) {
            bf16_t* base = pn < 4 ? ZP : ZS; const int col0 = (pn & 3) * 256 + wc * 32 + 8 * fq;
#pragma unroll
            for (int ai = 0; ai < 2; ++ai)
#pragma unroll
                for (int m = 0; m < 4; ++m) { bf16_t* rowp = base + (size_t)(row0 + ai * HALF + m * 16) * PW + col0;
#pragma unroll
                    for (int bj = 0; bj < 2; ++bj) ST16((u32x4*)(rowp + bj * HALF), pack8(acc[ai][bj][m][0], acc[ai][bj][m][1])); }
        } else {
            unsigned char* base = pn < 16 ? GP : GS; const float lo = pn < 16 ? 0.f : 1.f; const int col0 = (pn & 7) * 256 + wc * 32 + 8 * fq;
#pragma unroll
            for (int ai = 0; ai < 2; ++ai)
#pragma unroll
                for (int m = 0; m < 4; ++m) { unsigned char* rowp = base + (size_t)(row0 + ai * HALF + m * 16) * DM + col0;
#pragma unroll
                    for (int bj = 0; bj < 2; ++bj) { f32x4 v0 = acc[ai][bj][m][0], v1 = acc[ai][bj][m][1];
#pragma unroll
                        for (int j = 0; j < 4; ++j) { v0[j] = fsigm(v0[j]); v1[j] = fsigm(v1[j]); }
                        *(u32x2*)(rowp + bj * HALF) = (u32x2){pack_u8x4(v0, lo), pack_u8x4(v1, lo)}; } }
        }
    }
};
struct EpiPool {
    static DI bool keep_acc(const Unit&) { return false; }
    static constexpr bool PERM = true, IDEMPOTENT = true; static constexpr int EID = 1;
    bf16_t* PP; const float* scale;
    DI void operator()(Acc& acc, const Unit& u, int wr, int wc, int fr, int fq) const {
        const int row0 = u.pm * BM + wr * 64 + fr, col0 = u.pn * 256 + wc * 32 + 8 * fq;
        f32x4 sc[2][2];
#pragma unroll
        for (int bj = 0; bj < 2; ++bj) { sc[bj][0] = *(const f32x4*)(scale + col0 + bj * HALF); sc[bj][1] = *(const f32x4*)(scale + col0 + bj * HALF + 4); }
#pragma unroll
        for (int ai = 0; ai < 2; ++ai)
#pragma unroll
            for (int m = 0; m < 4; ++m) { bf16_t* rowp = PP + (size_t)(row0 + ai * HALF + m * 16) * PW + col0;
#pragma unroll
                for (int bj = 0; bj < 2; ++bj) *(u32x4*)(rowp + bj * HALF) = pack8(acc[ai][bj][m][0] * sc[bj][0], acc[ai][bj][m][1] * sc[bj][1]); }
    }
};
struct EpiGlu {
    static DI bool keep_acc(const Unit&) { return false; }
    static constexpr bool PERM = true, IDEMPOTENT = true; static constexpr int EID = 2;
    const bf16_t* S0; bf16_t* SS; const float* bias;
    DI void operator()(Acc& acc, const Unit& u, int wr, int wc, int fr, int fq) const {
        const int row0 = u.pm * BM + wr * 64 + fr, col0 = u.pn * 256 + wc * 32 + 8 * fq;
        f32x4 bv[2][2];
#pragma unroll
        for (int bj = 0; bj < 2; ++bj) { bv[bj][0] = *(const f32x4*)(bias + col0 + bj * HALF); bv[bj][1] = *(const f32x4*)(bias + col0 + bj * HALF + 4); }
#pragma unroll
        for (int ai = 0; ai < 2; ++ai) {
            u32x4 sw[4][2];
#pragma unroll
            for (int m = 0; m < 4; ++m)
#pragma unroll
                for (int bj = 0; bj < 2; ++bj) sw[m][bj] = *(const u32x4*)(S0 + (size_t)(row0 + ai * HALF + m * 16) * SW + col0 + bj * HALF);
#pragma unroll
            for (int m = 0; m < 4; ++m) { const size_t off = (size_t)(row0 + ai * HALF + m * 16) * SW + col0;
#pragma unroll
                for (int bj = 0; bj < 2; ++bj) { f32x4 s0, s1; unpack8(sw[m][bj], s0, s1);
                    f32x4 t0 = acc[ai][bj][m][0] + bv[bj][0], t1 = acc[ai][bj][m][1] + bv[bj][1];
#pragma unroll
                    for (int j = 0; j < 4; ++j) { t0[j] = s0[j] * fsigm(t0[j]); t1[j] = s1[j] * fsigm(t1[j]); }
                    *(u32x4*)(SS + off + bj * HALF) = pack8(t0, t1); } }
            asm volatile("" ::: "memory");
        }
    }
};
template <bool ADD> struct EpiGate {
    static DI bool keep_acc(const Unit&) { return false; }
    static constexpr bool PERM = true, IDEMPOTENT = !ADD; static constexpr int EID = 3;
    const bf16_t* G; bf16_t* MP;
    DI void operator()(Acc& acc, const Unit& u, int wr, int wc, int fr, int fq) const {
        const int row0 = u.pm * BM + wr * 64 + fr, col0 = u.pn * 256 + wc * 32 + 8 * fq;
#pragma unroll
        for (int ai = 0; ai < 2; ++ai)
#pragma unroll
            for (int m = 0; m < 4; ++m) { const size_t off = (size_t)(row0 + ai * HALF + m * 16) * DM + col0;
#pragma unroll
                for (int bj = 0; bj < 2; ++bj) { const u32x4 gw = *(const u32x4*)(G + off + bj * HALF); f32x4 g0, g1; unpack8(gw, g0, g1);
                    f32x4 t0 = acc[ai][bj][m][0] * g0, t1 = acc[ai][bj][m][1] * g1;
                    if (ADD) { const u32x4 pw = *(const u32x4*)(MP + off + bj * HALF); f32x4 p0, p1; unpack8(pw, p0, p1); t0 += p0; t1 += p1; }
                    *(u32x4*)(MP + off + bj * HALF) = pack8(t0, t1); } }
    }
};
struct EpiMerge {
    static DI bool keep_acc(const Unit& u) { return u.e == 0; }
    static constexpr bool PERM = true, IDEMPOTENT = false; static constexpr int EID = 8;
    const unsigned char* GP; const unsigned char* GS; bf16_t* MP;
    DI void operator()(Acc& acc, const Unit& u, int wr, int wc, int fr, int fq) const {
        const int row0 = u.pm * BM + wr * 64 + fr, col0 = u.pn * 256 + wc * 32 + 8 * fq;
        if (u.e == 0) {
#pragma unroll
            for (int ai = 0; ai < 2; ++ai) {
                u32x2 sw[4][2], pw[4][2];
#pragma unroll
                for (int m = 0; m < 4; ++m)
#pragma unroll
                    for (int bj = 0; bj < 2; ++bj) { const size_t off = (size_t)(row0 + ai * HALF + m * 16) * DM + col0 + bj * HALF; sw[m][bj] = *(const u32x2*)(GS + off); pw[m][bj] = *(const u32x2*)(GP + off); }
#pragma unroll
                for (int m = 0; m < 4; ++m)
#pragma unroll
                    for (int bj = 0; bj < 2; ++bj) { const f32x4 s0 = unpack_u8x4(sw[m][bj].x), s1 = unpack_u8x4(sw[m][bj].y), p0 = unpack_u8x4(pw[m][bj].x), p1 = unpack_u8x4(pw[m][bj].y);
#pragma unroll
                        for (int j = 0; j < 4; ++j) { acc[ai][bj][m][0][j] *= p0[j] * __builtin_amdgcn_rcpf(s0[j]); acc[ai][bj][m][1][j] *= p1[j] * __builtin_amdgcn_rcpf(s1[j]); } }
            }
        } else {
            constexpr float I255 = 1.f / 255.f;
#pragma unroll
            for (int ai = 0; ai < 2; ++ai) {
                u32x2 sw[4][2];
#pragma unroll
                for (int m = 0; m < 4; ++m)
#pragma unroll
                    for (int bj = 0; bj < 2; ++bj) sw[m][bj] = *(const u32x2*)(GS + (size_t)(row0 + ai * HALF + m * 16) * DM + col0 + bj * HALF);
#pragma unroll
                for (int m = 0; m < 4; ++m)
#pragma unroll
                    for (int bj = 0; bj < 2; ++bj) { const f32x4 s0 = unpack_u8x4(sw[m][bj].x) * I255, s1 = unpack_u8x4(sw[m][bj].y) * I255;
                        *(u32x4*)(MP + (size_t)(row0 + ai * HALF + m * 16) * DM + col0 + bj * HALF) = pack8(acc[ai][bj][m][0] * s0, acc[ai][bj][m][1] * s1); }
                asm volatile("" ::: "memory");
            }
        }
    }
};
struct MergeOrder : GridOrder {
    static constexpr bool GATHER = false;
    const char *A0, *B0, *A1, *B1; size_t tstepA, tstepB;
    DI bool next(int i, Unit& u) const { int pm, pn; if (!tile(i >> 1, pm, pn)) return false; const int h = i & 1; u.pm = pm; u.pn = pn; u.e = h; u.cnt = 256; u.list = nullptr;
        u.A = (h ? A1 : A0) + (size_t)pm * tstepA; u.B = (h ? B1 : B0) + (size_t)pn * tstepB; return true; }
};
struct EpiDelta {
    static DI bool keep_acc(const Unit&) { return false; }
    static constexpr bool PERM = true, IDEMPOTENT = true; static constexpr int EID = 4;
    bf16_t* DL;
    DI void operator()(Acc& acc, const Unit& u, int wr, int wc, int fr, int fq) const {
        const int row0 = u.pm * BM + wr * 64 + fr, col0 = u.pn * 256 + wc * 32 + 8 * fq;
#pragma unroll
        for (int ai = 0; ai < 2; ++ai)
#pragma unroll
            for (int m = 0; m < 4; ++m) { bf16_t* rowp = DL + (size_t)(row0 + ai * HALF + m * 16) * DM + col0;
#pragma unroll
                for (int bj = 0; bj < 2; ++bj) ST16((u32x4*)(rowp + bj * HALF), pack8(acc[ai][bj][m][0], acc[ai][bj][m][1])); }
    }
};
struct EpiH1 {
    static DI bool keep_acc(const Unit&) { return false; }
    static constexpr bool PERM = true, IDEMPOTENT = false; static constexpr int EID = 9;
    bf16_t* V; const float* rstd1; const float* ig;
    DI void operator()(Acc& acc, const Unit& u, int wr, int wc, int fr, int fq) const {
        const int row0 = u.pm * BM + wr * 64 + fr, col0 = u.pn * 256 + wc * 32 + 8 * fq;
        f32x4 g[2][2];
#pragma unroll
        for (int bj = 0; bj < 2; ++bj) { g[bj][0] = *(const f32x4*)(ig + col0 + bj * HALF); g[bj][1] = *(const f32x4*)(ig + col0 + bj * HALF + 4); }
#pragma unroll
        for (int ai = 0; ai < 2; ++ai) {
            u32x4 uw[4][2]; float inv[4];
#pragma unroll
            for (int m = 0; m < 4; ++m) { const int row = row0 + ai * HALF + m * 16; inv[m] = rstd1[row];
#pragma unroll
                for (int bj = 0; bj < 2; ++bj) uw[m][bj] = *(const u32x4*)(V + (size_t)row * DM + col0 + bj * HALF); }
#pragma unroll
            for (int m = 0; m < 4; ++m) { const float iv = __builtin_amdgcn_rcpf(inv[m]); bf16_t* rowp = V + (size_t)(row0 + ai * HALF + m * 16) * DM + col0;
#pragma unroll
                for (int bj = 0; bj < 2; ++bj) { f32x4 u0, u1; unpack8(uw[m][bj], u0, u1);
                    *(u32x4*)(rowp + bj * HALF) = pack8(u0 * g[bj][0] * iv + acc[ai][bj][m][0], u1 * g[bj][1] * iv + acc[ai][bj][m][1]); } }
            asm volatile("" ::: "memory");
        }
    }
};
struct EpiResid {
    static DI bool keep_acc(const Unit&) { return false; }
    static constexpr bool PERM = false, IDEMPOTENT = true; static constexpr int EID = 5;
    const float* X; float* H1;
    DI void operator()(Acc& acc, const Unit& u, int wr, int wc, int fr, int fq) const {
        const int row0 = u.pm * BM + wr * 64 + fr, col0 = u.pn * 256 + wc * 32 + 4 * fq;
#pragma unroll
        for (int ai = 0; ai < 2; ++ai)
#pragma unroll
            for (int m = 0; m < 4; ++m) { const size_t off = (size_t)(row0 + ai * HALF + m * 16) * DM + col0;
#pragma unroll
                for (int bj = 0; bj < 2; ++bj)
#pragma unroll
                    for (int n = 0; n < 2; ++n) { const f32x4 xv = *(const f32x4*)(X + off + bj * HALF + n * 16); *(f32x4*)(H1 + off + bj * HALF + n * 16) = xv + acc[ai][bj][m][n]; }
                asm volatile("" ::: "memory"); }
    }
};
struct EpiMoeUp {
    static DI bool keep_acc(const Unit&) { return false; }
    static constexpr bool PERM = true, IDEMPOTENT = true; static constexpr int EID = 6;
    bf16_t* HH;
    DI void operator()(Acc& acc, const Unit& u, int wr, int wc, int fr, int fq) const {
        const int col0 = u.pn * 128 + wc * 32 + 8 * fq;
        float rsv[2][4];
#pragma unroll
        for (int ai = 0; ai < 2; ++ai)
#pragma unroll
            for (int m = 0; m < 4; ++m) rsv[ai][m] = __uint_as_float(u.list[ai * HALF + wr * 64 + m * 16 + fr].w);
#pragma unroll
        for (int ai = 0; ai < 2; ++ai)
#pragma unroll
            for (int m = 0; m < 4; ++m) { const int r = ai * HALF + wr * 64 + m * 16 + fr; const float rs = rsv[ai][m];
                f32x4 g0 = acc[ai][0][m][0] * rs, g1 = acc[ai][0][m][1] * rs, u0 = acc[ai][1][m][0] * rs, u1 = acc[ai][1][m][1] * rs;
#pragma unroll
                for (int j = 0; j < 4; ++j) { g0[j] = g0[j] * fsigm(g0[j]) * u0[j]; g1[j] = g1[j] * fsigm(g1[j]) * u1[j]; }
                *(u32x4*)(HH + (size_t)(u.pm + r) * FF + col0) = pack8(g0, g1); }
    }
};
struct EpiMoeDown {
    static DI bool keep_acc(const Unit&) { return false; }
    static constexpr bool PERM = true, IDEMPOTENT = true; static constexpr int EID = 7;
    bf16_t* YB;
    DI void operator()(Acc& acc, const Unit& u, int wr, int wc, int fr, int fq) const {
        const int col0 = u.pn * 256 + wc * 32 + 8 * fq;
        unsigned dstv[2][4]; float wv[2][4];
#pragma unroll
        for (int ai = 0; ai < 2; ++ai)
#pragma unroll
            for (int m = 0; m < 4; ++m) { const uint4* le = u.list + (ai * HALF + wr * 64 + m * 16 + fr); dstv[ai][m] = le->y; wv[ai][m] = __uint_as_float(le->z); }
#pragma unroll
        for (int ai = 0; ai < 2; ++ai)
#pragma unroll
            for (int m = 0; m < 4; ++m) { const int r = ai * HALF + wr * 64 + m * 16 + fr;
#if YB_FP8
                if (r < u.cnt) { const float w = wv[ai][m] * 16.f; unsigned char* rowp = (unsigned char*)YB + (size_t)dstv[ai][m] * DM + col0;
#pragma unroll
                    for (int bj = 0; bj < 2; ++bj) { f32x4 a0 = acc[ai][bj][m][0] * w, a1 = acc[ai][bj][m][1] * w; int lo = 0, hi = 0;
#pragma unroll
                        for (int j = 0; j < 4; ++j) { a0[j] = __builtin_amdgcn_fmed3f(a0[j], -416.f, 416.f); a1[j] = __builtin_amdgcn_fmed3f(a1[j], -416.f, 416.f); }
                        lo = __builtin_amdgcn_cvt_pk_fp8_f32(a0[0], a0[1], lo, false); lo = __builtin_amdgcn_cvt_pk_fp8_f32(a0[2], a0[3], lo, true);
                        hi = __builtin_amdgcn_cvt_pk_fp8_f32(a1[0], a1[1], hi, false); hi = __builtin_amdgcn_cvt_pk_fp8_f32(a1[2], a1[3], hi, true);
                        *(u32x2*)(rowp + bj * HALF) = (u32x2){(unsigned)lo, (unsigned)hi}; } } }
#else
                if (r < u.cnt) { const float w = wv[ai][m]; bf16_t* rowp = YB + (size_t)dstv[ai][m] * DM + col0;
#pragma unroll
                    for (int bj = 0; bj < 2; ++bj) ST16((u32x4*)(rowp + bj * HALF), pack8(acc[ai][bj][m][0] * w, acc[ai][bj][m][1] * w)); } }
#endif
    }
};

struct MoeOrder {
    static constexpr bool GATHER_UP = true;
    const volatile LAS int* tab; int ntn, G, vcu; const uint4* list; const char* Abase; const char* Bbase; size_t bstep_e, bstep_n, astep_row; bool up;
    DI bool decode(int i, Unit& u) const {
        const int U = i * G + vcu; const int lane = threadIdx.x & 63;
        const int total = tab[64];
        if (U >= total) return false;
        const int ce = tab[lane + 1];
        const unsigned long long m = __ballot(ce > U);
        const int e = __builtin_amdgcn_readfirstlane((int)__builtin_ctzll(m));
        const int loc = U - tab[e]; const int mb = loc / ntn, nb = loc % ntn;
        const int cnt = tab[160 + e] - mb * 256;
        u.e = e; u.cnt = cnt < 256 ? cnt : 256; u.pn = nb; u.pm = tab[80 + e] + mb * 256; u.list = list + (size_t)e * LISTCAP + mb * 256;
        u.B = Bbase + (size_t)e * bstep_e + (size_t)nb * bstep_n;
        u.A = up ? Abase : Abase + (size_t)u.pm * astep_row;
        return true;
    }
};
struct MoeUpOrder : MoeOrder { static constexpr bool GATHER = true; DI bool next(int i, Unit& u) const { return decode(i, u); } };
struct MoeDownOrder : MoeOrder { static constexpr bool GATHER = false; DI bool next(int i, Unit& u) const { return decode(i, u); } };
struct PoolOrder : GridOrder {
    static constexpr bool GATHER = false;
    const char* DD; const char* PWT;
    DI bool next(int i, Unit& u) const { int pm, pn; if (!tile(i, pm, pn)) return false; u.pm = pm; u.pn = pn; u.e = 0; u.cnt = 256; u.list = nullptr;
        u.A = DD + ((size_t)pm * 256 * PW + (size_t)pn * 256) * 2; u.B = PWT + (size_t)pn * 65536 * 2; return true; }
};
}
#ifndef PROBE_TS
#define PROBE_TS 0
#endif
#ifndef PROBE_T0
#define PROBE_T0 0
#endif
#ifndef PROBE_T1
#define PROBE_T1 10
#endif
#if PROBE_TS
#define TSTAMP_C(C, k) do { if (blockIdx.x == PROBE_TS - 1 && (C).tid == 0) __hip_atomic_store((unsigned long long*)((C).ws + WS_CTL) + CW_DBG / 2 + (k), (unsigned long long)wall_clock64(), __ATOMIC_RELAXED, __HIP_MEMORY_SCOPE_AGENT); } while (0)
#else
#define TSTAMP_C(C, k) do { } while (0)
#endif
#ifndef PROBE_TK
#define PROBE_TK 1
#endif
#ifndef PROBE_TADD
#define PROBE_TADD 0
#endif
constexpr int NWAVES = 8;
constexpr int RING_BYTES = 131072, XB_OFF = RING_BYTES, MISC_OFF = RING_BYTES + 16384, TAB_OFF = MISC_OFF + 256;
constexpr int LDS_BYTES = RING_BYTES + 2048 + 16384;
#ifndef SIDE_P1
#define SIDE_P1 0
#endif
#ifndef SIDE_P56
#define SIDE_P56 0
#endif
using pg8::SIDE_ITEMS;
constexpr int SIDE_N1 = SIDE_P1 ? 192 * 256 : 0, SIDE_N5 = SIDE_P56 ? 32 * 256 : 0, SIDE_N6 = SIDE_P56 ? 64 * 256 : 0;
#ifndef SIDE_PROBE
#define SIDE_PROBE 0
#endif
#ifndef CONV_PAIRS
#define CONV_PAIRS 49152
#endif
#ifndef NCONV
#define NCONV 64
#endif
#ifndef CV_QFRAC
#define CV_QFRAC 25
#endif
#define CV_GRAB 16
#define CV_STATIC (((2 * CONV_PAIRS) * (100 - CV_QFRAC) / 100) / 512 * 512)
#ifndef TAIL_IN_P8
#define TAIL_IN_P8 0
#endif
constexpr int SIDE_TOTAL = NCONV ? (TAIL_IN_P8 ? SIDE_ITEMS : 2 * CONV_PAIRS) : (SIDE_PROBE ? 0 : SIDE_N1 + 2 * SIDE_N5 + SIDE_N6);
static_assert(!TAIL_IN_P8 || 2 * CONV_PAIRS >= 2 * 64 * 32 * 16, "gate/up weights must be complete before P8");
struct Args { const float* in[28]; float* out; unsigned char* ws; int ph_lo, ph_hi, use_cg, pad; };

struct Ctx {
    LAS unsigned char* lds; unsigned char* ws; int tid, lane, wave, vcu, G, gw, NGW;
};

#define MFMA16(a, b, c) __builtin_amdgcn_mfma_f32_16x16x32_bf16((a), (b), (c), 0, 0, 0)
#define MFMA32(a, b, c) __builtin_amdgcn_mfma_f32_32x32x16_bf16((a), (b), (c), 0, 0, 0)

struct TrItem { const float* W; bf16_t* WT; const float* rs; int ldw, ldt; };
#ifndef RT_AUX
#define RT_AUX 0
#endif
#ifndef FIN_ST_NT
#define FIN_ST_NT 0
#endif
#ifndef FIN_NT
#define FIN_NT 0
#endif
#ifndef P0_NT
#define P0_NT 1
#endif
#ifndef CV_NT
#define CV_NT 1
#endif
template <bool NT = false> DI void tr_load(const TrItem& t, f32x4 (&v)[8], int lane) {
#pragma unroll
    for (int i = 0; i < 8; ++i) { const f32x4* p = (const f32x4*)(t.W + (size_t)(8 * i + (lane >> 3)) * t.ldw + 4 * (lane & 7)); v[i] = NT ? __builtin_nontemporal_load(p) : *p; }
}
template <bool NT = false> DI void tr_finish(const TrItem& t, const f32x4 (&v)[8], LAS float* scr, int lane) {
#pragma unroll
    for (int i = 0; i < 8; ++i) { LAS float* s = scr + (8 * i + (lane >> 3)) * 33 + 4 * (lane & 7); s[0] = v[i].x; s[1] = v[i].y; s[2] = v[i].z; s[3] = v[i].w; }
    LDS_WAIT(); asm volatile("" ::: "memory");
    const int c = lane & 7;
    f32x4 g0 = {1.f, 1.f, 1.f, 1.f}, g1 = g0; if (t.rs) { g0 = *(const f32x4*)(t.rs + 8 * c); g1 = *(const f32x4*)(t.rs + 8 * c + 4); }
#pragma unroll
    for (int j = 0; j < 4; ++j) { const int n = (lane >> 3) + 8 * j; const LAS float* s = scr + (8 * c) * 33 + n;
        u32x4 o; o.x = pk2(s[0 * 33] * g0.x, s[1 * 33] * g0.y); o.y = pk2(s[2 * 33] * g0.z, s[3 * 33] * g0.w); o.z = pk2(s[4 * 33] * g1.x, s[5 * 33] * g1.y); o.w = pk2(s[6 * 33] * g1.z, s[7 * 33] * g1.w);
        if (NT) __builtin_nontemporal_store(o, (u32x4*)(t.WT + (size_t)n * t.ldt + 8 * c)); else *(u32x4*)(t.WT + (size_t)n * t.ldt + 8 * c) = o; }
    LDS_WAIT(); asm volatile("" ::: "memory");
}
DI void norm_regs_bf16(const f32x4 (&v)[8], const float* g, bf16_t* orow, int lane, float* rstd_out) {
    const f32x4* gr = (const f32x4*)g + lane; float s = 0.f;
#pragma unroll
    for (int j = 0; j < 8; ++j) s += (v[j].x * v[j].x + v[j].y * v[j].y) + (v[j].z * v[j].z + v[j].w * v[j].w);
    const float rstd = rsqrtf(wave_sum(s) * (1.f / DM) + RMS_EPS);
    if (rstd_out && lane == 0) *rstd_out = rstd;
    u32x2* o8 = (u32x2*)orow + lane;
#pragma unroll
    for (int j = 0; j < 8; ++j) { const f32x4 gg = gr[64 * j]; u32x2 w; w.x = pk2(v[j].x * rstd * gg.x, v[j].y * rstd * gg.y); w.y = pk2(v[j].z * rstd * gg.z, v[j].w * rstd * gg.w); o8[64 * j] = w; }
}
DI void norm_row_bf16(const float* xrow, const float* g, bf16_t* orow, int lane, float* rstd_out = nullptr) {
    const f32x4* xr = (const f32x4*)xrow + lane; const f32x4* gr = (const f32x4*)g + lane;
    f32x4 v[8]; float s = 0.f;
#pragma unroll
    for (int j = 0; j < 8; ++j) { v[j] = xr[64 * j]; s += (v[j].x * v[j].x + v[j].y * v[j].y) + (v[j].z * v[j].z + v[j].w * v[j].w); }
    const float rstd = rsqrtf(wave_sum(s) * (1.f / DM) + RMS_EPS);
    if (rstd_out && lane == 0) *rstd_out = rstd;
    u32x2* o8 = (u32x2*)orow + lane;
#pragma unroll
    for (int j = 0; j < 8; ++j) { const f32x4 gg = gr[64 * j]; u32x2 w; w.x = pk2(v[j].x * rstd * gg.x, v[j].y * rstd * gg.y); w.y = pk2(v[j].z * rstd * gg.z, v[j].w * rstd * gg.w); o8[64 * j] = w; }
}
DI void p0_prologue(const Ctx& C, const Args& a, int part = 3) {
    unsigned char* ws = C.ws;
    LAS float* scr = (LAS float*)(C.lds + C.wave * 8448);
    LAS float* scrB = (LAS float*)(C.lds + (C.wave < 7 ? 67584 + C.wave * 8448 : XB_OFF));
    constexpr int I_IN = 32 * 192, I_PW = 4 * 32, I_GLU = 16 * 32, I_BR = 16 * 64, I_OUT = 32 * 64, I_GU = 64 * 32 * 16, I_DN = 64 * 8 * 64;
    constexpr int NSMALL = I_IN + I_PW + I_GLU + 2 * I_BR + I_OUT;
    constexpr int NITEMS = NSMALL + (2 * I_GU + I_DN - SIDE_TOTAL);
    auto decode = [&](int it, TrItem& t) {
        int r = it < NSMALL ? it : it + SIDE_TOTAL;
        const float* W; bf16_t* WT; int ldw, ldt, k0, n0, drow0; bool gu = false;
        if (r < I_IN) { const int kb = r / 192, nb = r % 192; W = a.in[3]; ldw = INW; WT = (bf16_t*)(ws + WS_WIN); ldt = DM; k0 = 64 * kb; n0 = 32 * nb; drow0 = n0; }
        else if ((r -= I_IN) < I_PW) { const int g = r / 32, q = r % 32, kb = q / 8, nb = q % 8; W = a.in[4] + (size_t)g * 65536; ldw = 256; WT = (bf16_t*)(ws + WS_POOLW) + (size_t)g * 65536; ldt = 256; k0 = 64 * kb; n0 = 32 * nb; drow0 = n0; }
        else if ((r -= I_PW) < I_GLU) { const int kb = r / 32, nb = r % 32; W = a.in[14]; ldw = SW; WT = (bf16_t*)(ws + WS_WGLU); ldt = SW; k0 = 64 * kb; n0 = 32 * nb; drow0 = n0; }
        else if ((r -= I_GLU) < I_BR) { const int kb = r / 64, nb = r % 64; W = a.in[16]; ldw = DM; WT = (bf16_t*)(ws + WS_WBP); ldt = PW; k0 = 64 * kb; n0 = 32 * nb; drow0 = n0; }
        else if ((r -= I_BR) < I_BR) { const int kb = r / 64, nb = r % 64; W = a.in[17]; ldw = DM; WT = (bf16_t*)(ws + WS_WBS); ldt = SW; k0 = 64 * kb; n0 = 32 * nb; drow0 = n0; }
        else if ((r -= I_BR) < I_OUT) { const int kb = r / 64, nb = r % 64; W = a.in[18]; ldw = DM; WT = (bf16_t*)(ws + WS_WOUT); ldt = DM; k0 = 64 * kb; n0 = 32 * nb; drow0 = n0; }
        else if ((r -= I_OUT) < 2 * I_GU) { const int up = r / I_GU, q = r % I_GU, e = q / 512, q2 = q % 512, kb = q2 / 16, nb = q2 % 16; n0 = 32 * nb; k0 = 64 * kb;
            W = a.in[24 + up] + (size_t)e * DM * FF; ldw = FF; WT = (bf16_t*)(ws + WS_WGU) + (size_t)e * 1024 * DM; ldt = DM; drow0 = (n0 >> 7) * 256 + (n0 & 127) + up * 128; gu = true; }
        else { r -= 2 * I_GU; const int e = r / 512, q2 = r % 512, kb = q2 / 64, nb = q2 % 64; W = a.in[26] + (size_t)e * FF * DM; ldw = DM; WT = (bf16_t*)(ws + WS_WD) + (size_t)e * DM * FF; ldt = FF; k0 = 64 * kb; n0 = 32 * nb; drow0 = n0; }
        t.W = W + (size_t)k0 * ldw + n0; t.WT = WT + (size_t)drow0 * ldt + k0; t.ldw = ldw; t.ldt = ldt; t.rs = gu ? a.in[19] + k0 : nullptr;
    };
    const int it_lo = (part & 1) ? 0 : I_IN, it_hi = (part & 2) ? NITEMS : I_IN;
    for (int it = it_lo + C.gw; it < it_hi; it += 2 * C.NGW) {
        TrItem t0, t1; f32x4 v0[8], v1[8];
        const bool two = it + C.NGW < it_hi;
        decode(it, t0); tr_load<(P0_NT != 0)>(t0, v0, C.lane);
        decode(two ? it + C.NGW : it, t1); if (!two) { t1.WT = (bf16_t*)(ws + WS_SCR); t1.ldt = 64; } tr_load<(P0_NT != 0)>(t1, v1, C.lane);
        tr_finish(t0, v0, scr, C.lane);
        tr_finish(t1, v1, scrB, C.lane);
    }
    if (part & 1) {
        for (int m = 2 * C.gw; m < NTOK; m += 2 * C.NGW) {
            const f32x4* x0 = (const f32x4*)(a.in[0] + (size_t)m * DM) + C.lane; const f32x4* x1 = x0 + DM / 4;
            f32x4 v0[8], v1[8];
#pragma unroll
            for (int j = 0; j < 8; ++j) { v0[j] = P0_NT ? __builtin_nontemporal_load(x0 + 64 * j) : x0[64 * j]; v1[j] = P0_NT ? __builtin_nontemporal_load(x1 + 64 * j) : x1[64 * j]; }
            norm_regs_bf16(v0, a.in[2], (bf16_t*)(ws + WS_A1) + (size_t)m * DM, C.lane, (float*)(ws + WS_RSTD1) + m);
            norm_regs_bf16(v1, a.in[2], (bf16_t*)(ws + WS_A1) + (size_t)(m + 1) * DM, C.lane, (float*)(ws + WS_RSTD1) + m + 1);
        }
        for (int m = C.gw; m < NMETA; m += C.NGW) norm_row_bf16(a.in[1] + (size_t)m * DM, a.in[2], (bf16_t*)(ws + WS_A1M) + (size_t)m * DM, C.lane);
        for (int i = C.gw * 64 + C.lane; i < DM; i += C.NGW * 64) ((float*)(ws + WS_IG))[i] = 1.f / a.in[2][i];
    }
    if (!(part & 2)) return;
    for (int it = C.gw; it < 80 * DM / 64; it += C.NGW) { const int idx = it * 64 + C.lane, j = idx / DM, k = idx % DM;
        float w = 0.f; if (j < 8) w = a.in[20][k * 8 + j]; else if (j < 72) w = a.in[22][k * 64 + (j - 8)];
        w *= a.in[19][k];
        const unsigned hi = pk2(w, 0.f) & 0xffffu; const float lo = w - __uint_as_float(hi << 16);
        ((bf16_t*)(ws + WS_WRH))[idx] = (bf16_t)hi; ((bf16_t*)(ws + WS_WRL))[idx] = (bf16_t)(pk2(lo, 0.f) & 0xffffu); }
    for (int g = C.gw; g < 64; g += C.NGW) { const int n = C.lane;
        const float ar = a.in[6][g * 64 + n], ai = a.in[7][g * 64 + n], dt = expf(a.in[8][g]);
        const float mag = expf(ar * dt); float sn, cs; sincosf(ai * dt, &sn, &cs);
        const float lr = mag * cs, li = mag * sn, den = ar * ar + ai * ai, nr = lr - 1.f;
        const float cr = (nr * ar + li * ai) / den, ci = (li * ar - nr * ai) / den;
        ((f32x2*)(ws + WS_LAM))[g * 64 + n] = (f32x2){lr, li};
        float pr = lr, pi = li;
#pragma unroll
        for (int s = 0; s < 7; ++s) { const float t = pr * pr - pi * pi; pi = 2.f * pr * pi; pr = t; }
        ((f32x2*)(ws + WS_LAMP))[g * 64 + n] = (f32x2){pr, pi};
        bf16_t* bc = (bf16_t*)(ws + WS_BCAT) + (size_t)g * 128 * 16; bf16_t* cc = (bf16_t*)(ws + WS_CCATT) + (size_t)g * 16 * 128;
        unsigned rp[8], ip[8];
#pragma unroll
        for (int h = 0; h < 16; h += 2) { const float b0r = a.in[9][(g * 64 + n) * 16 + h], b0i = a.in[10][(g * 64 + n) * 16 + h], b1r = a.in[9][(g * 64 + n) * 16 + h + 1], b1i = a.in[10][(g * 64 + n) * 16 + h + 1];
            rp[h / 2] = pk2(cr * b0r - ci * b0i, cr * b1r - ci * b1i); ip[h / 2] = pk2(cr * b0i + ci * b0r, cr * b1i + ci * b1r); }
        *(u32x4*)(bc + (size_t)n * 16) = (u32x4){rp[0], rp[1], rp[2], rp[3]}; *(u32x4*)(bc + (size_t)n * 16 + 8) = (u32x4){rp[4], rp[5], rp[6], rp[7]};
        *(u32x4*)(bc + (size_t)(64 + n) * 16) = (u32x4){ip[0], ip[1], ip[2], ip[3]}; *(u32x4*)(bc + (size_t)(64 + n) * 16 + 8) = (u32x4){ip[4], ip[5], ip[6], ip[7]};
#pragma unroll
        for (int h = 0; h < 16; ++h) { cc[h * 128 + n] = (bf16_t)(pk2(a.in[11][(g * 16 + h) * 64 + n], 0.f) & 0xffffu); cc[h * 128 + 64 + n] = (bf16_t)(pk2(-a.in[12][(g * 16 + h) * 64 + n], 0.f) & 0xffffu); }
    }
    for (int it = C.gw; it < NE * LISTCAP / 64; it += C.NGW) ((u32x4*)(ws + WS_LIST))[(size_t)it * 64 + C.lane] = (u32x4){0u, 0u, 0u, 0u};
}

struct CvItem { const float* W; bf16_t* WT; int ldw, ldt, gk; };
DI void cv_decode(const Args& a, unsigned char* ws, int idx, CvItem& t) {
    constexpr int I_GU = 64 * 32 * 16;
    if (idx < 2 * I_GU) { const int up = idx / I_GU, q = idx % I_GU, e = q >> 9, q2 = q & 511, kb = q2 >> 4, nb = q2 & 15, n0 = 32 * nb, k0 = 64 * kb;
        t.W = a.in[24 + up] + (size_t)e * DM * FF + (size_t)k0 * FF + n0; t.ldw = FF; t.ldt = DM; t.gk = k0;
        t.WT = (bf16_t*)(ws + WS_WGU) + (size_t)e * 1024 * DM + (size_t)((n0 >> 7) * 256 + (n0 & 127) + up * 128) * DM + k0; }
    else { const int r = idx - 2 * I_GU, e = r >> 9, q2 = r & 511, kb = q2 >> 6, nb = q2 & 63, n0 = 32 * nb, k0 = 64 * kb;
        t.W = a.in[26] + (size_t)e * FF * DM + (size_t)k0 * DM + n0; t.ldw = DM; t.ldt = FF; t.gk = -1;
        t.WT = (bf16_t*)(ws + WS_WD) + (size_t)e * DM * FF + (size_t)n0 * FF + k0; }
}
DI void cv_issue(const Ctx& C, const Args& a, int idx, LAS unsigned char* slot) {
    CvItem t; cv_decode(a, C.ws, idx, t);
    const int l = C.lane, w = C.wave;
    const float* src = t.W + (size_t)(8 * w + (l >> 3)) * t.ldw + 4 * ((l & 7) ^ w);
    __builtin_amdgcn_global_load_lds((const unsigned*)src, (LAS unsigned*)(slot + 1024 * w), 16, 0, 0);
}
DI void cv_consume(const Ctx& C, const Args& a, int idx, const LAS unsigned char* slot, const LAS float* gl) {
    CvItem t; cv_decode(a, C.ws, idx, t);
    const int l = C.lane, c = l & 7, n = 8 * (C.wave & 3) + (l >> 3);
    const LAS float* xf = (const LAS float*)slot + (8 * c) * 32 + (((n >> 2) ^ c) << 2) + (n & 3);
    float v[8];
#pragma unroll
    for (int i = 0; i < 8; ++i) v[i] = xf[i * 32];
    if (t.gk >= 0) { const f32x4 g0 = *(const LAS f32x4*)(gl + t.gk + 8 * c), g1 = *(const LAS f32x4*)(gl + t.gk + 8 * c + 4);
        v[0] *= g0.x; v[1] *= g0.y; v[2] *= g0.z; v[3] *= g0.w; v[4] *= g1.x; v[5] *= g1.y; v[6] *= g1.z; v[7] *= g1.w; }
    u32x4 o; o.x = pk2(v[0], v[1]); o.y = pk2(v[2], v[3]); o.z = pk2(v[4], v[5]); o.w = pk2(v[6], v[7]);
    *(u32x4*)(t.WT + (size_t)n * t.ldt + 8 * c) = o;
}
DI void expert_item(const Args& a, unsigned char* ws, int idx, TrItem& t) {
    constexpr int I_GU = 64 * 32 * 16;
    if (idx < 2 * I_GU) { const int up = idx / I_GU, q = idx % I_GU, e = q >> 9, q2 = q & 511, kb = q2 >> 4, nb = q2 & 15, n0 = 32 * nb, k0 = 64 * kb;
        t.W = a.in[24 + up] + (size_t)e * DM * FF + (size_t)k0 * FF + n0; t.ldw = FF; t.ldt = DM; t.rs = a.in[19] + k0;
        t.WT = (bf16_t*)(ws + WS_WGU) + (size_t)e * 1024 * DM + (size_t)((n0 >> 7) * 256 + (n0 & 127) + up * 128) * DM + k0; }
    else { const int r = idx - 2 * I_GU, e = r >> 9, q2 = r & 511, kb = q2 >> 6, nb = q2 & 63, n0 = 32 * nb, k0 = 64 * kb;
        t.W = a.in[26] + (size_t)e * FF * DM + (size_t)k0 * DM + n0; t.ldw = DM; t.ldt = FF; t.rs = nullptr;
        t.WT = (bf16_t*)(ws + WS_WD) + (size_t)e * DM * FF + (size_t)n0 * FF + k0; }
}
DI void cv_item(const Args& a, unsigned char* ws, int idx, int nitems, TrItem& t) {
    expert_item(a, ws, idx < nitems ? idx : 0, t);
    if (idx >= nitems) { t.WT = (bf16_t*)(ws + WS_SCR); t.ldt = 64; }
}
DI void convert_range(const Ctx& C, const Args& a, int start, int stride, int end) {
    const int cw = start, ncw = stride, nitems = end;
    LAS float* scr = (LAS float*)(C.lds + C.wave * 8448);
#define CV_LD(k, idx) do { cv_item(a, C.ws, (idx), nitems, t##k); tr_load<(CV_NT >= 1)>(t##k, v##k, C.lane); } while (0)
#define CV_FIN(k) tr_finish<(CV_NT >= 2)>(t##k, v##k, scr, C.lane)
    TrItem t0, t1, t2, t3; f32x4 v0[8], v1[8], v2[8], v3[8];
    CV_LD(0, cw); CV_LD(1, cw + ncw); CV_LD(2, cw + 2 * ncw);
    for (int it = cw; it < nitems; it += 4 * ncw) {
        CV_LD(3, it + 3 * ncw); CV_FIN(0); CV_LD(0, it + 4 * ncw); CV_FIN(1); CV_LD(1, it + 5 * ncw); CV_FIN(2); CV_LD(2, it + 6 * ncw); CV_FIN(3);
    }
#undef CV_LD
#undef CV_FIN
}
DI void convert_queue(const Ctx& C, const Args& a) {
    unsigned* Q = (unsigned*)(C.ws + WS_CTL) + CW_Q;
    for (;;) {
        unsigned k = 0; if (C.lane == 0) k = atomicAdd(Q, (unsigned)CV_GRAB);
        const int idx = CV_STATIC + (int)__builtin_amdgcn_readfirstlane(k);
        if (idx >= 2 * CONV_PAIRS) break;
        const int end = idx + CV_GRAB < 2 * CONV_PAIRS ? idx + CV_GRAB : 2 * CONV_PAIRS;
        convert_range(C, a, idx, 1, end);
    }
}
DI void convert_stream(const Ctx& C, const Args& a, int ci, int nconv, int npairs) {
    (void)npairs;
    convert_range(C, a, ci * NWAVES + C.wave, nconv * NWAVES, CV_STATIC); TSTAMP_C(C, 28);
    convert_queue(C, a); TSTAMP_C(C, 29);
    VM_WAIT(); __syncthreads();
}

DI void convert_tail(const Ctx& C, const Args& a) {
#if TAIL_IN_P8
    unsigned* Q = (unsigned*)(C.ws + WS_CTL) + CW_Q;
    LAS float* scr = (LAS float*)(C.lds + C.wave * 8448); LAS float* scrB = (LAS float*)(C.lds + (C.wave < 7 ? 67584 + C.wave * 8448 : XB_OFF));
    for (;;) {
        unsigned k = 0; if (C.lane == 0) k = atomicAdd(Q, 2u);
        const int idx = 2 * CONV_PAIRS + (int)__builtin_amdgcn_readfirstlane(k);
        if (idx >= SIDE_ITEMS) break;
        TrItem t0, t1; f32x4 v0[8], v1[8];
        cv_item(a, C.ws, idx, SIDE_ITEMS, t0); tr_load(t0, v0, C.lane);
        cv_item(a, C.ws, idx + 1, SIDE_ITEMS, t1); tr_load(t1, v1, C.lane);
        tr_finish(t0, v0, scr, C.lane); tr_finish(t1, v1, scrB, C.lane);
    }
    VM_WAIT();
#endif
}

DI void meta_gemm(const Ctx& C) {
    if (C.vcu >= 128) return;
    const int n0 = 16 * C.vcu, l = C.lane, r = l & 15, q = l >> 4;
    const bf16_t* ap = (const bf16_t*)(C.ws + WS_A1M) + (size_t)r * DM + C.wave * 256 + 8 * q;
    const bf16_t* wp = (const bf16_t*)(C.ws + WS_WIN) + (size_t)(n0 + r) * DM + C.wave * 256 + 8 * q;
    f32x4 acc = {0.f, 0.f, 0.f, 0.f};
#pragma unroll
    for (int ks = 0; ks < 8; ++ks) { const bf16x8 af = *(const bf16x8*)(ap + 32 * ks), wf = *(const bf16x8*)(wp + 32 * ks); acc = MFMA16(wf, af, acc); }
    LAS f32x4* red = (LAS f32x4*)(C.lds);
    red[C.wave * 64 + l] = acc;
    __syncthreads();
    if (C.wave == 0) {
#pragma unroll
        for (int w = 1; w < 8; ++w) acc += red[w * 64 + l];
        const int col = n0 + 4 * q; bf16_t* dst = (col < PW) ? (bf16_t*)(C.ws + WS_ZP) + (size_t)(NTOK + r) * PW + col : (bf16_t*)(C.ws + WS_ZS) + (size_t)(NTOK + r) * SW + (col - PW);
        u32x2 w; w.x = pk2(acc[0], acc[1]); w.y = pk2(acc[2], acc[3]); *(u32x2*)dst = w;
    }
}

DI int zrow(int b, int s) { return s >= 0 ? b * SEQ + s : NTOK + NMETA + s; }
DI void pool_diff(const Ctx& C) {
    const bf16_t* ZP = (const bf16_t*)(C.ws + WS_ZP); bf16_t* DD = (bf16_t*)(C.ws + WS_DD);
    for (int it = C.gw; it < 2048; it += C.NGW) {
        const int tb = it >> 1, hf = it & 1, b = tb >> 9, s0 = (tb & 511) * 16, c0 = hf * 512 + C.lane * 8, w = 2 << (c0 >> 8);
        const float inv = 1.f / (float)w;
        f32x4 a0 = {0.f, 0.f, 0.f, 0.f}, a1 = a0;
        for (int j = 1; j < w; ++j) { f32x4 v0, v1; pg8::unpack8(*(const u32x4*)(ZP + (size_t)zrow(b, s0 - j) * PW + c0), v0, v1); a0 += v0; a1 += v1; }
        for (int i = 0; i < 16; ++i) { const int s = s0 + i; f32x4 c0v, c1v, l0, l1;
            pg8::unpack8(*(const u32x4*)(ZP + (size_t)zrow(b, s) * PW + c0), c0v, c1v); a0 += c0v; a1 += c1v;
            *(u32x4*)(DD + (size_t)(b * SEQ + s) * PW + c0) = pg8::pack8(a0 * inv - c0v, a1 * inv - c1v);
            pg8::unpack8(*(const u32x4*)(ZP + (size_t)zrow(b, s - w + 1) * PW + c0), l0, l1); a0 -= l0; a1 -= l1; }
    }
}

template <bool PASS2> DI void ssm_pass(const Ctx& C, const Args& a) {
    const bf16_t* ZS = (const bf16_t*)(C.ws + WS_ZS); bf16_t* S0 = (bf16_t*)(C.ws + WS_S0);
    f32x4* Eb = (f32x4*)(C.ws + WS_E);
    const int l = C.lane, rr = l & 31, bb = (rr >> 2) & 1, jj = (rr & 3) + 4 * (rr >> 3), kofs = 8 * (l >> 5);
    LAS unsigned char* xs = C.lds + C.wave * 8704;
    for (int it = C.gw; it < 64 * NCH; it += C.NGW) {
        const int g = it & 63, c0 = (it >> 6) & 31, c = (it >> 11) ? 63 - c0 : c0;
        const f32x2 lamA = ((const f32x2*)(C.ws + WS_LAM))[g * 64 + (l & 31)], lamB = ((const f32x2*)(C.ws + WS_LAM))[g * 64 + 32 + (l & 31)];
        bf16x8 bfr[4];
#pragma unroll
        for (int ct = 0; ct < 4; ++ct) bfr[ct] = *(const bf16x8*)((const bf16_t*)(C.ws + WS_BCAT) + ((size_t)g * 128 + 32 * ct + (l & 31)) * 16 + kofs);
        float xAr = 0.f, xAi = 0.f, xBr = 0.f, xBi = 0.f;
        bf16x8 cfr[4]; f32x4 dsk = {0.f, 0.f, 0.f, 0.f};
        if constexpr (PASS2) {
#pragma unroll
            for (int ks = 0; ks < 4; ++ks) cfr[ks] = *(const bf16x8*)((const bf16_t*)(C.ws + WS_CCATT) + ((size_t)g * 16 + (l & 15)) * 128 + 32 * ks + 8 * (l >> 4));
            dsk = *(const f32x4*)(a.in[13] + g * 16 + 4 * (l >> 4));
            if (c > 0) {
                const f32x2 LA = ((const f32x2*)(C.ws + WS_LAMP))[g * 64 + (l & 31)], LB = ((const f32x2*)(C.ws + WS_LAMP))[g * 64 + 32 + (l & 31)];
                const f32x4* ep = Eb + ((size_t)g * NCH) * 64 + l;
                f32x4 t = ep[0];
                for (int j0 = 1; j0 < c; j0 += 8) {
                    f32x4 eb[8];
#pragma unroll
                    for (int i = 0; i < 8; ++i) { const int j = (j0 + i < c) ? j0 + i : c - 1; eb[i] = ep[(size_t)j * 64]; }
#pragma unroll
                    for (int i = 0; i < 8; ++i) if (j0 + i < c) { const f32x4 e = eb[i];
                        const float ar = LA.x * t.x - LA.y * t.y + e.x, ai = LA.x * t.y + LA.y * t.x + e.y, br = LB.x * t.z - LB.y * t.w + e.z, bi = LB.x * t.w + LB.y * t.z + e.w;
                        t = (f32x4){ar, ai, br, bi}; }
                }
                xAr = t.x; xAi = t.y; xBr = t.z; xBi = t.w;
            }
        }
        const int nsteps = (c == 0) ? 9 : 8;
        auto urow = [&](int st) { const bool m = (c == 0 && st == 0); const int sb = c * CHL + 16 * (st - (c == 0 ? 1 : 0)); return m ? NTOK + jj : bb * SEQ + sb + jj; };
        bf16x8 af0 = *(const bf16x8*)(ZS + (size_t)urow(0) * SW + g * 16 + kofs), af1 = *(const bf16x8*)(ZS + (size_t)urow(1) * SW + g * 16 + kofs);
        for (int st = 0; st < nsteps; ++st) {
            const bool meta = (c == 0 && st == 0);
            const int sbase = c * CHL + 16 * (st - (c == 0 ? 1 : 0));
            const bf16x8 af = af0; af0 = af1;
            { const int stn = st + 2 < nsteps ? st + 2 : nsteps - 1; af1 = *(const bf16x8*)(ZS + (size_t)urow(stn) * SW + g * 16 + kofs); }
            u32x2 uw2[2];
            if constexpr (PASS2) { const int sbc = sbase < 0 ? 0 : sbase;
#pragma unroll
                for (int hb = 0; hb < 2; ++hb) uw2[hb] = *(const u32x2*)(ZS + ((size_t)hb * SEQ + sbc + (l & 15)) * SW + g * 16 + 4 * (l >> 4)); }
            f32x16 z16;
#pragma unroll
            for (int i = 0; i < 16; ++i) z16[i] = 0.f;
            f32x16 q0 = MFMA32(af, bfr[0], z16), q1 = MFMA32(af, bfr[1], z16), q2 = MFMA32(af, bfr[2], z16), q3 = MFMA32(af, bfr[3], z16);
#pragma unroll
            for (int r = 0; r < 16; ++r) {
                const float nar = lamA.x * xAr - lamA.y * xAi + q0[r], nai = lamA.x * xAi + lamA.y * xAr + q2[r];
                const float nbr = lamB.x * xBr - lamB.y * xBi + q1[r], nbi = lamB.x * xBi + lamB.y * xBr + q3[r];
                xAr = nar; xAi = nai; xBr = nbr; xBi = nbi;
                if constexpr (PASS2) { q0[r] = nar; q1[r] = nbr; q2[r] = nai; q3[r] = nbi; }
            }
            if constexpr (PASS2) {
                if (!meta) {
#pragma unroll
                    for (int r = 0; r < 16; ++r) { LAS unsigned short* xr = (LAS unsigned short*)(xs + (16 * (l >> 5) + r) * 272) + (l & 31);
                        const unsigned wre = pk2(q0[r], q1[r]), wim = pk2(q2[r], q3[r]);
                        xr[0] = (unsigned short)(wre & 0xffffu); xr[32] = (unsigned short)(wre >> 16); xr[64] = (unsigned short)(wim & 0xffffu); xr[96] = (unsigned short)(wim >> 16); }
                    asm volatile("" ::: "memory");
#pragma unroll
                    for (int hb = 0; hb < 2; ++hb) {
                        f32x4 y = {0.f, 0.f, 0.f, 0.f};
#pragma unroll
                        for (int ks = 0; ks < 4; ++ks) { const bf16x8 xf = *(const LAS bf16x8*)(xs + (16 * hb + (l & 15)) * 272 + (32 * ks + 8 * (l >> 4)) * 2); y = MFMA16(cfr[ks], xf, y); }
                        const size_t orow = (size_t)hb * SEQ + sbase + (l & 15);
                        const u32x2 uw = uw2[hb];
                        const float s0 = y[0] + dsk[0] * bflo(uw.x), s1 = y[1] + dsk[1] * bfhi(uw.x), s2 = y[2] + dsk[2] * bflo(uw.y), s3 = y[3] + dsk[3] * bfhi(uw.y);
                        u32x2 ow; ow.x = pk2(gelu_t(s0), gelu_t(s1)); ow.y = pk2(gelu_t(s2), gelu_t(s3));
                        *(u32x2*)(S0 + orow * SW + g * 16 + 4 * (l >> 4)) = ow;
                    }
                    asm volatile("" ::: "memory");
                }
            }
        }
        if constexpr (!PASS2) Eb[((size_t)g * NCH + c) * 64 + l] = (f32x4){xAr, xAi, xBr, xBi};
    }
}

#ifndef H1_IN_EPI
#define H1_IN_EPI 1
#endif
constexpr int RT_XD = 8192, RT_NXD = 8, RT_NW = 4, RT_WOFF = RT_NXD * RT_XD, RT_W = 20480, RT_WH = 0, RT_WL = 10240;
static_assert(RT_WOFF + RT_NW * RT_W <= MISC_OFF, "router rings");
DI void rt_issue_xd(const Ctx& C, const bf16_t* U, int t0, int c, LAS unsigned char* stg) {
    const int l = C.lane, w = C.wave;
#pragma unroll
    for (int i = 0; i < 2; ++i) { const int j = 2 * w + i, row = 8 * j + (l >> 3), u = (l & 7) ^ (row & 7);
        __builtin_amdgcn_global_load_lds((const unsigned*)(U + (size_t)(t0 + row) * DM + 64 * c + 8 * u), (LAS unsigned*)(stg + 1024 * j), 16, 0, 0); }
}
DI void rt_issue_w(const Ctx& C, int c, LAS unsigned char* stg) {
    const int l = C.lane, w = C.wave - 4;
    const bf16_t* WRH = (const bf16_t*)(C.ws + WS_WRH); const bf16_t* WRL = (const bf16_t*)(C.ws + WS_WRL);
#pragma unroll
    for (int i = 0; i < 5; ++i) { const int j = 5 * w + i;
        const int jj = j < 10 ? j : j - 10, n = 8 * jj + (l >> 3), u = (l & 7) ^ (n & 7); const bf16_t* src = (j < 10 ? WRH : WRL) + (size_t)n * DM + 64 * c + 8 * u;
        __builtin_amdgcn_global_load_lds((const unsigned*)src, (LAS unsigned*)(stg + (j < 10 ? RT_WH : RT_WL) + 1024 * jj), 16, 0, 0); }
}
DI void router_phase(const Ctx& C, const Args& a) {
    const bf16_t* V = (const bf16_t*)(C.ws + WS_V);
    unsigned* counts = (unsigned*)(C.ws + WS_CTL) + CW_CNT; uint4* LIST = (uint4*)(C.ws + WS_LIST);
    const int l = C.lane, r = l & 15, q = l >> 4, rt = C.wave & 3, kp = C.wave >> 2;
    LAS float* part = (LAS float*)(C.lds);
    LAS float* lgb = (LAS float*)(C.lds + 32768);
    for (int tb = C.vcu; tb < NTOK / 64; tb += C.G) {
        const int t0 = tb * 64, row = 16 * rt + r;
        f32x4 acc[5];
#pragma unroll
        for (int n = 0; n < 5; ++n) acc[n] = (f32x4){0.f, 0.f, 0.f, 0.f};
        float ss = 0.f;
        if (C.wave < 4) {
#pragma unroll
            for (int s = 0; s < RT_NXD - 1; ++s) rt_issue_xd(C, V, t0, s, C.lds + s * RT_XD);
        } else {
#pragma unroll
            for (int s = 0; s < RT_NW - 1; ++s) rt_issue_w(C, s, C.lds + RT_WOFF + s * RT_W);
        }
        for (int c = 0; c < 32; ++c) {
            if (C.wave < 4) {
                if (c + RT_NXD - 2 < 32) asm volatile("s_waitcnt vmcnt(12)" ::: "memory");
                else asm volatile("s_waitcnt vmcnt(0)" ::: "memory");
            } else {
                if (c + RT_NW - 2 < 32) asm volatile("s_waitcnt vmcnt(10)" ::: "memory");
                else asm volatile("s_waitcnt vmcnt(0)" ::: "memory");
            }
            LDS_WAIT(); __builtin_amdgcn_s_barrier(); asm volatile("" ::: "memory");
            if (C.wave < 4) { if (c + RT_NXD - 1 < 32) rt_issue_xd(C, V, t0, c + RT_NXD - 1, C.lds + ((c + RT_NXD - 1) & (RT_NXD - 1)) * RT_XD); }
            else { if (c + RT_NW - 1 < 32) rt_issue_w(C, c + RT_NW - 1, C.lds + RT_WOFF + ((c + RT_NW - 1) & (RT_NW - 1)) * RT_W); }
            const LAS unsigned char* stg = C.lds + (c & (RT_NXD - 1)) * RT_XD; const LAS unsigned char* wst = C.lds + RT_WOFF + (c & (RT_NW - 1)) * RT_W;
            const u32x4 uw = *(const LAS u32x4*)(stg + row * 128 + (((4 * kp + q) ^ (row & 7)) << 4));
            bf16x8 wh[5], wl[5];
#pragma unroll
            for (int n = 0; n < 5; ++n) { const int nn = 16 * n + r; const int off = nn * 128 + (((4 * kp + q) ^ (nn & 7)) << 4);
                wh[n] = *(const LAS bf16x8*)(wst + RT_WH + off); wl[n] = *(const LAS bf16x8*)(wst + RT_WL + off); }
            f32x4 h0, h1; pg8::unpack8(uw, h0, h1);
            ss += (h0.x * h0.x + h0.y * h0.y) + (h0.z * h0.z + h0.w * h0.w) + (h1.x * h1.x + h1.y * h1.y) + (h1.z * h1.z + h1.w * h1.w);
            const bf16x8 ah = __builtin_bit_cast(bf16x8, uw);
#pragma unroll
            for (int n = 0; n < 5; ++n) { acc[n] = MFMA16(wh[n], ah, acc[n]); acc[n] = MFMA16(wl[n], ah, acc[n]); }
        }
        LDS_WAIT(); __syncthreads();
        ss += __shfl_xor(ss, 16); ss += __shfl_xor(ss, 32);
        if (kp == 1) {
#pragma unroll
            for (int n = 0; n < 5; ++n)
#pragma unroll
                for (int j = 0; j < 4; ++j) part[(rt * 21 + n * 4 + j) * 64 + l] = acc[n][j];
            part[(rt * 21 + 20) * 64 + l] = ss;
        }
        __syncthreads();
        if (kp == 0) {
#pragma unroll
            for (int n = 0; n < 5; ++n)
#pragma unroll
                for (int j = 0; j < 4; ++j) acc[n][j] += part[(rt * 21 + n * 4 + j) * 64 + l];
            ss += part[(rt * 21 + 20) * 64 + l];
            const float rstd = rsqrtf(ss * (1.f / DM) + RMS_EPS);
            LAS float* lg = lgb + rt * 16 * 80;
#pragma unroll
            for (int n = 0; n < 5; ++n)
#pragma unroll
                for (int j = 0; j < 4; ++j) { const int idx = 16 * n + 4 * q + j; if (idx < 72) { const float bias = idx < 8 ? a.in[21][idx] : a.in[23][idx - 8]; lg[r * 80 + idx] = acc[n][j] * rstd + bias; } }
            LDS_WAIT(); asm volatile("" ::: "memory");
            if (l < 16) {
                const LAS float* p = lg + l * 80;
                int gs = 0; float mx = p[0];
#pragma unroll
                for (int k = 1; k < 8; ++k) { const float v = p[k]; if (v > mx) { mx = v; gs = k; } }
                float den = 0.f;
#pragma unroll
                for (int k = 0; k < 8; ++k) den += expf(p[k] - mx);
                const float pgp = 1.f / den;
                const LAS float* el = p + 8 + gs * 8;
                int i0 = 0; float v0 = el[0];
#pragma unroll
                for (int k = 1; k < 8; ++k) { const float v = el[k]; if (v > v0) { v0 = v; i0 = k; } }
                int i1 = -1; float v1 = -3.0e38f;
#pragma unroll
                for (int k = 0; k < 8; ++k) { const float v = el[k]; if (k != i0 && v > v1) { v1 = v; i1 = k; } }
                const float e1 = expf(v1 - v0), w0 = pgp / (1.f + e1), w1 = pgp * e1 / (1.f + e1);
                const int tok = t0 + 16 * rt + l, ex0 = gs * 8 + i0, ex1 = gs * 8 + i1;
                const unsigned r0 = atomicAdd(&counts[ex0 * CNT_STRIDE], 1u), r1 = atomicAdd(&counts[ex1 * CNT_STRIDE], 1u);
                LIST[(size_t)ex0 * LISTCAP + r0] = make_uint4((unsigned)tok, (unsigned)(2 * tok), __float_as_uint(w0), __float_as_uint(rstd));
                LIST[(size_t)ex1 * LISTCAP + r1] = make_uint4((unsigned)tok, (unsigned)(2 * tok + 1), __float_as_uint(w1), __float_as_uint(rstd));
            }
        }
        VM_WAIT(); __syncthreads();
    }
}
DI void moe_tables(const Ctx& C, int ntn) {
    volatile LAS int* tab = (volatile LAS int*)(C.lds + TAB_OFF);
    if (C.tid < 64) {
        const unsigned* counts = (const unsigned*)(C.ws + WS_CTL) + CW_CNT;
        const int cnt = (int)__hip_atomic_load(counts + C.tid * CNT_STRIDE, RLX_AGENT); const int nblk = (cnt + 255) >> 8;
        int incl = nblk;
#pragma unroll
        for (int o = 1; o < 64; o <<= 1) { const int t = __shfl_up(incl, o); if (C.tid >= o) incl += t; }
        tab[C.tid + 1] = incl * ntn; if (C.tid == 0) tab[0] = 0;
        tab[80 + C.tid] = (incl - nblk) * 256; tab[160 + C.tid] = cnt;
    }
    __syncthreads();
}
struct FinRow { u32x2 hw[8]; unsigned p[8], q[8]; };
DI void fin_load(FinRow& R, const unsigned char* ws, int t, int lane) {
    const u32x2* hb = (const u32x2*)((const bf16_t*)(ws + WS_V) + (size_t)t * DM) + lane;
    const unsigned* y0 = (const unsigned*)(ws + WS_YB + (size_t)(2 * t) * DM) + lane; const unsigned* y1 = (const unsigned*)(ws + WS_YB + (size_t)(2 * t + 1) * DM) + lane;
#pragma unroll
    for (int j = 0; j < 8; ++j) { if (FIN_NT) { R.hw[j] = __builtin_nontemporal_load(hb + 64 * j); R.p[j] = __builtin_nontemporal_load(y0 + 64 * j); R.q[j] = __builtin_nontemporal_load(y1 + 64 * j); }
        else { R.hw[j] = hb[64 * j]; R.p[j] = y0[64 * j]; R.q[j] = y1[64 * j]; } }
}
DI void fin_finish(const FinRow& R, const float* gfin, float* orow, int lane) {
    constexpr float IS = 1.f / 16.f;
    f32x4 v[8]; float s = 0.f;
#pragma unroll
    for (int j = 0; j < 8; ++j) { const u32x2 hw = R.hw[j]; const int p = (int)R.p[j], q = (int)R.q[j];
        v[j] = (f32x4){bflo(hw.x) + IS * (__builtin_amdgcn_cvt_f32_fp8(p, 0) + __builtin_amdgcn_cvt_f32_fp8(q, 0)), bfhi(hw.x) + IS * (__builtin_amdgcn_cvt_f32_fp8(p, 1) + __builtin_amdgcn_cvt_f32_fp8(q, 1)),
                       bflo(hw.y) + IS * (__builtin_amdgcn_cvt_f32_fp8(p, 2) + __builtin_amdgcn_cvt_f32_fp8(q, 2)), bfhi(hw.y) + IS * (__builtin_amdgcn_cvt_f32_fp8(p, 3) + __builtin_amdgcn_cvt_f32_fp8(q, 3))};
        s += (v[j].x * v[j].x + v[j].y * v[j].y) + (v[j].z * v[j].z + v[j].w * v[j].w); }
    const float rstd = rsqrtf(wave_sum(s) * (1.f / DM) + RMS_EPS);
    const f32x4* gr = (const f32x4*)gfin + lane; f32x4* o = (f32x4*)orow + lane;
#pragma unroll
    for (int j = 0; j < 8; ++j) { const f32x4 gg = gr[64 * j]; const f32x4 r = {v[j].x * rstd * gg.x, v[j].y * rstd * gg.y, v[j].z * rstd * gg.z, v[j].w * rstd * gg.w};
        if (FIN_ST_NT) __builtin_nontemporal_store(r, o + 64 * j); else o[64 * j] = r; }
}
DI void final_phase(const Ctx& C, const Args& a, float* dst_override = nullptr) {
    float* out = dst_override ? dst_override : a.out;
    static_assert(NTOK % 2 == 0, "rows are taken in pairs");
    for (int t = 2 * C.gw; t < NTOK; t += 2 * C.NGW) {
        FinRow A, B; fin_load(A, C.ws, t, C.lane); fin_load(B, C.ws, t + 1, C.lane);
        fin_finish(A, a.in[27], out + (size_t)t * DM, C.lane); fin_finish(B, a.in[27], out + (size_t)(t + 1) * DM, C.lane);
    }
}
constexpr int N_PHASES = 11;
DI bool is_conv(const Ctx& C) { return NCONV && C.G == 256 && (C.vcu & 31) >= 32 - NCONV / 8; }
DI int gemm_index(const Ctx& C) { return (C.vcu >> 5) * (32 - NCONV / 8) + (C.vcu & 31); }
DI void meta_gemm_g(const Ctx& C) { Ctx M = C; M.vcu = (NCONV && C.G == 256) ? gemm_index(C) : C.vcu; meta_gemm(M); }
DI void phase1_conv(const Ctx& C, const Args& args) { const int ng = 32 - NCONV / 8; convert_stream(C, args, (C.vcu >> 5) * (NCONV / 8) + ((C.vcu & 31) - ng), NCONV, CONV_PAIRS); }
DI void phase1_gemm(const Ctx& C, const Args& args) {
    unsigned char* ws = C.ws;
    pg8::DenseOrder S;
    if (NCONV && C.G == 256) S.setup(ws + WS_A1, ws + WS_WIN, NTOK, INW, DM, DM, 256 - NCONV, (C.vcu & 31) * 8 + (C.vcu >> 5));
    else S.setup(ws + WS_A1, ws + WS_WIN, NTOK, INW, DM, DM, C.G, (int)blockIdx.x);
    pg8::EpiZ E{(bf16_t*)(ws + WS_ZP), (bf16_t*)(ws + WS_ZS), ws + WS_GP, ws + WS_GS};
    pg8::gemm_phase<pg8::EpiZ, pg8::DenseOrder, true, true>(C.lds, pg8::Gemm{DM, DM, DM}, S, E); TSTAMP_C(C, 26);
    meta_gemm_g(C); TSTAMP_C(C, 27);
    if (NCONV && C.G == 256 && CV_QFRAC) { __syncthreads(); convert_queue(C, args); VM_WAIT(); __syncthreads(); }
}
DI void phase1(const Ctx& C, const Args& args) { if (is_conv(C)) phase1_conv(C, args); else phase1_gemm(C, args); }
DI void phase2(const Ctx& C, const Args& args) { pool_diff(C); TSTAMP_C(C, 30); ssm_pass<false>(C, args); }
DI void phase3(const Ctx& C, const Args& args) {
    unsigned char* ws = C.ws;
    pg8::PoolOrder S; S.init(NTOK / 256, 4, C.G, (int)blockIdx.x); S.DD = (const char*)(ws + WS_DD); S.PWT = (const char*)(ws + WS_POOLW);
    pg8::EpiPool E{(bf16_t*)(ws + WS_PP), args.in[5]};
    pg8::gemm_phase<pg8::EpiPool, pg8::PoolOrder, true, true>(C.lds, pg8::Gemm{PW, 256, 256}, S, E); TSTAMP_C(C, 31);
    ssm_pass<true>(C, args);
}
DI void phase4(const Ctx& C, const Args& args) {
    unsigned char* ws = C.ws;
    pg8::DenseOrder S; S.setup(ws + WS_S0, ws + WS_WGLU, NTOK, SW, SW, SW, C.G, (int)blockIdx.x);
    pg8::EpiGlu E{(const bf16_t*)(ws + WS_S0), (bf16_t*)(ws + WS_SS), args.in[15]};
    pg8::gemm_phase<pg8::EpiGlu, pg8::DenseOrder, true, true>(C.lds, pg8::Gemm{SW, SW, SW}, S, E);
}
DI void phase5(const Ctx& C, const Args& args) {
    unsigned char* ws = C.ws;
    pg8::MergeOrder S; S.init(NTOK / 256, DM / 256, C.G, (int)blockIdx.x);
    S.A0 = (const char*)(ws + WS_PP); S.B0 = (const char*)(ws + WS_WBP); S.A1 = (const char*)(ws + WS_SS); S.B1 = (const char*)(ws + WS_WBS); S.tstepA = (size_t)256 * PW * 2; S.tstepB = (size_t)256 * PW * 2;
    pg8::EpiMerge E{ws + WS_GP, ws + WS_GS, (bf16_t*)(ws + WS_MP)};
    pg8::gemm_phase<pg8::EpiMerge, pg8::MergeOrder, true, true>(C.lds, pg8::Gemm{PW, PW, PW}, S, E);
}
DI void phase6(const Ctx& C, const Args& args) {
    unsigned char* ws = C.ws;
    pg8::DenseOrder S; S.setup(ws + WS_MP, ws + WS_WOUT, NTOK, DM, DM, DM, C.G, (int)blockIdx.x);
    pg8::EpiH1 E{(bf16_t*)(ws + WS_V), (const float*)(ws + WS_RSTD1), (const float*)(ws + WS_IG)};
#if SIDE_P56
    pg8::SideConv sd; sd.init(args.in[24], args.in[25], args.in[26], (bf16_t*)(ws + WS_WGU), (bf16_t*)(ws + WS_WD), (bf16_t*)(ws + WS_SCR), C.lds + XB_OFF, SIDE_N1 + 2 * SIDE_N5 + C.vcu, SIDE_TOTAL, C.G);
    pg8::gemm_phase<pg8::EpiH1, pg8::DenseOrder, true, true, pg8::SideConv>(C.lds, pg8::Gemm{DM, DM, DM}, S, E, sd);
#else
    pg8::gemm_phase<pg8::EpiH1, pg8::DenseOrder, true, true>(C.lds, pg8::Gemm{DM, DM, DM}, S, E);
#endif
}
DI void phase8(const Ctx& C, const Args& args) {
    unsigned char* ws = C.ws;
    __syncthreads();
    moe_tables(C, 4);
    pg8::MoeUpOrder S; S.tab = (const volatile LAS int*)(C.lds + TAB_OFF); S.ntn = 4; S.G = C.G; S.vcu = C.vcu; S.list = (const uint4*)(ws + WS_LIST);
    S.Abase = (const char*)(ws + WS_V); S.Bbase = (const char*)(ws + WS_WGU); S.bstep_e = (size_t)1024 * DM * 2; S.bstep_n = (size_t)256 * DM * 2; S.astep_row = 0; S.up = true;
    pg8::EpiMoeUp E{(bf16_t*)(ws + WS_HH)};
    pg8::gemm_phase<pg8::EpiMoeUp, pg8::MoeUpOrder, true, true>(C.lds, pg8::Gemm{DM, DM, DM}, S, E);
    convert_tail(C, args);
}
DI void phase9(const Ctx& C, const Args& args) {
    unsigned char* ws = C.ws;
    __syncthreads();
    moe_tables(C, 8);
    pg8::MoeDownOrder S; S.tab = (const volatile LAS int*)(C.lds + TAB_OFF); S.ntn = 8; S.G = C.G; S.vcu = C.vcu; S.list = (const uint4*)(ws + WS_LIST);
    S.Abase = (const char*)(ws + WS_HH); S.Bbase = (const char*)(ws + WS_WD); S.bstep_e = (size_t)DM * FF * 2; S.bstep_n = (size_t)256 * FF * 2; S.astep_row = (size_t)FF * 2; S.up = false;
    pg8::EpiMoeDown E{(bf16_t*)(ws + WS_YB)};
    pg8::gemm_phase<pg8::EpiMoeDown, pg8::MoeDownOrder, true, true>(C.lds, pg8::Gemm{FF, FF, FF}, S, E);
}
#ifndef PH_MASK
#define PH_MASK 0x7ff
#endif
#ifndef PROBE_DBL
#define PROBE_DBL 0
#endif
#ifndef OVERLAP_P0
#define OVERLAP_P0 1
#endif
__global__ void __launch_bounds__(NWAVES * 64, 2) mk_fwd(Args args) {
    extern __shared__ __attribute__((aligned(16))) unsigned char lds_raw[];
    Ctx C; C.lds = (LAS unsigned char*)lds_raw; C.ws = args.ws; C.tid = threadIdx.x; C.lane = C.tid & 63; C.wave = __builtin_amdgcn_readfirstlane(C.tid >> 6);
    C.G = gridDim.x; { const int bx = blockIdx.x; C.vcu = (C.G % 8 == 0) ? (bx % 8) * (C.G / 8) + bx / 8 : bx; }
    C.gw = C.wave * C.G + C.vcu; C.NGW = NWAVES * C.G;
    unsigned char* ws = args.ws;
    for (int u = C.tid; u < (LDS_BYTES - MISC_OFF) / 4; u += NWAVES * 64) ((LAS unsigned*)(C.lds + MISC_OFF))[u] = 0u;
    __syncthreads();
    const int lo = args.ph_lo, hi = args.ph_hi;
    XcdBarrier bar; bar.bar = (unsigned*)(ws + WS_CTL) + CW_BAR; bar.x = 0; bar.st = nullptr;
    if (hi - lo > 1) bar = xcd_barrier_post((unsigned*)(ws + WS_CTL) + CW_BAR, (volatile LAS unsigned*)(C.lds + MISC_OFF) + 8, gridDim.x);
#if NCONV && OVERLAP_P0
    XcdBarrier bar2; bar2.bar = (unsigned*)(ws + WS_CTL) + CW_BAR2; bar2.x = 0; bar2.st = nullptr; bar2.expected = 0;
    if (hi - lo > 1 && C.G == 256 && !is_conv(C)) bar2 = xcd_barrier_post((unsigned*)(ws + WS_CTL) + CW_BAR2, (volatile LAS unsigned*)(C.lds + MISC_OFF) + 10, 256 - NCONV);
#endif
#define IN(k) (((PH_MASK >> (k)) & 1) && lo <= (k) && (k) < hi)
#if PROBE_TS
#define TSTAMP(k) do { if (blockIdx.x == PROBE_TS - 1 && C.tid == 0) __hip_atomic_store((unsigned long long*)(ws + WS_CTL) + CW_DBG / 2 + (k), (unsigned long long)wall_clock64(), __ATOMIC_RELAXED, __HIP_MEMORY_SCOPE_AGENT); } while (0)
#else
#define TSTAMP(k) do { } while (0)
#endif
    TSTAMP(0);
#ifndef PROBE_BAR
#define PROBE_BAR 0
#endif
#define SEAM(k) do { if (IN(k) && IN((k) + 1)) { if (args.use_cg && (k) == 0) { cg::this_grid().sync(); } else xcd_barrier(bar); for (int pb_ = 0; pb_ < PROBE_BAR; ++pb_) xcd_barrier(bar); } } while (0)
#ifndef STAGGER
#define STAGGER 0
#endif
#ifndef STAGGER_MASK
#define STAGGER_MASK 0x362
#endif
#define RUN(k, call) do { if (IN(k)) { if (STAGGER && ((STAGGER_MASK >> (k)) & 1)) { for (int sg_ = 0; sg_ < (C.vcu & 7); ++sg_) __builtin_amdgcn_s_sleep(STAGGER); } call; if ((PROBE_DBL >> (k)) & 1) { xcd_barrier(bar); call; } } } while (0)
#if NCONV && OVERLAP_P0
    if (IN(0) && IN(1) && C.G == 256) {
        if (is_conv(C)) phase1_conv(C, args);
        else { Ctx P = C; const int gi = gemm_index(C); P.gw = C.wave * (256 - NCONV) + gi; P.NGW = NWAVES * (256 - NCONV);
               p0_prologue(P, args, 3); TSTAMP(16); xcd_barrier(bar2); TSTAMP(1); phase1_gemm(C, args); TSTAMP(17); }
    } else
#endif
    { RUN(0, p0_prologue(C, args)); SEAM(0);
      RUN(1, phase1(C, args)); }
    SEAM(1); TSTAMP(2);
    RUN(2, phase2(C, args)); TSTAMP(18); SEAM(2); TSTAMP(3);
    RUN(3, phase3(C, args)); TSTAMP(19); SEAM(3); TSTAMP(4);
    RUN(4, phase4(C, args)); TSTAMP(20); SEAM(4); TSTAMP(5);
    RUN(5, phase5(C, args)); TSTAMP(21); SEAM(5); TSTAMP(6);
    RUN(6, phase6(C, args)); TSTAMP(22); SEAM(6); TSTAMP(7);
#if (PROBE_DBL >> 7) & 1
    if (IN(7)) { router_phase(C, args); xcd_barrier(bar); if (blockIdx.x == 0 && C.tid < 64) ((unsigned*)(ws + WS_CTL) + CW_CNT)[C.tid * CNT_STRIDE] = 0u; xcd_barrier(bar); router_phase(C, args); } SEAM(7); TSTAMP(8);
#else
    RUN(7, router_phase(C, args)); TSTAMP(23); SEAM(7); TSTAMP(8);
#endif
    RUN(8, phase8(C, args)); TSTAMP(24); SEAM(8); TSTAMP(9);
    RUN(9, phase9(C, args)); TSTAMP(25); SEAM(9); TSTAMP(10);
#if (PROBE_DBL >> 10) & 1
    if (IN(10)) { final_phase(C, args, (float*)(ws + WS_ZP)); xcd_barrier(bar); final_phase(C, args); }
#else
    RUN(10, final_phase(C, args));
#endif
#if PROBE_TS
    if (blockIdx.x == PROBE_TS - 1 && C.tid == 0) { const unsigned long long* ts = (const unsigned long long*)(ws + WS_CTL) + CW_DBG / 2;
        const unsigned long long d = (__hip_atomic_load(ts + PROBE_T1, __ATOMIC_RELAXED, __HIP_MEMORY_SCOPE_AGENT) - __hip_atomic_load(ts + PROBE_T0, __ATOMIC_RELAXED, __HIP_MEMORY_SCOPE_AGENT)) * (unsigned long long)(PROBE_TK) + (unsigned long long)(PROBE_TADD);
        const unsigned long long s = wall_clock64(); while (wall_clock64() - s < d) __builtin_amdgcn_s_sleep(8); }
#endif
#undef IN
#undef SEAM
#undef RUN
}

#ifdef MK_DEBUG
namespace dbg {
constexpr int DL = 16 + 768;
__global__ void __launch_bounds__(256) k_cmp(const void* opt, int is_bf16, int old_, int ocol0, const float* ref, int rld, int rcol0, int ncols, int kind, int transform, float tol, unsigned* res) {
    __shared__ float red[4];
    const int r = blockIdx.x, p = r;
    if (kind == 0 && p < 16) return;
    if (kind >= 2 && p >= 16) return;
    const size_t orow = kind == 2 ? (size_t)p : (p < 16 ? (size_t)(NTOK + p) : (size_t)(SEQ + p - 16));
    float e2 = 0.f, r2 = 0.f;
    for (int c = threadIdx.x; c < ncols; c += 256) {
        float rv = ref[(size_t)r * rld + rcol0 + c]; if (transform == 1) rv = 1.f / (1.f + expf(-rv));
        float ov = is_bf16 ? __uint_as_float(((unsigned)((const bf16_t*)opt)[orow * old_ + ocol0 + c]) << 16) : ((const float*)opt)[orow * old_ + ocol0 + c];
        const float d = ov - rv; e2 += d * d; r2 += rv * rv; }
    e2 = nv::block_sum_256(e2, red); r2 = nv::block_sum_256(r2, red);
    if (threadIdx.x == 0) { const bool bad = !(e2 <= tol * tol * r2 + 1e-20f); if (bad) atomicAdd(res, 1u); const float rel = sqrtf(e2 / (r2 + 1e-30f)); atomicMax(res + 1, __float_as_uint(rel == rel ? rel : 3.0e38f)); }
}
__global__ void __launch_bounds__(256) k_cmp_moe(const bf16_t* YB, const float* ref, float tol, unsigned* res) {
    __shared__ float red[4];
    const int r = blockIdx.x, p = r; if (p < 16) return; const size_t t = (size_t)(SEQ + p - 16);
    float e2 = 0.f, r2 = 0.f;
    for (int c = threadIdx.x; c < DM; c += 256) { const float rv = ref[(size_t)r * DM + c];
        const float ov = __uint_as_float(((unsigned)YB[(2 * t) * DM + c]) << 16) + __uint_as_float(((unsigned)YB[(2 * t + 1) * DM + c]) << 16);
        const float d = ov - rv; e2 += d * d; r2 += rv * rv; }
    e2 = nv::block_sum_256(e2, red); r2 = nv::block_sum_256(r2, red);
    if (threadIdx.x == 0) { const bool bad = !(e2 <= tol * tol * r2 + 1e-20f); if (bad) atomicAdd(res, 1u); const float rel = sqrtf(e2 / (r2 + 1e-30f)); atomicMax(res + 1, __float_as_uint(rel == rel ? rel : 3.0e38f)); }
}
__global__ void __launch_bounds__(256) k_cmp_wt(const bf16_t* WT, int ldt, const float* W, const float* W2, int ldw, int K, int mode, float tol, unsigned* res) {
    __shared__ float red[4];
    const int n = blockIdx.x; const float* src = W; int col = n;
    if (mode == 1) { const int blk = n >> 8, within = n & 255; col = blk * 128 + (within & 127); src = within >= 128 ? W2 : W; }
    float e2 = 0.f, r2 = 0.f;
    for (int k = threadIdx.x; k < K; k += 256) { const float rv = src[(size_t)k * ldw + col]; const float ov = __uint_as_float(((unsigned)WT[(size_t)n * ldt + k]) << 16); const float d = ov - rv; e2 += d * d; r2 += rv * rv; }
    e2 = nv::block_sum_256(e2, red); r2 = nv::block_sum_256(r2, red);
    if (threadIdx.x == 0) { const bool bad = !(e2 <= tol * tol * r2 + 1e-20f); if (bad) atomicAdd(res, 1u); const float rel = sqrtf(e2 / (r2 + 1e-30f)); atomicMax(res + 1, __float_as_uint(rel == rel ? rel : 3.0e38f)); }
}
__global__ void __launch_bounds__(256) k_finalize(float* out, size_t n, const unsigned* res, int nchecks, int mode, int which) {
    int first = -1;
    for (int k = 0; k < nchecks; ++k) { const unsigned allowed = (k >= 22) ? 60u : 0u; if (res[2 * k] > allowed) { first = k; break; } }
    float K = 0.f;
    if (mode == 0) { if (first < 0) return; K = (float)(first + 1); }
    else { const float rel = __uint_as_float(res[2 * which + 1]); K = 1.f + 10.f * fminf(rel, 2.f); }
    for (size_t i = (size_t)blockIdx.x * 256 + threadIdx.x; i < n; i += (size_t)gridDim.x * 256) out[i] = K;
}
}
#endif

#ifndef MK_LAUNCHES
#define MK_LAUNCHES 1
#endif
#ifndef MK_USE_CG
#define MK_USE_CG 0
#endif
#ifndef MK_DBG_MODE
#define MK_DBG_MODE 0
#endif
#ifndef MK_DBG_WHICH
#define MK_DBG_WHICH 0
#endif
extern "C" void kernel_launch(void* const* d_in, const int* in_sizes, int n_in, void* d_out, int out_size, void* d_ws, size_t ws_size, hipStream_t stream) {
    static int grid = 0;
    if (grid == 0) {
        if (n_in != 28 || out_size != NTOK * DM || ws_size < WS_END) { fprintf(stderr, "kernel_launch: unexpected problem (n_in %d out %d ws %zu)\n", n_in, out_size, ws_size); grid = -1; return; }
        int dev = 0, cus = 0, per_cu = 0;
        if (hipGetDevice(&dev) != hipSuccess || hipDeviceGetAttribute(&cus, hipDeviceAttributeMultiprocessorCount, dev) != hipSuccess) { grid = -1; return; }
        if (hipFuncSetAttribute((const void*)mk_fwd, hipFuncAttributeMaxDynamicSharedMemorySize, LDS_BYTES) != hipSuccess) { fprintf(stderr, "kernel_launch: hipFuncSetAttribute failed\n"); grid = -1; return; }
        if (hipOccupancyMaxActiveBlocksPerMultiprocessor(&per_cu, (const void*)mk_fwd, NWAVES * 64, LDS_BYTES) != hipSuccess || per_cu < 1) { fprintf(stderr, "kernel_launch: occupancy query says %d blocks per CU\n", per_cu); grid = -1; return; }
        (void)hipGetLastError();
        if (cus != 256) { fprintf(stderr, "kernel_launch: built for a 256-CU device (role split and unit counts), found %d CUs\n", cus); grid = -1; return; }
        grid = cus;
    }
    if (grid < 0) return;
    (void)hipMemsetAsync((char*)d_ws + WS_CTL, 0, CTL_ZERO_BYTES, stream);
    Args a{};
    for (int i = 0; i < 28; ++i) a.in[i] = (const float*)d_in[i];
    a.out = (float*)d_out; a.ws = (unsigned char*)d_ws; a.use_cg = MK_USE_CG; a.pad = 0;
#if MK_LAUNCHES == 1
    a.ph_lo = 0; a.ph_hi = N_PHASES;
    void* kargs[] = {&a};
#ifdef MK_PLAIN_LAUNCH
    (void)kargs; hipLaunchKernelGGL(mk_fwd, dim3(grid), dim3(NWAVES * 64), LDS_BYTES, stream, a); hipError_t e = hipPeekAtLastError();
#else
    hipError_t e = hipLaunchCooperativeKernel((const void*)mk_fwd, dim3(grid), dim3(NWAVES * 64), kargs, LDS_BYTES, stream);
#endif
    if (e != hipSuccess) fprintf(stderr, "kernel_launch: cooperative launch failed: %s (grid %d)\n", hipGetErrorString(e), grid);
#else
    a.use_cg = 0;
#ifdef MK_DEBUG
    const size_t R = dbg::DL; unsigned char* ws = (unsigned char*)d_ws;
    float* base = (float*)(ws + WS_DBG); size_t off = 0;
    auto take = [&](size_t nfloats) { float* p = base + off; off += (nfloats + 63) & ~(size_t)63; return p; };
    nv::Bufs B; B.nH = take(R * DM); B.nU = take(R * DM); B.nZ = take(R * 6144); B.nD = take(R * 1024); B.nP = take(R * 1024); B.nS0 = take(R * 1024); B.nT = take(R * 1024); B.nS = take(R * 1024);
    B.nYP = take(R * DM); B.nYS = take(R * DM); B.nV = take(R * DM); B.nMoe = take(R * DM); float* nOut = take(R * DM); B.eid = (int*)take(R * 2); B.gate = take(R * 2); B.logits = nullptr;
    if ((size_t)((char*)(base + off) - (char*)d_ws) > ws_size) { fprintf(stderr, "debug buffers do not fit\n"); return; }
    nv::Cfg c{1, 1, dbg::DL};
    nv::run(d_in, B, nOut, 0, c, stream);
    unsigned* res = (unsigned*)(ws + WS_CTL) + CW_DBG;
    const float* const* in = (const float* const*)d_in;
    int k = 0;
#define CMP(opt, isbf, old_, oc0, ref, rld, rc0, nc, kind, tr, tol) dbg::k_cmp<<<(unsigned)R, 256, 0, stream>>>((const void*)(opt), isbf, old_, oc0, ref, rld, rc0, nc, kind, tr, tol, res + 2 * (k++))
#define CWT(WT, ldt, W, W2, ldw, K, mode, nrows) dbg::k_cmp_wt<<<(unsigned)(nrows), 256, 0, stream>>>((const bf16_t*)(WT), ldt, W, W2, ldw, K, mode, 0.01f, res + 2 * (k++))
#endif
    for (int ph = 0; ph < N_PHASES; ++ph) {
        a.ph_lo = ph; a.ph_hi = ph + 1;
        hipLaunchKernelGGL(mk_fwd, dim3(grid), dim3(NWAVES * 64), LDS_BYTES, stream, a);
#ifdef MK_DEBUG
        if (ph == 0) {
            CMP(ws + WS_A1, 1, DM, 0, B.nU, DM, 0, DM, 0, 0, 0.01f);
            CMP(ws + WS_A1M, 1, DM, 0, B.nU, DM, 0, DM, 2, 0, 0.01f);
            CWT(ws + WS_WIN, DM, in[3], nullptr, INW, DM, 0, INW);
            CWT(ws + WS_POOLW + 2 * 65536 * 2, 256, in[4] + 2 * 65536, nullptr, 256, 256, 0, 256);
            CWT(ws + WS_WGLU, SW, in[14], nullptr, SW, SW, 0, SW);
            CWT(ws + WS_WBP, PW, in[16], nullptr, DM, PW, 0, DM);
            CWT(ws + WS_WBS, SW, in[17], nullptr, DM, SW, 0, DM);
            CWT(ws + WS_WOUT, DM, in[18], nullptr, DM, DM, 0, DM);
            CWT(ws + WS_WGU + (size_t)37 * 1024 * DM * 2, DM, in[24] + (size_t)37 * DM * FF, in[25] + (size_t)37 * DM * FF, FF, DM, 1, 1024);
            CWT(ws + WS_WD + (size_t)37 * DM * FF * 2, FF, in[26] + (size_t)37 * FF * DM, nullptr, DM, FF, 0, DM);
        }
        if (ph == 1) {
            CMP(ws + WS_ZP, 1, PW, 0, B.nZ, 6144, 0, 1024, 0, 0, 0.03f);
            CMP(ws + WS_ZP, 1, PW, 0, B.nZ, 6144, 0, 1024, 3, 0, 0.03f);
            CMP(ws + WS_ZS, 1, SW, 0, B.nZ, 6144, 1024, 1024, 0, 0, 0.03f);
            CMP(ws + WS_ZS, 1, SW, 0, B.nZ, 6144, 1024, 1024, 3, 0, 0.03f);
            CMP(ws + WS_GP, 1, DM, 0, B.nZ, 6144, 2048, 2048, 0, 1, 0.03f);
            CMP(ws + WS_GS, 1, DM, 0, B.nZ, 6144, 4096, 2048, 0, 1, 0.03f);
        }
        if (ph == 2) { CMP(ws + WS_DD, 1, PW, 0, B.nD, 1024, 0, 1024, 0, 0, 0.05f); }
        if (ph == 3) { CMP(ws + WS_PP, 1, PW, 0, B.nP, 1024, 0, 1024, 0, 0, 0.05f);
                       CMP(ws + WS_S0, 1, SW, 0, B.nS0, 1024, 0, 1024, 0, 0, 0.05f); }
        if (ph == 4) { CMP(ws + WS_SS, 1, SW, 0, B.nS, 1024, 0, 1024, 0, 0, 0.05f); }
        if (ph == 5) { CMP(ws + WS_MP, 1, DM, 0, B.nYP, DM, 0, DM, 0, 0, 0.06f); }
        if (ph == 7) { CMP(ws + WS_V, 1, DM, 0, B.nH, DM, 0, DM, 0, 0, 0.03f); }
        if (ph == 9) { dbg::k_cmp_moe<<<(unsigned)R, 256, 0, stream>>>((const bf16_t*)(ws + WS_YB), B.nMoe, 0.08f, res + 2 * (k++)); }
        if (ph == 10) { CMP(d_out, 0, DM, 0, nOut, DM, 0, DM, 0, 0, 0.03f); }
#endif
    }
#ifdef MK_DEBUG
#undef CMP
#undef CWT
    dbg::k_finalize<<<1024, 256, 0, stream>>>((float*)d_out, (size_t)NTOK * DM, res, k, MK_DBG_MODE, MK_DBG_WHICH);
#endif
#endif
}
```

```cpp
#include <hip/hip_runtime.h>
#include <hip/hip_cooperative_groups.h>
#include <cstdio>
#include <cstdint>
namespace cg = cooperative_groups;

#define GAS __attribute__((address_space(1)))
#define LAS __attribute__((address_space(3)))
typedef unsigned short bf16_t;
typedef short bf16x8 __attribute__((ext_vector_type(8)));
typedef float f32x4 __attribute__((ext_vector_type(4)));
typedef float f32x16 __attribute__((ext_vector_type(16)));
typedef float f32x2 __attribute__((ext_vector_type(2)));
typedef unsigned u32x4 __attribute__((ext_vector_type(4)));
typedef unsigned u32x2 __attribute__((ext_vector_type(2)));
typedef __bf16 bf16x2v __attribute__((ext_vector_type(2)));
#define DI __device__ __forceinline__
#define RLX_AGENT __ATOMIC_RELAXED, __HIP_MEMORY_SCOPE_AGENT
#define LDS_WAIT() asm volatile("s_waitcnt lgkmcnt(0)" ::: "memory")
#define VM_WAIT() asm volatile("s_waitcnt vmcnt(0)" ::: "memory")

DI unsigned pk2(float lo, float hi) { f32x2 v = {lo, hi}; bf16x2v r = __builtin_convertvector(v, bf16x2v); return __builtin_bit_cast(unsigned, r); }
DI float bflo(unsigned w) { return __uint_as_float(w << 16); }
DI float bfhi(unsigned w) { return __uint_as_float(w & 0xffff0000u); }
DI float fsigm(float x) { return __builtin_amdgcn_rcpf(1.f + __builtin_amdgcn_exp2f(-1.4426950408889634f * x)); }
DI float gelu_t(float x) { const float z = 1.5957691216057308f * (x + 0.044715f * x * x * x); return x * fsigm(z); }
DI float wave_sum(float v) {
#pragma unroll
    for (int o = 1; o < 64; o <<= 1) v += __shfl_xor(v, o);
    return v;
}

constexpr int DM = 2048, SEQ = 8192, NTOK = 16384, NMETA = 16, INW = 6144, PW = 1024, SW = 1024, FF = 512, NE = 64;
constexpr int NCH = 64, CHL = 128;
constexpr int LISTCAP = 16384;
constexpr int HH_ROWS = 49152;
constexpr float RMS_EPS = 1e-6f;
constexpr size_t MiB = 1u << 20;
constexpr size_t WS_CTL = 0, CTL_ZERO_BYTES = 128 * 1024;
constexpr size_t WS_LAM = 1 * MiB, WS_LAMP = WS_LAM + 65536, WS_BCAT = WS_LAM + 262144, WS_CCATT = WS_LAM + 524288, WS_WRH = WS_LAM + 786432, WS_WRL = WS_WRH + 393216,
                 WS_A1M = WS_WRL + 393216, WS_SCR = WS_A1M + 65536, WS_RSTD1 = WS_SCR + 65536, WS_IG = WS_RSTD1 + 65536, WS_E = 3 * MiB, WS_LIST = 8 * MiB;
constexpr size_t WS_WIN = 24 * MiB, WS_POOLW = 48 * MiB, WS_WGLU = 49 * MiB, WS_WBP = 51 * MiB, WS_WBS = 55 * MiB, WS_WOUT = 59 * MiB, WS_WGU = 68 * MiB, WS_WD = 324 * MiB;
constexpr size_t WS_A1 = 452 * MiB, WS_V = WS_A1;
constexpr size_t WS_ZP = 516 * MiB, WS_ZS = 549 * MiB, WS_DD = 582 * MiB, WS_PP = 614 * MiB, WS_S0 = 646 * MiB, WS_SS = 678 * MiB, WS_HH = 516 * MiB, WS_DL = WS_DD;
constexpr size_t WS_GP = 710 * MiB, WS_GS = 774 * MiB, WS_YB = 710 * MiB, WS_MP = 838 * MiB, WS_DBG = 902 * MiB, WS_END = 1024 * MiB;
static_assert(WS_IG + 8192 <= WS_E && WS_E + (size_t)64 * 64 * 64 * 16 <= WS_LIST && WS_LIST + (size_t)NE * LISTCAP * 16 <= WS_WIN, "small region");
static_assert(WS_HH + (size_t)HH_ROWS * FF * 2 <= WS_GP && WS_YB + (size_t)32768 * DM * 2 <= WS_MP, "overlays");
constexpr int CW_BAR = 4096;
constexpr int CW_BAR2 = 8192;
#ifndef CNT_STRIDE
#define CNT_STRIDE 32
#endif
constexpr int CW_CNT = 16384;
constexpr int CW_DBG = 20480;
constexpr int CW_Q = 24576;

#define XB_TMO      128
#define XB_XCNT(j)  (256  + 64 * (j))
#define XB_XSUB(j)  (1280 + 64 * (j))
#define XB_XGEN(j)  (2304 + 64 * (j))
#define XB_TOP      3328
#define XB_TOPGEN   3392
#define XCD_BAR_WORDS 3456
#define XB_SPIN_CAP (1u << 18)
DI unsigned xb_ld(unsigned* p)              { return __hip_atomic_load(p, __ATOMIC_RELAXED, __HIP_MEMORY_SCOPE_AGENT); }
DI unsigned xb_add(unsigned* p, unsigned v) { return __hip_atomic_fetch_add(p, v, __ATOMIC_RELAXED, __HIP_MEMORY_SCOPE_AGENT); }
DI unsigned xb_xcc_id() { return (unsigned)__builtin_amdgcn_s_getreg((3 << 11) | 20) & 0xFu; }
#define XB_SPIN(cond, bar) do { unsigned _sp = 0; while (cond) { __builtin_amdgcn_s_sleep(1); \
    if ((++_sp & 255u) == 0u) { if (xb_ld(&(bar)[XB_TMO])) break; if (_sp > XB_SPIN_CAP) { atomicAdd(&(bar)[XB_TMO], 1u); break; } } } } while (0)
struct XcdBarrier { unsigned* bar; unsigned x; volatile LAS unsigned* st; unsigned expected; };
DI XcdBarrier xcd_barrier_post(unsigned* bar, volatile LAS unsigned* st, unsigned expected) {
    XcdBarrier b; b.bar = bar; b.x = xb_xcc_id(); b.st = st; b.expected = expected;
    if (threadIdx.x == 0) (void)xb_add(&bar[XB_XCNT(b.x)], 1u);
    return b;
}
DI void xcd_barrier_complete(unsigned* bar, unsigned x, unsigned& nloc, unsigned& nx, unsigned G) {
    unsigned sum, cnt, mine, sp = 0u;
    for (;;) {
        sum = 0u; cnt = 0u; mine = 0u;
#pragma unroll
        for (unsigned j = 0; j < 16; ++j) { const unsigned c = xb_ld(&bar[XB_XCNT(j)]); sum += c; cnt += (c > 0u) ? 1u : 0u; mine = (j == x) ? c : mine; }
        if (sum == G) break;
        __builtin_amdgcn_s_sleep(1);
        if ((++sp & 255u) == 0u) { if (xb_ld(&bar[XB_TMO])) break; if (sp > XB_SPIN_CAP) { atomicAdd(&bar[XB_TMO], 1u); break; } }
    }
    nloc = mine > 0u ? mine : 1u; nx = cnt > 0u ? cnt : 1u;
}
DI void xcd_barrier(const XcdBarrier& b) {
    asm volatile("s_waitcnt vmcnt(0)" ::: "memory");
    __syncthreads();
    if (threadIdx.x == 0) {
        unsigned* bar = b.bar;
        __builtin_amdgcn_s_waitcnt(0);
        unsigned nloc = b.st[0], nx = b.st[1];
        if (nloc == 0u) { xcd_barrier_complete(bar, b.x, nloc, nx, b.expected); b.st[0] = nloc; b.st[1] = nx; }
        const unsigned old = xb_add(&bar[XB_XSUB(b.x)], 1u);
        const unsigned gen = old / nloc;
        if (old + 1u == (gen + 1u) * nloc) {
            __builtin_amdgcn_fence(__ATOMIC_RELEASE, "agent");
            asm volatile("s_waitcnt vmcnt(0)" ::: "memory");
            const unsigned og = xb_add(&bar[XB_TOP], 1u);
            const unsigned tg = og / nx;
            if (og + 1u == (tg + 1u) * nx) xb_add(&bar[XB_TOPGEN], 1u);
            else XB_SPIN(xb_ld(&bar[XB_TOPGEN]) == tg, bar);
            __builtin_amdgcn_fence(__ATOMIC_ACQUIRE, "agent");
            xb_add(&bar[XB_XGEN(b.x)], 1u);
            asm volatile("s_waitcnt vmcnt(0)" ::: "memory");
        } else {
            XB_SPIN(xb_ld(&bar[XB_XGEN(b.x)]) == gen, bar);
            __builtin_amdgcn_fence(__ATOMIC_ACQUIRE, "agent");
            asm volatile("s_waitcnt vmcnt(0)" ::: "memory");
        }
    }
    __syncthreads();
}

namespace pg8 {
constexpr int BM = 256, BK = 64, HALF = 128, HTB = HALF * BK * 2, STAGE_BYTES = 8 * HTB, NXCD = 8, WGM = 8;
__host__ __device__ __forceinline__ int lds_byte(int r, int c) { const int st = (r >> 4) * 2 + (c >> 5), rr = r & 15, cc = c & 31, ob = rr * 64 + cc * 2; return st * 1024 + (ob ^ (((ob >> 9) & 1) << 5)); }
__host__ __device__ __forceinline__ void stage_rc(int b, int& R, int& C) { const int st = b / 1024, sb = b % 1024, swz = sb ^ (((sb >> 9) & 1) << 5); R = (st >> 1) * 16 + swz / 64; C = (st & 1) * 32 + (swz % 64) / 2; }
__host__ __device__ __forceinline__ int perm32(int rho) { const int n = rho >> 4, i = rho & 15; return 8 * (i >> 2) + 4 * n + (i & 3); }

struct Unit { const char* A; const char* B; int pm, pn, e, cnt; const uint4* list; };
struct Gemm { int lda, ldb, K; };

struct GridOrder {
    int nM, nN, nwg, G, c;
    DI void init(int nM_, int nN_, int G_, int c_) { nM = nM_; nN = nN_; nwg = nM * nN; G = G_; c = c_; }
    DI bool tile(int i, int& pm, int& pn) const {
        const long L = (long)i * G + c; if (L >= nwg) return false;
        int wgid = (int)L; { const int q = nwg / NXCD, r = nwg % NXCD, xcd = wgid % NXCD, off = wgid / NXCD; wgid = (xcd < r ? xcd * (q + 1) : r * (q + 1) + (xcd - r) * q) + off; }
        const int nig = WGM * nN, gid = wgid / nig, fm = gid * WGM, gsz = (nM - fm) < WGM ? (nM - fm) : WGM;
        pm = fm + ((wgid % nig) % gsz); pn = (wgid % nig) / gsz; return true;
    }
};
struct DenseOrder : GridOrder {
    static constexpr bool GATHER = false;
    const char* A; const char* Bt; size_t tstepA, tstepB;
    DI void setup(const void* A_, const void* Bt_, int M, int N, int lda, int ldb, int G_, int c_) { init(M / BM, N / BM, G_, c_); A = (const char*)A_; Bt = (const char*)Bt_; tstepA = (size_t)BM * lda * 2; tstepB = (size_t)BM * ldb * 2; }
    DI bool next(int i, Unit& u) const { int pm, pn; if (!tile(i, pm, pn)) return false; u.pm = pm; u.pn = pn; u.e = 0; u.cnt = 256; u.list = nullptr; u.A = A + (size_t)pm * tstepA; u.B = Bt + (size_t)pn * tstepB; return true; }
};

constexpr int SIDE_I_GU = 64 * 32 * 16, SIDE_I_DN = 64 * 8 * 64, SIDE_ITEMS = 2 * SIDE_I_GU + SIDE_I_DN;
struct SideNone { static constexpr bool ON = false; };
struct SideConv {
    static constexpr bool ON = true;
    const float *wg, *wu, *wd; bf16_t *WGU, *WD, *scratch; LAS unsigned char* xb;
    int next, end, stride;
    bf16_t* dst0; bf16_t* dst1; int ldt0, ldt1;
    DI void init(const float* wg_, const float* wu_, const float* wd_, bf16_t* WGU_, bf16_t* WD_, bf16_t* scratch_, LAS unsigned char* xb_, int begin, int end_, int stride_) {
        wg = wg_; wu = wu_; wd = wd_; WGU = WGU_; WD = WD_; scratch = scratch_; xb = xb_; next = begin; end = end_; stride = stride_; dst0 = scratch_; dst1 = scratch_; ldt0 = 0; ldt1 = 0; }
    template <int SLOT> DI void issue(int wid, int lane) {
#ifndef SIDE_PROBE
#define SIDE_PROBE 0
#endif
        int idx = next; bool valid = idx < end; if (valid) next += stride; else idx = 0;
        if (SIDE_PROBE == 2) idx = 0;
        const float* W; int ldw, k0, n0, ldt, drow0; bf16_t* WT;
        if (idx < 2 * SIDE_I_GU) { const int up = idx / SIDE_I_GU, q = idx % SIDE_I_GU, e = q >> 9, q2 = q & 511, kb = q2 >> 4, nb = q2 & 15; n0 = 32 * nb; k0 = 64 * kb;
            W = (up ? wu : wg) + (size_t)e * 2048 * 512; ldw = 512; WT = WGU + (size_t)e * 1024 * 2048; ldt = 2048; drow0 = (n0 >> 7) * 256 + (n0 & 127) + up * 128; }
        else { const int r = idx - 2 * SIDE_I_GU, e = r >> 9, q2 = r & 511, kb = q2 >> 6, nb = q2 & 63; n0 = 32 * nb; k0 = 64 * kb;
            W = wd + (size_t)e * 512 * 2048; ldw = 2048; WT = WD + (size_t)e * 2048 * 512; ldt = 512; drow0 = n0; }
        const float* src = W + (size_t)(k0 + 8 * wid + (lane >> 3)) * ldw + n0 + (lane & 7) * 4;
        __builtin_amdgcn_global_load_lds((const unsigned*)src, (LAS unsigned*)(xb + SLOT * 8192 + wid * 1024), 16, 0, 0);
        if (SIDE_PROBE == 1 || SIDE_PROBE == 2) valid = false;
        bf16_t* d = valid ? WT + (size_t)drow0 * ldt + k0 : scratch; const int l2 = valid ? ldt : 0;
        if (SLOT == 0) { dst0 = d; ldt0 = l2; } else { dst1 = d; ldt1 = l2; }
    }
    template <int SLOT> DI void read(int tid, f32x4& v) const {
        const LAS float* xf = (const LAS float*)(xb + SLOT * 8192) + (tid >> 5) * 128 + (tid & 31);
        v[0] = xf[0]; v[1] = xf[32]; v[2] = xf[64]; v[3] = xf[96];
    }
    template <int SLOT> DI void store(int tid, const f32x4& v) const {
        bf16_t* d = (SLOT == 0 ? dst0 : dst1) + (size_t)(tid & 31) * (SLOT == 0 ? ldt0 : ldt1) + 4 * (tid >> 5);
        u32x2 w; w.x = pk2(v[0], v[1]); w.y = pk2(v[2], v[3]); *(u32x2*)d = w;
    }
};

template <class Epi, class Sched, bool ALIGN_EPI = false, bool SP2 = true, class Side = SideNone>
__device__ __forceinline__ void gemm_phase(LAS unsigned char* lds, const Gemm g, const Sched& S, const Epi& E, Side side = Side()) {
    const int tid = threadIdx.x, wid = __builtin_amdgcn_readfirstlane(tid >> 6), lane = tid & 63, wr = wid >> 2, wc = wid & 3, fr = lane & 15, fq = lane >> 4;
    const int K = g.K, nt = K / BK;
    unsigned voffB[2], oA0[2], oA1[2], nA0[2], nA1[2]; int sR[2], sC[2];
    const size_t kstep = (size_t)(BK * 2);
    const unsigned hstepA = (unsigned)HALF * g.lda * 2u; const size_t hstepB = (size_t)HALF * g.ldb * 2;
#pragma unroll
    for (int i = 0; i < 2; ++i) { int R, C; stage_rc(tid * 16 + i * 8192, R, C); const int Rb = Epi::PERM ? ((R & ~31) + perm32(R & 31)) : R; sR[i] = R; sC[i] = C;
        voffB[i] = (unsigned)(Rb * g.ldb + C) * 2u; oA0[i] = (unsigned)(R * g.lda + C) * 2u; oA1[i] = oA0[i] + hstepA; nA0[i] = oA0[i]; nA1[i] = oA1[i]; }
    const unsigned ldsw = (unsigned)wid * 1024u;
    const int aoff = lds_byte(wr * 64 + fr, fq * 8), boff = lds_byte(wc * 32 + fr, fq * 8);
#define PG8_SA(b, h) (((b) * 2 + (h)) * HTB)
#define PG8_SB(b, h) ((4 + (b) * 2 + (h)) * HTB)
#define PG8_STAGE(bufoff, gbase, voff) do { _Pragma("unroll") for (int _i = 0; _i < 2; ++_i) \
        __builtin_amdgcn_global_load_lds((const unsigned*)((const char*)(gbase) + (voff)[_i]), (LAS unsigned*)(lds + (bufoff) + ldsw + _i * 8192), 16, 0, 0); } while (0)
#define PG8_LDA(dst, b, h) do { _Pragma("unroll") for (int m = 0; m < 4; ++m) _Pragma("unroll") for (int k = 0; k < 2; ++k) dst[m][k] = *(const LAS bf16x8*)(lds + PG8_SA(b, h) + aoff + m * 2048 + k * 1024); } while (0)
#define PG8_LDB(dst, b, h) do { _Pragma("unroll") for (int n = 0; n < 2; ++n) _Pragma("unroll") for (int k = 0; k < 2; ++k) dst[n][k] = *(const LAS bf16x8*)(lds + PG8_SB(b, h) + boff + n * 2048 + k * 1024); } while (0)
#define PG8_MMA(ai, bj, At, Bt) do { __builtin_amdgcn_s_setprio(1); _Pragma("unroll") for (int m = 0; m < 4; ++m) _Pragma("unroll") for (int n = 0; n < 2; ++n) _Pragma("unroll") for (int k = 0; k < 2; ++k) \
        acc[ai][bj][m][n] = __builtin_amdgcn_mfma_f32_16x16x32_bf16(Bt[n][k], At[m][k], acc[ai][bj][m][n], 0, 0, 0); __builtin_amdgcn_s_setprio(0); } while (0)
#define PG8_WAIT_V(n) asm volatile("s_waitcnt vmcnt(" #n ")" ::: "memory")
#define PG8_WAIT_L(n) asm volatile("s_waitcnt lgkmcnt(" #n ")" ::: "memory")
#define PG8_BAR __builtin_amdgcn_s_barrier()
#define PG8_SCHED __builtin_amdgcn_sched_barrier(0)
#define PG8_GOFF(u, d0, d1) do { _Pragma("unroll") for (int _i = 0; _i < 2; ++_i) { \
        const unsigned _t0 = (u).list[sR[_i]].x, _t1 = (u).list[HALF + sR[_i]].x; d0[_i] = (_t0 * (unsigned)g.lda + (unsigned)sC[_i]) * 2u; d1[_i] = (_t1 * (unsigned)g.lda + (unsigned)sC[_i]) * 2u; } } while (0)
    Unit cur, nxt; int ui = 0;
    if (!S.next(0, cur)) return;
    f32x4 acc[2][2][4][2];
#pragma unroll
    for (int a = 0; a < 2; ++a)
#pragma unroll
        for (int b = 0; b < 2; ++b)
#pragma unroll
            for (int m = 0; m < 4; ++m)
#pragma unroll
                for (int n = 0; n < 2; ++n) acc[a][b][m][n] = (f32x4){0.f, 0.f, 0.f, 0.f};
    bf16x8 At[4][2], B0[2][2], B1[2][2];
    const char* cA = cur.A; const char* cB = cur.B;
    if constexpr (Sched::GATHER) { PG8_GOFF(cur, oA0, oA1); }
    if constexpr (SP2) {
        PG8_STAGE(PG8_SB(0, 0), cB, voffB); PG8_STAGE(PG8_SB(0, 1), cB + hstepB, voffB); PG8_STAGE(PG8_SA(0, 0), cA, oA0); PG8_STAGE(PG8_SA(0, 1), cA, oA1);
        if (wr == 1) PG8_BAR;
        PG8_WAIT_V(2); PG8_BAR;
        PG8_STAGE(PG8_SB(1, 0), cB + kstep, voffB); PG8_STAGE(PG8_SA(1, 0), cA + kstep, oA0); PG8_STAGE(PG8_SB(1, 1), cB + hstepB + kstep, voffB);
        PG8_WAIT_V(6); PG8_BAR;
    } else {
        PG8_STAGE(PG8_SB(0, 0), cB, voffB); PG8_STAGE(PG8_SA(0, 0), cA, oA0); PG8_STAGE(PG8_SB(0, 1), cB + hstepB, voffB); PG8_STAGE(PG8_SA(0, 1), cA, oA1);
        if (wr == 1) PG8_BAR;
        PG8_WAIT_V(4); PG8_BAR;
        PG8_STAGE(PG8_SB(1, 0), cB + kstep, voffB); PG8_STAGE(PG8_SA(1, 0), cA + kstep, oA0); PG8_STAGE(PG8_SB(1, 1), cB + hstepB + kstep, voffB);
        PG8_WAIT_V(6); PG8_BAR;
    }
    for (;;) {
        const bool has_next = S.next(ui + 1, nxt);
        const char* nA = has_next ? nxt.A : cA; const char* nB = has_next ? nxt.B : cB;
        if constexpr (Sched::GATHER) { if (has_next) { PG8_GOFF(nxt, nA0, nA1); } else {
#pragma unroll
            for (int i = 0; i < 2; ++i) { nA0[i] = oA0[i]; nA1[i] = oA1[i]; } } }
#pragma nounroll
        for (int t = 0; t < nt; t += 2) {
            const bool last = (t == nt - 2);
            const char* a1 = cA + (size_t)(t + 1) * kstep;
            const char* a2 = last ? nA : cA + (size_t)(t + 2) * kstep; const char* b2 = last ? nB : cB + (size_t)(t + 2) * kstep;
            const char* a3 = a2 + kstep; const char* b3 = b2 + kstep;
            unsigned q0[2], q1[2];
#pragma unroll
            for (int i = 0; i < 2; ++i) { q0[i] = (Sched::GATHER && last) ? nA0[i] : oA0[i]; q1[i] = (Sched::GATHER && last) ? nA1[i] : oA1[i]; }
            if constexpr (SP2) {
            if constexpr (Side::ON) {
            f32x4 sv;
            PG8_LDB(B0, 0, 0); PG8_LDB(B1, 0, 1); PG8_SCHED; PG8_LDA(At, 0, 0); PG8_STAGE(PG8_SA(1, 1), a1, oA1); side.template read<0>(tid, sv);
            PG8_WAIT_V(9); PG8_WAIT_L(0); PG8_BAR; PG8_MMA(0, 0, At, B0); side.template store<0>(tid, sv); PG8_MMA(0, 1, At, B1); PG8_BAR; PG8_SCHED;
            PG8_LDA(At, 0, 1); PG8_STAGE(PG8_SB(0, 0), b2, voffB); PG8_STAGE(PG8_SB(0, 1), b2 + hstepB, voffB); PG8_STAGE(PG8_SA(0, 0), a2, q0);
            PG8_WAIT_V(9); PG8_WAIT_L(0); PG8_BAR; PG8_MMA(1, 0, At, B0); side.template issue<0>(wid, lane); PG8_MMA(1, 1, At, B1); PG8_BAR; PG8_SCHED;
            PG8_LDB(B0, 1, 0); PG8_LDB(B1, 1, 1); PG8_SCHED; PG8_LDA(At, 1, 0); PG8_STAGE(PG8_SA(0, 1), a2, q1); side.template read<1>(tid, sv);
            PG8_WAIT_V(9); PG8_WAIT_L(0); PG8_BAR; PG8_MMA(0, 0, At, B0); side.template store<1>(tid, sv); PG8_MMA(0, 1, At, B1); PG8_BAR; PG8_SCHED;
            PG8_LDA(At, 1, 1); PG8_STAGE(PG8_SB(1, 0), b3, voffB); PG8_STAGE(PG8_SB(1, 1), b3 + hstepB, voffB); PG8_STAGE(PG8_SA(1, 0), a3, q0);
            PG8_WAIT_V(9); PG8_WAIT_L(0); PG8_BAR; PG8_MMA(1, 0, At, B0); side.template issue<1>(wid, lane); PG8_MMA(1, 1, At, B1); PG8_BAR; PG8_SCHED;
            } else {
            PG8_LDB(B0, 0, 0); PG8_LDB(B1, 0, 1); PG8_SCHED; PG8_LDA(At, 0, 0); PG8_STAGE(PG8_SA(1, 1), a1, oA1);
            PG8_WAIT_V(8); PG8_WAIT_L(0); PG8_BAR; PG8_MMA(0, 0, At, B0); PG8_MMA(0, 1, At, B1); PG8_BAR; PG8_SCHED;
            PG8_LDA(At, 0, 1); PG8_STAGE(PG8_SB(0, 0), b2, voffB); PG8_STAGE(PG8_SB(0, 1), b2 + hstepB, voffB); PG8_STAGE(PG8_SA(0, 0), a2, q0);
            PG8_WAIT_V(8); PG8_WAIT_L(0); PG8_BAR; PG8_MMA(1, 0, At, B0); PG8_MMA(1, 1, At, B1); PG8_BAR; PG8_SCHED;
            PG8_LDB(B0, 1, 0); PG8_LDB(B1, 1, 1); PG8_SCHED; PG8_LDA(At, 1, 0); PG8_STAGE(PG8_SA(0, 1), a2, q1);
            PG8_WAIT_V(8); PG8_WAIT_L(0); PG8_BAR; PG8_MMA(0, 0, At, B0); PG8_MMA(0, 1, At, B1); PG8_BAR; PG8_SCHED;
            PG8_LDA(At, 1, 1); PG8_STAGE(PG8_SB(1, 0), b3, voffB); PG8_STAGE(PG8_SB(1, 1), b3 + hstepB, voffB); PG8_STAGE(PG8_SA(1, 0), a3, q0);
            PG8_WAIT_V(8); PG8_WAIT_L(0); PG8_BAR; PG8_MMA(1, 0, At, B0); PG8_MMA(1, 1, At, B1); PG8_BAR; PG8_SCHED;
            }
            } else {
            PG8_LDB(B0, 0, 0); PG8_SCHED; PG8_LDA(At, 0, 0); PG8_STAGE(PG8_SA(1, 1), a1, oA1);
            PG8_WAIT_L(8); PG8_BAR; PG8_WAIT_L(0); PG8_MMA(0, 0, At, B0); PG8_BAR; PG8_SCHED;
            PG8_LDB(B1, 0, 1); PG8_STAGE(PG8_SB(0, 0), b2, voffB);
            PG8_BAR; PG8_WAIT_L(0); PG8_MMA(0, 1, At, B1); PG8_BAR;
            PG8_LDA(At, 0, 1); PG8_STAGE(PG8_SA(0, 0), a2, q0);
            PG8_BAR; PG8_WAIT_L(0); PG8_MMA(1, 0, At, B0); PG8_BAR; PG8_SCHED;
            PG8_STAGE(PG8_SB(0, 1), b2 + hstepB, voffB);
            PG8_WAIT_V(6); PG8_BAR; PG8_MMA(1, 1, At, B1); PG8_BAR;
            PG8_LDB(B0, 1, 0); PG8_SCHED; PG8_LDA(At, 1, 0); PG8_STAGE(PG8_SA(0, 1), a2, q1);
            PG8_WAIT_L(8); PG8_BAR; PG8_WAIT_L(0); PG8_MMA(0, 0, At, B0); PG8_BAR; PG8_SCHED;
            PG8_LDB(B1, 1, 1); PG8_STAGE(PG8_SB(1, 0), b3, voffB);
            PG8_BAR; PG8_WAIT_L(0); PG8_MMA(0, 1, At, B1); PG8_BAR;
            PG8_LDA(At, 1, 1); PG8_STAGE(PG8_SA(1, 0), a3, q0);
            PG8_BAR; PG8_WAIT_L(0); PG8_MMA(1, 0, At, B0); PG8_BAR; PG8_SCHED;
            PG8_STAGE(PG8_SB(1, 1), b3 + hstepB, voffB);
            PG8_WAIT_V(6); PG8_BAR; PG8_MMA(1, 1, At, B1); PG8_BAR;
            }
        }
        if constexpr (ALIGN_EPI) { if (wr == 0) PG8_BAR; }
#ifndef PROBE_EPI2
#define PROBE_EPI2 0
#endif
        E(acc, cur, wr, wc, fr, fq);
        if (((PROBE_EPI2 >> Epi::EID) & 1) && Epi::IDEMPOTENT) { asm volatile("" ::: "memory"); E(acc, cur, wr, wc, fr, fq); }
        if (!has_next) break;
        if (!Epi::keep_acc(cur)) {
#pragma unroll
        for (int a = 0; a < 2; ++a)
#pragma unroll
            for (int b = 0; b < 2; ++b)
#pragma unroll
                for (int m = 0; m < 4; ++m)
#pragma unroll
                    for (int n = 0; n < 2; ++n) acc[a][b][m][n] = (f32x4){0.f, 0.f, 0.f, 0.f};
        }
        cur = nxt; cA = nA; cB = nB; ++ui;
        if constexpr (Sched::GATHER) {
#pragma unroll
            for (int i = 0; i < 2; ++i) { oA0[i] = nA0[i]; oA1[i] = nA1[i]; } }
        if constexpr (ALIGN_EPI) { if (wr == 1) PG8_BAR; }
    }
    PG8_WAIT_V(0);
    if constexpr (!ALIGN_EPI) { if (wr == 0) PG8_BAR; }
    PG8_BAR;
    if constexpr (Side::ON) { f32x4 s0, s1; side.template read<0>(tid, s0); side.template read<1>(tid, s1); PG8_WAIT_L(0); side.template store<0>(tid, s0); side.template store<1>(tid, s1); PG8_WAIT_V(0); PG8_BAR; }
#undef PG8_SA
#undef PG8_SB
#undef PG8_STAGE
#undef PG8_LDA
#undef PG8_LDB
#undef PG8_MMA
#undef PG8_WAIT_V
#undef PG8_WAIT_L
#undef PG8_BAR
#undef PG8_SCHED
#undef PG8_GOFF
}
}
#ifndef YB_FP8
#define YB_FP8 1
#endif
namespace pg8 {
#ifndef NT_STORES
#define NT_STORES 0
#endif
#if NT_STORES == 1
#define ST16(p, v) __builtin_nontemporal_store((v), (p))
#elif NT_STORES == 2
DI void st16_sc1(u32x4* p, const u32x4& v) { asm volatile("global_store_dwordx4 %0, %1, off sc1\n\ts_nop 1" :: "v"(p), "v"(v) : "memory"); }
#define ST16(p, v) st16_sc1((p), (v))
#else
#define ST16(p, v) (*(p) = (v))
#endif
typedef f32x4 Acc[2][2][4][2];
DI u32x4 pack8(const f32x4& v0, const f32x4& v1) { u32x4 w; w.x = pk2(v0[0], v0[1]); w.y = pk2(v0[2], v0[3]); w.z = pk2(v1[0], v1[1]); w.w = pk2(v1[2], v1[3]); return w; }
DI void unpack8(const u32x4& w, f32x4& v0, f32x4& v1) { v0 = (f32x4){bflo(w.x), bfhi(w.x), bflo(w.y), bfhi(w.y)}; v1 = (f32x4){bflo(w.z), bfhi(w.z), bflo(w.w), bfhi(w.w)}; }

DI unsigned pack_u8x4(const f32x4& g, float lo) { unsigned w = 0;
    w = __builtin_amdgcn_cvt_pk_u8_f32(fmaxf(__builtin_floorf(255.f * g[0] + 0.5f), lo), 0, w); w = __builtin_amdgcn_cvt_pk_u8_f32(fmaxf(__builtin_floorf(255.f * g[1] + 0.5f), lo), 1, w);
    w = __builtin_amdgcn_cvt_pk_u8_f32(fmaxf(__builtin_floorf(255.f * g[2] + 0.5f), lo), 2, w); w = __builtin_amdgcn_cvt_pk_u8_f32(fmaxf(__builtin_floorf(255.f * g[3] + 0.5f), lo), 3, w); return w; }
DI f32x4 unpack_u8x4(unsigned w) { return (f32x4){(float)(w & 0xffu), (float)((w >> 8) & 0xffu), (float)((w >> 16) & 0xffu), (float)(w >> 24)}; }
struct EpiZ {
    static DI bool keep_acc(const Unit&) { return false; }
    static constexpr bool PERM = true, IDEMPOTENT = true; static constexpr int EID = 0;
    bf16_t *ZP, *ZS; unsigned char *GP, *GS;
    DI void operator()(Acc& acc, const Unit& u, int wr, int wc, int fr, int fq) const {
        const int pn = u.pn; const int row0 = u.pm * BM + wr * 64 + fr;
        if (pn < 8) {
            bf16_t* base = pn < 4 ? ZP : ZS; const int col0 = (pn & 3) * 256 + wc * 32 + 8 * fq;
#pragma unroll
            for (int ai = 0; ai < 2; ++ai)
#pragma unroll
                for (int m = 0; m < 4; ++m) { bf16_t* rowp = base + (size_t)(row0 + ai * HALF + m * 16) * PW + col0;
#pragma unroll
                    for (int bj = 0; bj < 2; ++bj) ST16((u32x4*)(rowp + bj * HALF), pack8(acc[ai][bj][m][0], acc[ai][bj][m][1])); }
        } else {
            unsigned char* base = pn < 16 ? GP : GS; const float lo = pn < 16 ? 0.f : 1.f; const int col0 = (pn & 7) * 256 + wc * 32 + 8 * fq;
#pragma unroll
            for (int ai = 0; ai < 2; ++ai)
#pragma unroll
                for (int m = 0; m < 4; ++m) { unsigned char* rowp = base + (size_t)(row0 + ai * HALF + m * 16) * DM + col0;
#pragma unroll
                    for (int bj = 0; bj < 2; ++bj) { f32x4 v0 = acc[ai][bj][m][0], v1 = acc[ai][bj][m][1];
#pragma unroll
                        for (int j = 0; j < 4; ++j) { v0[j] = fsigm(v0[j]); v1[j] = fsigm(v1[j]); }
                        *(u32x2*)(rowp + bj * HALF) = (u32x2){pack_u8x4(v0, lo), pack_u8x4(v1, lo)}; } }
        }
    }
};
struct EpiPool {
    static DI bool keep_acc(const Unit&) { return false; }
    static constexpr bool PERM = true, IDEMPOTENT = true; static constexpr int EID = 1;
    bf16_t* PP; const float* scale;
    DI void operator()(Acc& acc, const Unit& u, int wr, int wc, int fr, int fq) const {
        const int row0 = u.pm * BM + wr * 64 + fr, col0 = u.pn * 256 + wc * 32 + 8 * fq;
        f32x4 sc[2][2];
#pragma unroll
        for (int bj = 0; bj < 2; ++bj) { sc[bj][0] = *(const f32x4*)(scale + col0 + bj * HALF); sc[bj][1] = *(const f32x4*)(scale + col0 + bj * HALF + 4); }
#pragma unroll
        for (int ai = 0; ai < 2; ++ai)
#pragma unroll
            for (int m = 0; m < 4; ++m) { bf16_t* rowp = PP + (size_t)(row0 + ai * HALF + m * 16) * PW + col0;
#pragma unroll
                for (int bj = 0; bj < 2; ++bj) *(u32x4*)(rowp + bj * HALF) = pack8(acc[ai][bj][m][0] * sc[bj][0], acc[ai][bj][m][1] * sc[bj][1]); }
    }
};
struct EpiW2 {
    static DI bool keep_acc(const Unit&) { return false; }
    static constexpr bool PERM = true, IDEMPOTENT = true; static constexpr int EID = 10;
    bf16_t* W2T;
    DI void operator()(Acc& acc, const Unit& u, int wr, int wc, int fr, int fq) const {
        const int row0 = u.pm * BM + wr * 64 + fr, col0 = u.pn * 256 + wc * 32 + 8 * fq;
#pragma unroll
        for (int ai = 0; ai < 2; ++ai)
#pragma unroll
            for (int m = 0; m < 4; ++m) { bf16_t* rowp = W2T + (size_t)(row0 + ai * HALF + m * 16) * PW + col0;
#pragma unroll
                for (int bj = 0; bj < 2; ++bj) *(u32x4*)(rowp + bj * HALF) = pack8(acc[ai][bj][m][0], acc[ai][bj][m][1]); }
    }
};
struct W2Order {
    static constexpr bool GATHER = false;
    const char* WBPT; const char* PWS; int first, stride;
    DI bool next(int i, Unit& u) const { const int un = first + i * stride; if (un >= 32) return false; const int pm = un & 7, g = un >> 3;
        u.pm = pm; u.pn = g; u.e = 0; u.cnt = 256; u.list = nullptr; u.A = WBPT + ((size_t)pm * 256 * PW + (size_t)g * 256) * 2; u.B = PWS + (size_t)g * 65536 * 2; return true; }
};
struct EpiGlu {
    static DI bool keep_acc(const Unit&) { return false; }
    static constexpr bool PERM = true, IDEMPOTENT = true; static constexpr int EID = 2;
    const bf16_t* S0; bf16_t* SS; const float* bias;
    DI void operator()(Acc& acc, const Unit& u, int wr, int wc, int fr, int fq) const {
        const int row0 = u.pm * BM + wr * 64 + fr, col0 = u.pn * 256 + wc * 32 + 8 * fq;
        f32x4 bv[2][2];
#pragma unroll
        for (int bj = 0; bj < 2; ++bj) { bv[bj][0] = *(const f32x4*)(bias + col0 + bj * HALF); bv[bj][1] = *(const f32x4*)(bias + col0 + bj * HALF + 4); }
#pragma unroll
        for (int ai = 0; ai < 2; ++ai) {
            u32x4 sw[4][2];
#pragma unroll
            for (int m = 0; m < 4; ++m)
#pragma unroll
                for (int bj = 0; bj < 2; ++bj) sw[m][bj] = *(const u32x4*)(S0 + (size_t)(row0 + ai * HALF + m * 16) * SW + col0 + bj * HALF);
#pragma unroll
            for (int m = 0; m < 4; ++m) { const size_t off = (size_t)(row0 + ai * HALF + m * 16) * SW + col0;
#pragma unroll
                for (int bj = 0; bj < 2; ++bj) { f32x4 s0, s1; unpack8(sw[m][bj], s0, s1);
                    f32x4 t0 = acc[ai][bj][m][0] + bv[bj][0], t1 = acc[ai][bj][m][1] + bv[bj][1];
#pragma unroll
                    for (int j = 0; j < 4; ++j) { t0[j] = s0[j] * fsigm(t0[j]); t1[j] = s1[j] * fsigm(t1[j]); }
                    *(u32x4*)(SS + off + bj * HALF) = pack8(t0, t1); } }
            asm volatile("" ::: "memory");
        }
    }
};
template <bool ADD> struct EpiGate {
    static DI bool keep_acc(const Unit&) { return false; }
    static constexpr bool PERM = true, IDEMPOTENT = !ADD; static constexpr int EID = 3;
    const bf16_t* G; bf16_t* MP;
    DI void operator()(Acc& acc, const Unit& u, int wr, int wc, int fr, int fq) const {
        const int row0 = u.pm * BM + wr * 64 + fr, col0 = u.pn * 256 + wc * 32 + 8 * fq;
#pragma unroll
        for (int ai = 0; ai < 2; ++ai)
#pragma unroll
            for (int m = 0; m < 4; ++m) { const size_t off = (size_t)(row0 + ai * HALF + m * 16) * DM + col0;
#pragma unroll
                for (int bj = 0; bj < 2; ++bj) { const u32x4 gw = *(const u32x4*)(G + off + bj * HALF); f32x4 g0, g1; unpack8(gw, g0, g1);
                    f32x4 t0 = acc[ai][bj][m][0] * g0, t1 = acc[ai][bj][m][1] * g1;
                    if (ADD) { const u32x4 pw = *(const u32x4*)(MP + off + bj * HALF); f32x4 p0, p1; unpack8(pw, p0, p1); t0 += p0; t1 += p1; }
                    *(u32x4*)(MP + off + bj * HALF) = pack8(t0, t1); } }
    }
};
struct EpiMerge {
    static DI bool keep_acc(const Unit& u) { return u.e == 0; }
    static constexpr bool PERM = true, IDEMPOTENT = false; static constexpr int EID = 8;
    const unsigned char* GP; const unsigned char* GS; bf16_t* MP;
    DI void operator()(Acc& acc, const Unit& u, int wr, int wc, int fr, int fq) const {
        const int row0 = u.pm * BM + wr * 64 + fr, col0 = u.pn * 256 + wc * 32 + 8 * fq;
        if (u.e == 0) {
#pragma unroll
            for (int ai = 0; ai < 2; ++ai) {
                u32x2 sw[4][2], pw[4][2];
#pragma unroll
                for (int m = 0; m < 4; ++m)
#pragma unroll
                    for (int bj = 0; bj < 2; ++bj) { const size_t off = (size_t)(row0 + ai * HALF + m * 16) * DM + col0 + bj * HALF; sw[m][bj] = *(const u32x2*)(GS + off); pw[m][bj] = *(const u32x2*)(GP + off); }
#pragma unroll
                for (int m = 0; m < 4; ++m)
#pragma unroll
                    for (int bj = 0; bj < 2; ++bj) { const f32x4 s0 = unpack_u8x4(sw[m][bj].x), s1 = unpack_u8x4(sw[m][bj].y), p0 = unpack_u8x4(pw[m][bj].x), p1 = unpack_u8x4(pw[m][bj].y);
#pragma unroll
                        for (int j = 0; j < 4; ++j) { acc[ai][bj][m][0][j] *= p0[j] * __builtin_amdgcn_rcpf(s0[j]); acc[ai][bj][m][1][j] *= p1[j] * __builtin_amdgcn_rcpf(s1[j]); } }
            }
        } else {
            constexpr float I255 = 1.f / 255.f;
#pragma unroll
            for (int ai = 0; ai < 2; ++ai) {
                u32x2 sw[4][2];
#pragma unroll
                for (int m = 0; m < 4; ++m)
#pragma unroll
                    for (int bj = 0; bj < 2; ++bj) sw[m][bj] = *(const u32x2*)(GS + (size_t)(row0 + ai * HALF + m * 16) * DM + col0 + bj * HALF);
#pragma unroll
                for (int m = 0; m < 4; ++m)
#pragma unroll
                    for (int bj = 0; bj < 2; ++bj) { const f32x4 s0 = unpack_u8x4(sw[m][bj].x) * I255, s1 = unpack_u8x4(sw[m][bj].y) * I255;
                        *(u32x4*)(MP + (size_t)(row0 + ai * HALF + m * 16) * DM + col0 + bj * HALF) = pack8(acc[ai][bj][m][0] * s0, acc[ai][bj][m][1] * s1); }
                asm volatile("" ::: "memory");
            }
        }
    }
};
struct MergeOrder : GridOrder {
    static constexpr bool GATHER = false;
    const char *A0, *B0, *A1, *B1; size_t tstepA, tstepB;
    DI bool next(int i, Unit& u) const { int pm, pn; if (!tile(i >> 1, pm, pn)) return false; const int h = i & 1; u.pm = pm; u.pn = pn; u.e = h; u.cnt = 256; u.list = nullptr;
        u.A = (h ? A1 : A0) + (size_t)pm * tstepA; u.B = (h ? B1 : B0) + (size_t)pn * tstepB; return true; }
};
struct EpiDelta {
    static DI bool keep_acc(const Unit&) { return false; }
    static constexpr bool PERM = true, IDEMPOTENT = true; static constexpr int EID = 4;
    bf16_t* DL;
    DI void operator()(Acc& acc, const Unit& u, int wr, int wc, int fr, int fq) const {
        const int row0 = u.pm * BM + wr * 64 + fr, col0 = u.pn * 256 + wc * 32 + 8 * fq;
#pragma unroll
        for (int ai = 0; ai < 2; ++ai)
#pragma unroll
            for (int m = 0; m < 4; ++m) { bf16_t* rowp = DL + (size_t)(row0 + ai * HALF + m * 16) * DM + col0;
#pragma unroll
                for (int bj = 0; bj < 2; ++bj) ST16((u32x4*)(rowp + bj * HALF), pack8(acc[ai][bj][m][0], acc[ai][bj][m][1])); }
    }
};
struct EpiH1 {
    static DI bool keep_acc(const Unit&) { return false; }
    static constexpr bool PERM = true, IDEMPOTENT = false; static constexpr int EID = 9;
    bf16_t* V; const float* rstd1; const float* ig;
    DI void operator()(Acc& acc, const Unit& u, int wr, int wc, int fr, int fq) const {
        const int row0 = u.pm * BM + wr * 64 + fr, col0 = u.pn * 256 + wc * 32 + 8 * fq;
        f32x4 g[2][2];
#pragma unroll
        for (int bj = 0; bj < 2; ++bj) { g[bj][0] = *(const f32x4*)(ig + col0 + bj * HALF); g[bj][1] = *(const f32x4*)(ig + col0 + bj * HALF + 4); }
#pragma unroll
        for (int ai = 0; ai < 2; ++ai) {
            u32x4 uw[4][2]; float inv[4];
#pragma unroll
            for (int m = 0; m < 4; ++m) { const int row = row0 + ai * HALF + m * 16; inv[m] = rstd1[row];
#pragma unroll
                for (int bj = 0; bj < 2; ++bj) uw[m][bj] = *(const u32x4*)(V + (size_t)row * DM + col0 + bj * HALF); }
#pragma unroll
            for (int m = 0; m < 4; ++m) { const float iv = __builtin_amdgcn_rcpf(inv[m]); bf16_t* rowp = V + (size_t)(row0 + ai * HALF + m * 16) * DM + col0;
#pragma unroll
                for (int bj = 0; bj < 2; ++bj) { f32x4 u0, u1; unpack8(uw[m][bj], u0, u1);
                    *(u32x4*)(rowp + bj * HALF) = pack8(u0 * g[bj][0] * iv + acc[ai][bj][m][0], u1 * g[bj][1] * iv + acc[ai][bj][m][1]); } }
            asm volatile("" ::: "memory");
        }
    }
};
struct EpiResid {
    static DI bool keep_acc(const Unit&) { return false; }
    static constexpr bool PERM = false, IDEMPOTENT = true; static constexpr int EID = 5;
    const float* X; float* H1;
    DI void operator()(Acc& acc, const Unit& u, int wr, int wc, int fr, int fq) const {
        const int row0 = u.pm * BM + wr * 64 + fr, col0 = u.pn * 256 + wc * 32 + 4 * fq;
#pragma unroll
        for (int ai = 0; ai < 2; ++ai)
#pragma unroll
            for (int m = 0; m < 4; ++m) { const size_t off = (size_t)(row0 + ai * HALF + m * 16) * DM + col0;
#pragma unroll
                for (int bj = 0; bj < 2; ++bj)
#pragma unroll
                    for (int n = 0; n < 2; ++n) { const f32x4 xv = *(const f32x4*)(X + off + bj * HALF + n * 16); *(f32x4*)(H1 + off + bj * HALF + n * 16) = xv + acc[ai][bj][m][n]; }
                asm volatile("" ::: "memory"); }
    }
};
struct EpiMoeUp {
    static DI bool keep_acc(const Unit&) { return false; }
    static constexpr bool PERM = true, IDEMPOTENT = true; static constexpr int EID = 6;
    bf16_t* HH;
    DI void operator()(Acc& acc, const Unit& u, int wr, int wc, int fr, int fq) const {
        const int col0 = u.pn * 128 + wc * 32 + 8 * fq;
        float rsv[2][4];
#pragma unroll
        for (int ai = 0; ai < 2; ++ai)
#pragma unroll
            for (int m = 0; m < 4; ++m) rsv[ai][m] = __uint_as_float(u.list[ai * HALF + wr * 64 + m * 16 + fr].w);
#pragma unroll
        for (int ai = 0; ai < 2; ++ai)
#pragma unroll
            for (int m = 0; m < 4; ++m) { const int r = ai * HALF + wr * 64 + m * 16 + fr; const float rs = rsv[ai][m];
                f32x4 g0 = acc[ai][0][m][0] * rs, g1 = acc[ai][0][m][1] * rs, u0 = acc[ai][1][m][0] * rs, u1 = acc[ai][1][m][1] * rs;
#pragma unroll
                for (int j = 0; j < 4; ++j) { g0[j] = g0[j] * fsigm(g0[j]) * u0[j]; g1[j] = g1[j] * fsigm(g1[j]) * u1[j]; }
                *(u32x4*)(HH + (size_t)(u.pm + r) * FF + col0) = pack8(g0, g1); }
    }
};
struct EpiMoeDown {
    static DI bool keep_acc(const Unit&) { return false; }
    static constexpr bool PERM = true, IDEMPOTENT = true; static constexpr int EID = 7;
    bf16_t* YB;
    DI void operator()(Acc& acc, const Unit& u, int wr, int wc, int fr, int fq) const {
        const int col0 = u.pn * 256 + wc * 32 + 8 * fq;
        unsigned dstv[2][4]; float wv[2][4];
#pragma unroll
        for (int ai = 0; ai < 2; ++ai)
#pragma unroll
            for (int m = 0; m < 4; ++m) { const uint4* le = u.list + (ai * HALF + wr * 64 + m * 16 + fr); dstv[ai][m] = le->y; wv[ai][m] = __uint_as_float(le->z); }
#pragma unroll
        for (int ai = 0; ai < 2; ++ai)
#pragma unroll
            for (int m = 0; m < 4; ++m) { const int r = ai * HALF + wr * 64 + m * 16 + fr;
#if YB_FP8
                if (r < u.cnt) { const float w = wv[ai][m] * 16.f; unsigned char* rowp = (unsigned char*)YB + (size_t)dstv[ai][m] * DM + col0;
#pragma unroll
                    for (int bj = 0; bj < 2; ++bj) { f32x4 a0 = acc[ai][bj][m][0] * w, a1 = acc[ai][bj][m][1] * w; int lo = 0, hi = 0;
#pragma unroll
                        for (int j = 0; j < 4; ++j) { a0[j] = __builtin_amdgcn_fmed3f(a0[j], -416.f, 416.f); a1[j] = __builtin_amdgcn_fmed3f(a1[j], -416.f, 416.f); }
                        lo = __builtin_amdgcn_cvt_pk_fp8_f32(a0[0], a0[1], lo, false); lo = __builtin_amdgcn_cvt_pk_fp8_f32(a0[2], a0[3], lo, true);
                        hi = __builtin_amdgcn_cvt_pk_fp8_f32(a1[0], a1[1], hi, false); hi = __builtin_amdgcn_cvt_pk_fp8_f32(a1[2], a1[3], hi, true);
                        *(u32x2*)(rowp + bj * HALF) = (u32x2){(unsigned)lo, (unsigned)hi}; } } }
#else
                if (r < u.cnt) { const float w = wv[ai][m]; bf16_t* rowp = YB + (size_t)dstv[ai][m] * DM + col0;
#pragma unroll
                    for (int bj = 0; bj < 2; ++bj) ST16((u32x4*)(rowp + bj * HALF), pack8(acc[ai][bj][m][0] * w, acc[ai][bj][m][1] * w)); } }
#endif
    }
};

struct MoeOrder {
    static constexpr bool GATHER_UP = true;
    const volatile LAS int* tab; int ntn, G, vcu; const uint4* list; const char* Abase; const char* Bbase; size_t bstep_e, bstep_n, astep_row; bool up;
    DI bool decode(int i, Unit& u) const {
        const int U = i * G + vcu; const int lane = threadIdx.x & 63;
        const int total = tab[64];
        if (U >= total) return false;
        const int ce = tab[lane + 1];
        const unsigned long long m = __ballot(ce > U);
        const int e = __builtin_amdgcn_readfirstlane((int)__builtin_ctzll(m));
        const int loc = U - tab[e]; const int mb = loc / ntn, nb = loc % ntn;
        const int cnt = tab[160 + e] - mb * 256;
        u.e = e; u.cnt = cnt < 256 ? cnt : 256; u.pn = nb; u.pm = tab[80 + e] + mb * 256; u.list = list + (size_t)e * LISTCAP + mb * 256;
        u.B = Bbase + (size_t)e * bstep_e + (size_t)nb * bstep_n;
        u.A = up ? Abase : Abase + (size_t)u.pm * astep_row;
        return true;
    }
};
struct MoeUpOrder : MoeOrder { static constexpr bool GATHER = true; DI bool next(int i, Unit& u) const { return decode(i, u); } };
struct MoeDownOrder : MoeOrder { static constexpr bool GATHER = false; DI bool next(int i, Unit& u) const { return decode(i, u); } };
struct PoolOrder : GridOrder {
    static constexpr bool GATHER = false;
    const char* DD; const char* PWT;
    DI bool next(int i, Unit& u) const { int pm, pn; if (!tile(i, pm, pn)) return false; u.pm = pm; u.pn = pn; u.e = 0; u.cnt = 256; u.list = nullptr;
        u.A = DD + ((size_t)pm * 256 * PW + (size_t)pn * 256) * 2; u.B = PWT + (size_t)pn * 65536 * 2; return true; }
};
}
#ifndef RT_LO
#define RT_LO 0
#endif
#ifndef PROBE_TS
#define PROBE_TS 0
#endif
#ifndef PROBE_T0
#define PROBE_T0 0
#endif
#ifndef PROBE_T1
#define PROBE_T1 10
#endif
#if PROBE_TS
#define TSTAMP_C(C, k) do { if (blockIdx.x == PROBE_TS - 1 && (C).tid == 0) __hip_atomic_store((unsigned long long*)((C).ws + WS_CTL) + CW_DBG / 2 + (k), (unsigned long long)wall_clock64(), __ATOMIC_RELAXED, __HIP_MEMORY_SCOPE_AGENT); } while (0)
#else
#define TSTAMP_C(C, k) do { } while (0)
#endif
#ifndef PROBE_TK
#define PROBE_TK 1
#endif
#ifndef PROBE_TADD
#define PROBE_TADD 0
#endif
constexpr int NWAVES = 8;
constexpr int RING_BYTES = 131072, XB_OFF = RING_BYTES, MISC_OFF = RING_BYTES + 16384, TAB_OFF = MISC_OFF + 256;
constexpr int LDS_BYTES = RING_BYTES + 2048 + 16384;
#ifndef SIDE_P1
#define SIDE_P1 0
#endif
#ifndef SIDE_P56
#define SIDE_P56 0
#endif
using pg8::SIDE_ITEMS;
constexpr int SIDE_N1 = SIDE_P1 ? 192 * 256 : 0, SIDE_N5 = SIDE_P56 ? 32 * 256 : 0, SIDE_N6 = SIDE_P56 ? 64 * 256 : 0;
#ifndef SIDE_PROBE
#define SIDE_PROBE 0
#endif
#ifndef CONV_PAIRS
#define CONV_PAIRS 49152
#endif
#ifndef NCONV
#define NCONV 64
#endif
#ifndef CV_QFRAC
#define CV_QFRAC 25
#endif
#define CV_GRAB 16
#define CV_STATIC (((2 * CONV_PAIRS) * (100 - CV_QFRAC) / 100) / 512 * 512)
#ifndef TAIL_IN_P8
#define TAIL_IN_P8 0
#endif
constexpr int SIDE_TOTAL = NCONV ? (TAIL_IN_P8 ? SIDE_ITEMS : 2 * CONV_PAIRS) : (SIDE_PROBE ? 0 : SIDE_N1 + 2 * SIDE_N5 + SIDE_N6);
static_assert(!TAIL_IN_P8 || 2 * CONV_PAIRS >= 2 * 64 * 32 * 16, "gate/up weights must be complete before P8");
struct Args { const float* in[28]; float* out; unsigned char* ws; int ph_lo, ph_hi, use_cg, pad; };

struct Ctx {
    LAS unsigned char* lds; unsigned char* ws; int tid, lane, wave, vcu, G, gw, NGW;
};

#define MFMA16(a, b, c) __builtin_amdgcn_mfma_f32_16x16x32_bf16((a), (b), (c), 0, 0, 0)
#define MFMA32(a, b, c) __builtin_amdgcn_mfma_f32_32x32x16_bf16((a), (b), (c), 0, 0, 0)

struct TrItem { const float* W; bf16_t* WT; const float* rs; int ldw, ldt; };
#ifndef RT_AUX
#define RT_AUX 0
#endif
#ifndef FIN_ST_NT
#define FIN_ST_NT 0
#endif
#ifndef FIN_NT
#define FIN_NT 0
#endif
#ifndef P0_NT
#define P0_NT 1
#endif
#ifndef CV_NT
#define CV_NT 1
#endif
template <bool NT = false> DI void tr_load(const TrItem& t, f32x4 (&v)[8], int lane) {
#pragma unroll
    for (int i = 0; i < 8; ++i) { const f32x4* p = (const f32x4*)(t.W + (size_t)(8 * i + (lane >> 3)) * t.ldw + 4 * (lane & 7)); v[i] = NT ? __builtin_nontemporal_load(p) : *p; }
}
template <bool NT = false> DI void tr_finish(const TrItem& t, const f32x4 (&v)[8], LAS float* scr, int lane) {
#pragma unroll
    for (int i = 0; i < 8; ++i) { LAS float* s = scr + (8 * i + (lane >> 3)) * 33 + 4 * (lane & 7); s[0] = v[i].x; s[1] = v[i].y; s[2] = v[i].z; s[3] = v[i].w; }
    LDS_WAIT(); asm volatile("" ::: "memory");
    const int c = lane & 7;
    f32x4 g0 = {1.f, 1.f, 1.f, 1.f}, g1 = g0; if (t.rs) { g0 = *(const f32x4*)(t.rs + 8 * c); g1 = *(const f32x4*)(t.rs + 8 * c + 4); }
#pragma unroll
    for (int j = 0; j < 4; ++j) { const int n = (lane >> 3) + 8 * j; const LAS float* s = scr + (8 * c) * 33 + n;
        u32x4 o; o.x = pk2(s[0 * 33] * g0.x, s[1 * 33] * g0.y); o.y = pk2(s[2 * 33] * g0.z, s[3 * 33] * g0.w); o.z = pk2(s[4 * 33] * g1.x, s[5 * 33] * g1.y); o.w = pk2(s[6 * 33] * g1.z, s[7 * 33] * g1.w);
        if (NT) __builtin_nontemporal_store(o, (u32x4*)(t.WT + (size_t)n * t.ldt + 8 * c)); else *(u32x4*)(t.WT + (size_t)n * t.ldt + 8 * c) = o; }
    LDS_WAIT(); asm volatile("" ::: "memory");
}
DI void norm_regs_bf16(const f32x4 (&v)[8], const float* g, bf16_t* orow, int lane, float* rstd_out) {
    const f32x4* gr = (const f32x4*)g + lane; float s = 0.f;
#pragma unroll
    for (int j = 0; j < 8; ++j) s += (v[j].x * v[j].x + v[j].y * v[j].y) + (v[j].z * v[j].z + v[j].w * v[j].w);
    const float rstd = rsqrtf(wave_sum(s) * (1.f / DM) + RMS_EPS);
    if (rstd_out && lane == 0) *rstd_out = rstd;
    u32x2* o8 = (u32x2*)orow + lane;
#pragma unroll
    for (int j = 0; j < 8; ++j) { const f32x4 gg = gr[64 * j]; u32x2 w; w.x = pk2(v[j].x * rstd * gg.x, v[j].y * rstd * gg.y); w.y = pk2(v[j].z * rstd * gg.z, v[j].w * rstd * gg.w); o8[64 * j] = w; }
}
DI void norm_row_bf16(const float* xrow, const float* g, bf16_t* orow, int lane, float* rstd_out = nullptr) {
    const f32x4* xr = (const f32x4*)xrow + lane; const f32x4* gr = (const f32x4*)g + lane;
    f32x4 v[8]; float s = 0.f;
#pragma unroll
    for (int j = 0; j < 8; ++j) { v[j] = xr[64 * j]; s += (v[j].x * v[j].x + v[j].y * v[j].y) + (v[j].z * v[j].z + v[j].w * v[j].w); }
    const float rstd = rsqrtf(wave_sum(s) * (1.f / DM) + RMS_EPS);
    if (rstd_out && lane == 0) *rstd_out = rstd;
    u32x2* o8 = (u32x2*)orow + lane;
#pragma unroll
    for (int j = 0; j < 8; ++j) { const f32x4 gg = gr[64 * j]; u32x2 w; w.x = pk2(v[j].x * rstd * gg.x, v[j].y * rstd * gg.y); w.y = pk2(v[j].z * rstd * gg.z, v[j].w * rstd * gg.w); o8[64 * j] = w; }
}
DI void p0_prologue(const Ctx& C, const Args& a, int part = 3) {
    unsigned char* ws = C.ws;
    LAS float* scr = (LAS float*)(C.lds + C.wave * 8448);
    LAS float* scrB = (LAS float*)(C.lds + (C.wave < 7 ? 67584 + C.wave * 8448 : XB_OFF));
    constexpr int I_IN = 32 * 192, I_PW = 0  , I_GLU = 16 * 32, I_BR = 16 * 64, I_OUT = 32 * 64, I_GU = 64 * 32 * 16, I_DN = 64 * 8 * 64;
    constexpr int NSMALL = I_IN + I_PW + I_GLU + 2 * I_BR + I_OUT;
    constexpr int NITEMS = NSMALL + (2 * I_GU + I_DN - SIDE_TOTAL);
    auto decode = [&](int it, TrItem& t) {
        int r = it < NSMALL ? it : it + SIDE_TOTAL;
        const float* W; bf16_t* WT; int ldw, ldt, k0, n0, drow0; bool gu = false;
        if (r < I_IN) { const int kb = r / 192, nb = r % 192; W = a.in[3]; ldw = INW; WT = (bf16_t*)(ws + WS_WIN); ldt = DM; k0 = 64 * kb; n0 = 32 * nb; drow0 = n0; }
        else if ((r -= I_IN) < I_PW) { const int g = r / 32, q = r % 32, kb = q / 8, nb = q % 8; W = a.in[4] + (size_t)g * 65536; ldw = 256; WT = (bf16_t*)(ws + WS_POOLW) + (size_t)g * 65536; ldt = 256; k0 = 64 * kb; n0 = 32 * nb; drow0 = n0; }
        else if ((r -= I_PW) < I_GLU) { const int kb = r / 32, nb = r % 32; W = a.in[14]; ldw = SW; WT = (bf16_t*)(ws + WS_WGLU); ldt = SW; k0 = 64 * kb; n0 = 32 * nb; drow0 = n0; }
        else if ((r -= I_GLU) < I_BR) { const int kb = r / 64, nb = r % 64; W = a.in[16]; ldw = DM; WT = (bf16_t*)(ws + WS_WBP); ldt = PW; k0 = 64 * kb; n0 = 32 * nb; drow0 = n0; }
        else if ((r -= I_BR) < I_BR) { const int kb = r / 64, nb = r % 64; W = a.in[17]; ldw = DM; WT = (bf16_t*)(ws + WS_WBS); ldt = SW; k0 = 64 * kb; n0 = 32 * nb; drow0 = n0; }
        else if ((r -= I_BR) < I_OUT) { const int kb = r / 64, nb = r % 64; W = a.in[18]; ldw = DM; WT = (bf16_t*)(ws + WS_WOUT); ldt = DM; k0 = 64 * kb; n0 = 32 * nb; drow0 = n0; }
        else if ((r -= I_OUT) < 2 * I_GU) { const int up = r / I_GU, q = r % I_GU, e = q / 512, q2 = q % 512, kb = q2 / 16, nb = q2 % 16; n0 = 32 * nb; k0 = 64 * kb;
            W = a.in[24 + up] + (size_t)e * DM * FF; ldw = FF; WT = (bf16_t*)(ws + WS_WGU) + (size_t)e * 1024 * DM; ldt = DM; drow0 = (n0 >> 7) * 256 + (n0 & 127) + up * 128; gu = true; }
        else { r -= 2 * I_GU; const int e = r / 512, q2 = r % 512, kb = q2 / 64, nb = q2 % 64; W = a.in[26] + (size_t)e * FF * DM; ldw = DM; WT = (bf16_t*)(ws + WS_WD) + (size_t)e * DM * FF; ldt = FF; k0 = 64 * kb; n0 = 32 * nb; drow0 = n0; }
        t.W = W + (size_t)k0 * ldw + n0; t.WT = WT + (size_t)drow0 * ldt + k0; t.ldw = ldw; t.ldt = ldt; t.rs = gu ? a.in[19] + k0 : nullptr;
    };
    const int it_lo = (part & 1) ? 0 : I_IN, it_hi = (part & 2) ? NITEMS : I_IN;
    for (int it = it_lo + C.gw; it < it_hi; it += 2 * C.NGW) {
        TrItem t0, t1; f32x4 v0[8], v1[8];
        const bool two = it + C.NGW < it_hi;
        decode(it, t0); tr_load<(P0_NT != 0)>(t0, v0, C.lane);
        decode(two ? it + C.NGW : it, t1); if (!two) { t1.WT = (bf16_t*)(ws + WS_SCR); t1.ldt = 64; } tr_load<(P0_NT != 0)>(t1, v1, C.lane);
        tr_finish(t0, v0, scr, C.lane);
        tr_finish(t1, v1, scrB, C.lane);
    }
    if (part & 1) {
        const int gwr = (C.gw + C.NGW / 2) % C.NGW;
        for (int m = 2 * gwr; m < NTOK; m += 2 * C.NGW) {
            const f32x4* x0 = (const f32x4*)(a.in[0] + (size_t)m * DM) + C.lane; const f32x4* x1 = x0 + DM / 4;
            f32x4 v0[8], v1[8];
#pragma unroll
            for (int j = 0; j < 8; ++j) { v0[j] = P0_NT ? __builtin_nontemporal_load(x0 + 64 * j) : x0[64 * j]; v1[j] = P0_NT ? __builtin_nontemporal_load(x1 + 64 * j) : x1[64 * j]; }
            norm_regs_bf16(v0, a.in[2], (bf16_t*)(ws + WS_A1) + (size_t)m * DM, C.lane, (float*)(ws + WS_RSTD1) + m);
            norm_regs_bf16(v1, a.in[2], (bf16_t*)(ws + WS_A1) + (size_t)(m + 1) * DM, C.lane, (float*)(ws + WS_RSTD1) + m + 1);
        }
        for (int m = C.gw; m < NMETA; m += C.NGW) norm_row_bf16(a.in[1] + (size_t)m * DM, a.in[2], (bf16_t*)(ws + WS_A1M) + (size_t)m * DM, C.lane);
        for (int i = C.gw * 64 + C.lane; i < DM; i += C.NGW * 64) ((float*)(ws + WS_IG))[i] = 1.f / a.in[2][i];
    }
    if (!(part & 2)) return;
    for (int it = (C.gw + C.NGW / 4) % C.NGW; it < 80 * DM / 64; it += C.NGW) { const int idx = it * 64 + C.lane, j = idx / DM, k = idx % DM;
        float w = 0.f; if (j < 8) w = a.in[20][k * 8 + j]; else if (j < 72) w = a.in[22][k * 64 + (j - 8)];
        w *= a.in[19][k];
        const unsigned hi = pk2(w, 0.f) & 0xffffu; const float lo = w - __uint_as_float(hi << 16);
        ((bf16_t*)(ws + WS_WRH))[idx] = (bf16_t)hi; if (RT_LO) ((bf16_t*)(ws + WS_WRL))[idx] = (bf16_t)(pk2(lo, 0.f) & 0xffffu); }
    for (int it = (C.gw + 3 * C.NGW / 4) % C.NGW; it < 4 * 256 * 256 / 512; it += C.NGW) { const int idx = (it * 64 + C.lane) * 8, j = idx & 255, g = idx >> 16;
        const f32x4 w0 = *(const f32x4*)(a.in[4] + idx), w1 = *(const f32x4*)(a.in[4] + idx + 4), s0 = *(const f32x4*)(a.in[5] + g * 256 + j), s1 = *(const f32x4*)(a.in[5] + g * 256 + j + 4);
        *(u32x4*)((bf16_t*)(ws + WS_POOLW) + idx) = pg8::pack8(w0 * s0, w1 * s1); }
    for (int g = C.gw; g < 64; g += C.NGW) { const int n = C.lane;
        const float ar = a.in[6][g * 64 + n], ai = a.in[7][g * 64 + n], dt = expf(a.in[8][g]);
        const float mag = expf(ar * dt); float sn, cs; sincosf(ai * dt, &sn, &cs);
        const float lr = mag * cs, li = mag * sn, den = ar * ar + ai * ai, nr = lr - 1.f;
        const float cr = (nr * ar + li * ai) / den, ci = (li * ar - nr * ai) / den;
        ((f32x2*)(ws + WS_LAM))[g * 64 + n] = (f32x2){lr, li};
        float pr = lr, pi = li;
#pragma unroll
        for (int s = 0; s < 7; ++s) { const float t = pr * pr - pi * pi; pi = 2.f * pr * pi; pr = t; }
        ((f32x2*)(ws + WS_LAMP))[g * 64 + n] = (f32x2){pr, pi};
        bf16_t* bc = (bf16_t*)(ws + WS_BCAT) + (size_t)g * 128 * 16; bf16_t* cc = (bf16_t*)(ws + WS_CCATT) + (size_t)g * 16 * 128;
        unsigned rp[8], ip[8];
#pragma unroll
        for (int h = 0; h < 16; h += 2) { const float b0r = a.in[9][(g * 64 + n) * 16 + h], b0i = a.in[10][(g * 64 + n) * 16 + h], b1r = a.in[9][(g * 64 + n) * 16 + h + 1], b1i = a.in[10][(g * 64 + n) * 16 + h + 1];
            rp[h / 2] = pk2(cr * b0r - ci * b0i, cr * b1r - ci * b1i); ip[h / 2] = pk2(cr * b0i + ci * b0r, cr * b1i + ci * b1r); }
        *(u32x4*)(bc + (size_t)n * 16) = (u32x4){rp[0], rp[1], rp[2], rp[3]}; *(u32x4*)(bc + (size_t)n * 16 + 8) = (u32x4){rp[4], rp[5], rp[6], rp[7]};
        *(u32x4*)(bc + (size_t)(64 + n) * 16) = (u32x4){ip[0], ip[1], ip[2], ip[3]}; *(u32x4*)(bc + (size_t)(64 + n) * 16 + 8) = (u32x4){ip[4], ip[5], ip[6], ip[7]};
#pragma unroll
        for (int h = 0; h < 16; ++h) { cc[h * 128 + n] = (bf16_t)(pk2(a.in[11][(g * 16 + h) * 64 + n], 0.f) & 0xffffu); cc[h * 128 + 64 + n] = (bf16_t)(pk2(-a.in[12][(g * 16 + h) * 64 + n], 0.f) & 0xffffu); }
    }
    for (int it = C.gw; it < NE * LISTCAP / 64; it += C.NGW) ((u32x4*)(ws + WS_LIST))[(size_t)it * 64 + C.lane] = (u32x4){0u, 0u, 0u, 0u};
}

struct CvItem { const float* W; bf16_t* WT; int ldw, ldt, gk; };
DI void cv_decode(const Args& a, unsigned char* ws, int idx, CvItem& t) {
    constexpr int I_GU = 64 * 32 * 16;
    if (idx < 2 * I_GU) { const int up = idx / I_GU, q = idx % I_GU, e = q >> 9, q2 = q & 511, kb = q2 >> 4, nb = q2 & 15, n0 = 32 * nb, k0 = 64 * kb;
        t.W = a.in[24 + up] + (size_t)e * DM * FF + (size_t)k0 * FF + n0; t.ldw = FF; t.ldt = DM; t.gk = k0;
        t.WT = (bf16_t*)(ws + WS_WGU) + (size_t)e * 1024 * DM + (size_t)((n0 >> 7) * 256 + (n0 & 127) + up * 128) * DM + k0; }
    else { const int r = idx - 2 * I_GU, e = r >> 9, q2 = r & 511, kb = q2 >> 6, nb = q2 & 63, n0 = 32 * nb, k0 = 64 * kb;
        t.W = a.in[26] + (size_t)e * FF * DM + (size_t)k0 * DM + n0; t.ldw = DM; t.ldt = FF; t.gk = -1;
        t.WT = (bf16_t*)(ws + WS_WD) + (size_t)e * DM * FF + (size_t)n0 * FF + k0; }
}
DI void cv_issue(const Ctx& C, const Args& a, int idx, LAS unsigned char* slot) {
    CvItem t; cv_decode(a, C.ws, idx, t);
    const int l = C.lane, w = C.wave;
    const float* src = t.W + (size_t)(8 * w + (l >> 3)) * t.ldw + 4 * ((l & 7) ^ w);
    __builtin_amdgcn_global_load_lds((const unsigned*)src, (LAS unsigned*)(slot + 1024 * w), 16, 0, 0);
}
DI void cv_consume(const Ctx& C, const Args& a, int idx, const LAS unsigned char* slot, const LAS float* gl) {
    CvItem t; cv_decode(a, C.ws, idx, t);
    const int l = C.lane, c = l & 7, n = 8 * (C.wave & 3) + (l >> 3);
    const LAS float* xf = (const LAS float*)slot + (8 * c) * 32 + (((n >> 2) ^ c) << 2) + (n & 3);
    float v[8];
#pragma unroll
    for (int i = 0; i < 8; ++i) v[i] = xf[i * 32];
    if (t.gk >= 0) { const f32x4 g0 = *(const LAS f32x4*)(gl + t.gk + 8 * c), g1 = *(const LAS f32x4*)(gl + t.gk + 8 * c + 4);
        v[0] *= g0.x; v[1] *= g0.y; v[2] *= g0.z; v[3] *= g0.w; v[4] *= g1.x; v[5] *= g1.y; v[6] *= g1.z; v[7] *= g1.w; }
    u32x4 o; o.x = pk2(v[0], v[1]); o.y = pk2(v[2], v[3]); o.z = pk2(v[4], v[5]); o.w = pk2(v[6], v[7]);
    *(u32x4*)(t.WT + (size_t)n * t.ldt + 8 * c) = o;
}
DI void expert_item(const Args& a, unsigned char* ws, int idx, TrItem& t) {
    constexpr int I_GU = 64 * 32 * 16;
    if (idx < 2 * I_GU) { const int up = idx / I_GU, q = idx % I_GU, e = q >> 9, q2 = q & 511, kb = q2 >> 4, nb = q2 & 15, n0 = 32 * nb, k0 = 64 * kb;
        t.W = a.in[24 + up] + (size_t)e * DM * FF + (size_t)k0 * FF + n0; t.ldw = FF; t.ldt = DM; t.rs = a.in[19] + k0;
        t.WT = (bf16_t*)(ws + WS_WGU) + (size_t)e * 1024 * DM + (size_t)((n0 >> 7) * 256 + (n0 & 127) + up * 128) * DM + k0; }
    else { const int r = idx - 2 * I_GU, e = r >> 9, q2 = r & 511, kb = q2 >> 6, nb = q2 & 63, n0 = 32 * nb, k0 = 64 * kb;
        t.W = a.in[26] + (size_t)e * FF * DM + (size_t)k0 * DM + n0; t.ldw = DM; t.ldt = FF; t.rs = nullptr;
        t.WT = (bf16_t*)(ws + WS_WD) + (size_t)e * DM * FF + (size_t)n0 * FF + k0; }
}
DI void cv_item(const Args& a, unsigned char* ws, int idx, int nitems, TrItem& t) {
    expert_item(a, ws, idx < nitems ? idx : 0, t);
    if (idx >= nitems) { t.WT = (bf16_t*)(ws + WS_SCR); t.ldt = 64; }
}
DI void convert_range(const Ctx& C, const Args& a, int start, int stride, int end) {
    const int cw = start, ncw = stride, nitems = end;
    LAS float* scr = (LAS float*)(C.lds + C.wave * 8448);
#define CV_LD(k, idx) do { cv_item(a, C.ws, (idx), nitems, t##k); tr_load<(CV_NT >= 1)>(t##k, v##k, C.lane); } while (0)
#define CV_FIN(k) tr_finish<(CV_NT >= 2)>(t##k, v##k, scr, C.lane)
    TrItem t0, t1, t2, t3; f32x4 v0[8], v1[8], v2[8], v3[8];
    CV_LD(0, cw); CV_LD(1, cw + ncw); CV_LD(2, cw + 2 * ncw);
    for (int it = cw; it < nitems; it += 4 * ncw) {
        CV_LD(3, it + 3 * ncw); CV_FIN(0); CV_LD(0, it + 4 * ncw); CV_FIN(1); CV_LD(1, it + 5 * ncw); CV_FIN(2); CV_LD(2, it + 6 * ncw); CV_FIN(3);
    }
#undef CV_LD
#undef CV_FIN
}
DI void convert_queue(const Ctx& C, const Args& a) {
    unsigned* Q = (unsigned*)(C.ws + WS_CTL) + CW_Q;
    for (;;) {
        unsigned k = 0; if (C.lane == 0) k = atomicAdd(Q, (unsigned)CV_GRAB);
        const int idx = CV_STATIC + (int)__builtin_amdgcn_readfirstlane(k);
        if (idx >= 2 * CONV_PAIRS) break;
        const int end = idx + CV_GRAB < 2 * CONV_PAIRS ? idx + CV_GRAB : 2 * CONV_PAIRS;
        convert_range(C, a, idx, 1, end);
    }
}
DI void convert_stream(const Ctx& C, const Args& a, int ci, int nconv, int npairs) {
    (void)npairs;
    convert_range(C, a, ci * NWAVES + C.wave, nconv * NWAVES, CV_STATIC); TSTAMP_C(C, 28);
    convert_queue(C, a); TSTAMP_C(C, 29);
    VM_WAIT(); __syncthreads();
}

DI void convert_tail(const Ctx& C, const Args& a) {
#if TAIL_IN_P8
    unsigned* Q = (unsigned*)(C.ws + WS_CTL) + CW_Q;
    LAS float* scr = (LAS float*)(C.lds + C.wave * 8448); LAS float* scrB = (LAS float*)(C.lds + (C.wave < 7 ? 67584 + C.wave * 8448 : XB_OFF));
    for (;;) {
        unsigned k = 0; if (C.lane == 0) k = atomicAdd(Q, 2u);
        const int idx = 2 * CONV_PAIRS + (int)__builtin_amdgcn_readfirstlane(k);
        if (idx >= SIDE_ITEMS) break;
        TrItem t0, t1; f32x4 v0[8], v1[8];
        cv_item(a, C.ws, idx, SIDE_ITEMS, t0); tr_load(t0, v0, C.lane);
        cv_item(a, C.ws, idx + 1, SIDE_ITEMS, t1); tr_load(t1, v1, C.lane);
        tr_finish(t0, v0, scr, C.lane); tr_finish(t1, v1, scrB, C.lane);
    }
    VM_WAIT();
#endif
}

DI void meta_gemm(const Ctx& C) {
    if (C.vcu >= 128) return;
    const int n0 = 16 * C.vcu, l = C.lane, r = l & 15, q = l >> 4;
    const bf16_t* ap = (const bf16_t*)(C.ws + WS_A1M) + (size_t)r * DM + C.wave * 256 + 8 * q;
    const bf16_t* wp = (const bf16_t*)(C.ws + WS_WIN) + (size_t)(n0 + r) * DM + C.wave * 256 + 8 * q;
    f32x4 acc = {0.f, 0.f, 0.f, 0.f};
#pragma unroll
    for (int ks = 0; ks < 8; ++ks) { const bf16x8 af = *(const bf16x8*)(ap + 32 * ks), wf = *(const bf16x8*)(wp + 32 * ks); acc = MFMA16(wf, af, acc); }
    LAS f32x4* red = (LAS f32x4*)(C.lds);
    red[C.wave * 64 + l] = acc;
    __syncthreads();
    if (C.wave == 0) {
#pragma unroll
        for (int w = 1; w < 8; ++w) acc += red[w * 64 + l];
        const int col = n0 + 4 * q; bf16_t* dst = (col < PW) ? (bf16_t*)(C.ws + WS_ZP) + (size_t)(NTOK + r) * PW + col : (bf16_t*)(C.ws + WS_ZS) + (size_t)(NTOK + r) * SW + (col - PW);
        u32x2 w; w.x = pk2(acc[0], acc[1]); w.y = pk2(acc[2], acc[3]); *(u32x2*)dst = w;
    }
}

DI int zrow(int b, int s) { return s >= 0 ? b * SEQ + s : NTOK + NMETA + s; }
template <int WMAX> DI void pool_item(const bf16_t* ZP, bf16_t* DD, int b, int s0, int c0, int w) {
    const float inv = 1.f / (float)w;
    f32x4 a0 = {0.f, 0.f, 0.f, 0.f}, a1 = a0;
#pragma unroll
    for (int seg = 0; seg < 2; ++seg) {
        const int sb = s0 + 8 * seg;
        u32x4 X[WMAX + 7];
#pragma unroll
        for (int k = 0; k < WMAX + 7; ++k) { const int j = WMAX - 1 - k; const int s = (j > 0 && j >= w) ? sb : sb - j; X[k] = *(const u32x4*)(ZP + (size_t)zrow(b, s) * PW + c0); }
        if (seg == 0) {
#pragma unroll
            for (int j = 1; j < WMAX; ++j) { f32x4 v0, v1; pg8::unpack8(X[WMAX - 1 - j], v0, v1); if (j < w) { a0 += v0; a1 += v1; } }
        }
#pragma unroll
        for (int t = 0; t < 8; ++t) { f32x4 c0v, c1v, l0, l1;
            pg8::unpack8(X[WMAX - 1 + t], c0v, c1v); a0 += c0v; a1 += c1v;
            *(u32x4*)(DD + (size_t)(b * SEQ + sb + t) * PW + c0) = pg8::pack8(a0 * inv - c0v, a1 * inv - c1v);
            const u32x4 Lw = X[t], Lh = X[WMAX / 2 + t];
            const bool full = (w == WMAX);
            u32x4 L; L.x = full ? Lw.x : Lh.x; L.y = full ? Lw.y : Lh.y; L.z = full ? Lw.z : Lh.z; L.w = full ? Lw.w : Lh.w;
            pg8::unpack8(L, l0, l1); a0 -= l0; a1 -= l1; }
    }
}
DI void pool_diff(const Ctx& C) {
    const bf16_t* ZP = (const bf16_t*)(C.ws + WS_ZP); bf16_t* DD = (bf16_t*)(C.ws + WS_DD);
    for (int it = C.gw; it < 2048; it += C.NGW) {
        const int tb = it >> 1, hf = it & 1, b = tb >> 9, s0 = (tb & 511) * 16, c0 = hf * 512 + C.lane * 8, w = 2 << (c0 >> 8);
        if (hf == 0) pool_item<4>(ZP, DD, b, s0, c0, w); else pool_item<16>(ZP, DD, b, s0, c0, w);
    }
}

template <bool PASS2> DI void ssm_pass(const Ctx& C, const Args& a) {
    const bf16_t* ZS = (const bf16_t*)(C.ws + WS_ZS); bf16_t* S0 = (bf16_t*)(C.ws + WS_S0);
    f32x4* Eb = (f32x4*)(C.ws + WS_E);
    const int l = C.lane, rr = l & 31, bb = (rr >> 2) & 1, jj = (rr & 3) + 4 * (rr >> 3), kofs = 8 * (l >> 5);
    LAS unsigned char* xs = C.lds + C.wave * 8704;
    for (int it = C.gw; it < 64 * NCH; it += C.NGW) {
        const int g = it & 63, c0 = (it >> 6) & 31, c = (it >> 11) ? 63 - c0 : c0;
        const f32x2 lamA = ((const f32x2*)(C.ws + WS_LAM))[g * 64 + (l & 31)], lamB = ((const f32x2*)(C.ws + WS_LAM))[g * 64 + 32 + (l & 31)];
        bf16x8 bfr[4];
#pragma unroll
        for (int ct = 0; ct < 4; ++ct) bfr[ct] = *(const bf16x8*)((const bf16_t*)(C.ws + WS_BCAT) + ((size_t)g * 128 + 32 * ct + (l & 31)) * 16 + kofs);
        float xAr = 0.f, xAi = 0.f, xBr = 0.f, xBi = 0.f;
        bf16x8 cfr[4]; f32x4 dsk = {0.f, 0.f, 0.f, 0.f};
        if constexpr (PASS2) {
#pragma unroll
            for (int ks = 0; ks < 4; ++ks) cfr[ks] = *(const bf16x8*)((const bf16_t*)(C.ws + WS_CCATT) + ((size_t)g * 16 + (l & 15)) * 128 + 32 * ks + 8 * (l >> 4));
            dsk = *(const f32x4*)(a.in[13] + g * 16 + 4 * (l >> 4));
            if (c > 0) {
                const f32x2 LA = ((const f32x2*)(C.ws + WS_LAMP))[g * 64 + (l & 31)], LB = ((const f32x2*)(C.ws + WS_LAMP))[g * 64 + 32 + (l & 31)];
                const f32x4* ep = Eb + ((size_t)g * NCH) * 64 + l;
                f32x4 t = ep[0];
                for (int j0 = 1; j0 < c; j0 += 16) {
                    f32x4 eb[16];
#pragma unroll
                    for (int i = 0; i < 16; ++i) { const int j = (j0 + i < c) ? j0 + i : c - 1; eb[i] = ep[(size_t)j * 64]; }
#pragma unroll
                    for (int i = 0; i < 16; ++i) if (j0 + i < c) { const f32x4 e = eb[i];
                        const float ar = LA.x * t.x - LA.y * t.y + e.x, ai = LA.x * t.y + LA.y * t.x + e.y, br = LB.x * t.z - LB.y * t.w + e.z, bi = LB.x * t.w + LB.y * t.z + e.w;
                        t = (f32x4){ar, ai, br, bi}; }
                }
                xAr = t.x; xAi = t.y; xBr = t.z; xBi = t.w;
            }
        }
        const int nsteps = (c == 0) ? 9 : 8;
        auto urow = [&](int st) { const bool m = (c == 0 && st == 0); const int sb = c * CHL + 16 * (st - (c == 0 ? 1 : 0)); return m ? NTOK + jj : bb * SEQ + sb + jj; };
        bf16x8 af0 = *(const bf16x8*)(ZS + (size_t)urow(0) * SW + g * 16 + kofs), af1 = *(const bf16x8*)(ZS + (size_t)urow(1) * SW + g * 16 + kofs);
        for (int st = 0; st < nsteps; ++st) {
            const bool meta = (c == 0 && st == 0);
            const int sbase = c * CHL + 16 * (st - (c == 0 ? 1 : 0));
            const bf16x8 af = af0; af0 = af1;
            { const int stn = st + 2 < nsteps ? st + 2 : nsteps - 1; af1 = *(const bf16x8*)(ZS + (size_t)urow(stn) * SW + g * 16 + kofs); }
            u32x2 uw2[2];
            if constexpr (PASS2) { const int sbc = sbase < 0 ? 0 : sbase;
#pragma unroll
                for (int hb = 0; hb < 2; ++hb) uw2[hb] = *(const u32x2*)(ZS + ((size_t)hb * SEQ + sbc + (l & 15)) * SW + g * 16 + 4 * (l >> 4)); }
            f32x16 z16;
#pragma unroll
            for (int i = 0; i < 16; ++i) z16[i] = 0.f;
            f32x16 q0 = MFMA32(af, bfr[0], z16), q1 = MFMA32(af, bfr[1], z16), q2 = MFMA32(af, bfr[2], z16), q3 = MFMA32(af, bfr[3], z16);
#pragma unroll
            for (int r = 0; r < 16; ++r) {
                const float nar = lamA.x * xAr - lamA.y * xAi + q0[r], nai = lamA.x * xAi + lamA.y * xAr + q2[r];
                const float nbr = lamB.x * xBr - lamB.y * xBi + q1[r], nbi = lamB.x * xBi + lamB.y * xBr + q3[r];
                xAr = nar; xAi = nai; xBr = nbr; xBi = nbi;
                if constexpr (PASS2) { q0[r] = nar; q1[r] = nbr; q2[r] = nai; q3[r] = nbi; }
            }
            if constexpr (PASS2) {
                if (!meta) {
#pragma unroll
                    for (int r = 0; r < 16; ++r) { LAS unsigned short* xr = (LAS unsigned short*)(xs + (16 * (l >> 5) + r) * 272) + (l & 31);
                        const unsigned wre = pk2(q0[r], q1[r]), wim = pk2(q2[r], q3[r]);
                        xr[0] = (unsigned short)(wre & 0xffffu); xr[32] = (unsigned short)(wre >> 16); xr[64] = (unsigned short)(wim & 0xffffu); xr[96] = (unsigned short)(wim >> 16); }
                    asm volatile("" ::: "memory");
#pragma unroll
                    for (int hb = 0; hb < 2; ++hb) {
                        f32x4 y = {0.f, 0.f, 0.f, 0.f};
#pragma unroll
                        for (int ks = 0; ks < 4; ++ks) { const bf16x8 xf = *(const LAS bf16x8*)(xs + (16 * hb + (l & 15)) * 272 + (32 * ks + 8 * (l >> 4)) * 2); y = MFMA16(cfr[ks], xf, y); }
                        const size_t orow = (size_t)hb * SEQ + sbase + (l & 15);
                        const u32x2 uw = uw2[hb];
                        const float s0 = y[0] + dsk[0] * bflo(uw.x), s1 = y[1] + dsk[1] * bfhi(uw.x), s2 = y[2] + dsk[2] * bflo(uw.y), s3 = y[3] + dsk[3] * bfhi(uw.y);
                        u32x2 ow; ow.x = pk2(gelu_t(s0), gelu_t(s1)); ow.y = pk2(gelu_t(s2), gelu_t(s3));
                        *(u32x2*)(S0 + orow * SW + g * 16 + 4 * (l >> 4)) = ow;
                    }
                    asm volatile("" ::: "memory");
                }
            }
        }
        if constexpr (!PASS2) Eb[((size_t)g * NCH + c) * 64 + l] = (f32x4){xAr, xAi, xBr, xBi};
    }
}

#ifndef H1_IN_EPI
#define H1_IN_EPI 1
#endif
constexpr int RT_XD = 8192, RT_NXD = 8, RT_NW = 4, RT_WOFF = RT_NXD * RT_XD, RT_W = 20480, RT_WH = 0, RT_WL = 10240;
static_assert(RT_WOFF + RT_NW * RT_W <= MISC_OFF, "router rings");
DI void rt_issue_xd(const Ctx& C, const bf16_t* U, int t0, int c, LAS unsigned char* stg) {
    const int l = C.lane, w = C.wave;
#pragma unroll
    for (int i = 0; i < 2; ++i) { const int j = 2 * w + i, row = 8 * j + (l >> 3), u = (l & 7) ^ (row & 7);
        __builtin_amdgcn_global_load_lds((const unsigned*)(U + (size_t)(t0 + row) * DM + 64 * c + 8 * u), (LAS unsigned*)(stg + 1024 * j), 16, 0, 0); }
}
DI void rt_issue_w(const Ctx& C, int c, LAS unsigned char* stg) {
    const int l = C.lane, w = C.wave - 4;
    const bf16_t* WRH = (const bf16_t*)(C.ws + WS_WRH); const bf16_t* WRL = (const bf16_t*)(C.ws + WS_WRL);
#if RT_LO
#pragma unroll
    for (int i = 0; i < 5; ++i) { const int j = 5 * w + i;
        const int jj = j < 10 ? j : j - 10, n = 8 * jj + (l >> 3), u = (l & 7) ^ (n & 7); const bf16_t* src = (j < 10 ? WRH : WRL) + (size_t)n * DM + 64 * c + 8 * u;
        __builtin_amdgcn_global_load_lds((const unsigned*)src, (LAS unsigned*)(stg + (j < 10 ? RT_WH : RT_WL) + 1024 * jj), 16, 0, 0); }
#else
    (void)WRL;
#pragma unroll
    for (int i = 0; i < 3; ++i) { const int j = w + 4 * i; if (j < 10) { const int n = 8 * j + (l >> 3), u = (l & 7) ^ (n & 7);
        __builtin_amdgcn_global_load_lds((const unsigned*)(WRH + (size_t)n * DM + 64 * c + 8 * u), (LAS unsigned*)(stg + RT_WH + 1024 * j), 16, 0, 0); } }
#endif
}
DI void router_phase(const Ctx& C, const Args& a) {
    const bf16_t* V = (const bf16_t*)(C.ws + WS_V);
    unsigned* counts = (unsigned*)(C.ws + WS_CTL) + CW_CNT; uint4* LIST = (uint4*)(C.ws + WS_LIST);
    const int l = C.lane, r = l & 15, q = l >> 4, rt = C.wave & 3, kp = C.wave >> 2;
    LAS float* part = (LAS float*)(C.lds);
    LAS float* lgb = (LAS float*)(C.lds + 32768);
    for (int tb = C.vcu; tb < NTOK / 64; tb += C.G) {
        const int t0 = tb * 64, row = 16 * rt + r;
        f32x4 acc[5];
#pragma unroll
        for (int n = 0; n < 5; ++n) acc[n] = (f32x4){0.f, 0.f, 0.f, 0.f};
        float ss = 0.f;
        if (C.wave < 4) {
#pragma unroll
            for (int s = 0; s < RT_NXD - 1; ++s) rt_issue_xd(C, V, t0, s, C.lds + s * RT_XD);
        } else {
#pragma unroll
            for (int s = 0; s < RT_NW - 1; ++s) rt_issue_w(C, s, C.lds + RT_WOFF + s * RT_W);
        }
        for (int c = 0; c < 32; ++c) {
            if (C.wave < 4) {
                if (c + RT_NXD - 2 < 32) asm volatile("s_waitcnt vmcnt(12)" ::: "memory");
                else asm volatile("s_waitcnt vmcnt(0)" ::: "memory");
            } else {
#if RT_LO
                if (c + RT_NW - 2 < 32) asm volatile("s_waitcnt vmcnt(10)" ::: "memory");
#else
                if (c + RT_NW - 2 < 32) { if (C.wave < 6) asm volatile("s_waitcnt vmcnt(6)" ::: "memory"); else asm volatile("s_waitcnt vmcnt(4)" ::: "memory"); }
#endif
                else asm volatile("s_waitcnt vmcnt(0)" ::: "memory");
            }
            LDS_WAIT(); __builtin_amdgcn_s_barrier(); asm volatile("" ::: "memory");
            if (C.wave < 4) { if (c + RT_NXD - 1 < 32) rt_issue_xd(C, V, t0, c + RT_NXD - 1, C.lds + ((c + RT_NXD - 1) & (RT_NXD - 1)) * RT_XD); }
            else { if (c + RT_NW - 1 < 32) rt_issue_w(C, c + RT_NW - 1, C.lds + RT_WOFF + ((c + RT_NW - 1) & (RT_NW - 1)) * RT_W); }
            const LAS unsigned char* stg = C.lds + (c & (RT_NXD - 1)) * RT_XD; const LAS unsigned char* wst = C.lds + RT_WOFF + (c & (RT_NW - 1)) * RT_W;
            const u32x4 uw = *(const LAS u32x4*)(stg + row * 128 + (((4 * kp + q) ^ (row & 7)) << 4));
            bf16x8 wh[5], wl[5];
#pragma unroll
            for (int n = 0; n < 5; ++n) { const int nn = 16 * n + r; const int off = nn * 128 + (((4 * kp + q) ^ (nn & 7)) << 4);
                wh[n] = *(const LAS bf16x8*)(wst + RT_WH + off); if (RT_LO) wl[n] = *(const LAS bf16x8*)(wst + RT_WL + off); }
            f32x4 h0, h1; pg8::unpack8(uw, h0, h1);
            ss += (h0.x * h0.x + h0.y * h0.y) + (h0.z * h0.z + h0.w * h0.w) + (h1.x * h1.x + h1.y * h1.y) + (h1.z * h1.z + h1.w * h1.w);
            const bf16x8 ah = __builtin_bit_cast(bf16x8, uw);
#pragma unroll
            for (int n = 0; n < 5; ++n) { acc[n] = MFMA16(wh[n], ah, acc[n]); if (RT_LO) acc[n] = MFMA16(wl[n], ah, acc[n]); }
        }
        LDS_WAIT(); __syncthreads();
        ss += __shfl_xor(ss, 16); ss += __shfl_xor(ss, 32);
        if (kp == 1) {
#pragma unroll
            for (int n = 0; n < 5; ++n)
#pragma unroll
                for (int j = 0; j < 4; ++j) part[(rt * 21 + n * 4 + j) * 64 + l] = acc[n][j];
            part[(rt * 21 + 20) * 64 + l] = ss;
        }
        __syncthreads();
        if (kp == 0) {
#pragma unroll
            for (int n = 0; n < 5; ++n)
#pragma unroll
                for (int j = 0; j < 4; ++j) acc[n][j] += part[(rt * 21 + n * 4 + j) * 64 + l];
            ss += part[(rt * 21 + 20) * 64 + l];
            const float rstd = rsqrtf(ss * (1.f / DM) + RMS_EPS);
            LAS float* lg = lgb + rt * 16 * 80;
#pragma unroll
            for (int n = 0; n < 5; ++n)
#pragma unroll
                for (int j = 0; j < 4; ++j) { const int idx = 16 * n + 4 * q + j; if (idx < 72) { const float bias = idx < 8 ? a.in[21][idx] : a.in[23][idx - 8]; lg[r * 80 + idx] = acc[n][j] * rstd + bias; } }
            LDS_WAIT(); asm volatile("" ::: "memory");
            if (l < 16) {
                const LAS float* p = lg + l * 80;
                int gs = 0; float mx = p[0];
#pragma unroll
                for (int k = 1; k < 8; ++k) { const float v = p[k]; if (v > mx) { mx = v; gs = k; } }
                float den = 0.f;
#pragma unroll
                for (int k = 0; k < 8; ++k) den += expf(p[k] - mx);
                const float pgp = 1.f / den;
                const LAS float* el = p + 8 + gs * 8;
                int i0 = 0; float v0 = el[0];
#pragma unroll
                for (int k = 1; k < 8; ++k) { const float v = el[k]; if (v > v0) { v0 = v; i0 = k; } }
                int i1 = -1; float v1 = -3.0e38f;
#pragma unroll
                for (int k = 0; k < 8; ++k) { const float v = el[k]; if (k != i0 && v > v1) { v1 = v; i1 = k; } }
                const float e1 = expf(v1 - v0), w0 = pgp / (1.f + e1), w1 = pgp * e1 / (1.f + e1);
                const int tok = t0 + 16 * rt + l, ex0 = gs * 8 + i0, ex1 = gs * 8 + i1;
                const unsigned r0 = atomicAdd(&counts[ex0 * CNT_STRIDE], 1u), r1 = atomicAdd(&counts[ex1 * CNT_STRIDE], 1u);
                LIST[(size_t)ex0 * LISTCAP + r0] = make_uint4((unsigned)tok, (unsigned)(2 * tok), __float_as_uint(w0), __float_as_uint(rstd));
                LIST[(size_t)ex1 * LISTCAP + r1] = make_uint4((unsigned)tok, (unsigned)(2 * tok + 1), __float_as_uint(w1), __float_as_uint(rstd));
            }
        }
        VM_WAIT(); __syncthreads();
    }
}
DI void moe_tables(const Ctx& C, int ntn) {
    volatile LAS int* tab = (volatile LAS int*)(C.lds + TAB_OFF);
    if (C.tid < 64) {
        const unsigned* counts = (const unsigned*)(C.ws + WS_CTL) + CW_CNT;
        const int cnt = (int)__hip_atomic_load(counts + C.tid * CNT_STRIDE, RLX_AGENT); const int nblk = (cnt + 255) >> 8;
        int incl = nblk;
#pragma unroll
        for (int o = 1; o < 64; o <<= 1) { const int t = __shfl_up(incl, o); if (C.tid >= o) incl += t; }
        tab[C.tid + 1] = incl * ntn; if (C.tid == 0) tab[0] = 0;
        tab[80 + C.tid] = (incl - nblk) * 256; tab[160 + C.tid] = cnt;
    }
    __syncthreads();
}
struct FinRow { u32x2 hw[8]; unsigned p[8], q[8]; };
DI void fin_load(FinRow& R, const unsigned char* ws, int t, int lane) {
    const u32x2* hb = (const u32x2*)((const bf16_t*)(ws + WS_V) + (size_t)t * DM) + lane;
    const unsigned* y0 = (const unsigned*)(ws + WS_YB + (size_t)(2 * t) * DM) + lane; const unsigned* y1 = (const unsigned*)(ws + WS_YB + (size_t)(2 * t + 1) * DM) + lane;
#pragma unroll
    for (int j = 0; j < 8; ++j) { if (FIN_NT) { R.hw[j] = __builtin_nontemporal_load(hb + 64 * j); R.p[j] = __builtin_nontemporal_load(y0 + 64 * j); R.q[j] = __builtin_nontemporal_load(y1 + 64 * j); }
        else { R.hw[j] = hb[64 * j]; R.p[j] = y0[64 * j]; R.q[j] = y1[64 * j]; } }
}
DI void fin_finish(const FinRow& R, const float* gfin, float* orow, int lane) {
    constexpr float IS = 1.f / 16.f;
    f32x4 v[8]; float s = 0.f;
#pragma unroll
    for (int j = 0; j < 8; ++j) { const u32x2 hw = R.hw[j]; const int p = (int)R.p[j], q = (int)R.q[j];
        v[j] = (f32x4){bflo(hw.x) + IS * (__builtin_amdgcn_cvt_f32_fp8(p, 0) + __builtin_amdgcn_cvt_f32_fp8(q, 0)), bfhi(hw.x) + IS * (__builtin_amdgcn_cvt_f32_fp8(p, 1) + __builtin_amdgcn_cvt_f32_fp8(q, 1)),
                       bflo(hw.y) + IS * (__builtin_amdgcn_cvt_f32_fp8(p, 2) + __builtin_amdgcn_cvt_f32_fp8(q, 2)), bfhi(hw.y) + IS * (__builtin_amdgcn_cvt_f32_fp8(p, 3) + __builtin_amdgcn_cvt_f32_fp8(q, 3))};
        s += (v[j].x * v[j].x + v[j].y * v[j].y) + (v[j].z * v[j].z + v[j].w * v[j].w); }
    const float rstd = rsqrtf(wave_sum(s) * (1.f / DM) + RMS_EPS);
    const f32x4* gr = (const f32x4*)gfin + lane; f32x4* o = (f32x4*)orow + lane;
#pragma unroll
    for (int j = 0; j < 8; ++j) { const f32x4 gg = gr[64 * j]; const f32x4 r = {v[j].x * rstd * gg.x, v[j].y * rstd * gg.y, v[j].z * rstd * gg.z, v[j].w * rstd * gg.w};
        if (FIN_ST_NT) __builtin_nontemporal_store(r, o + 64 * j); else o[64 * j] = r; }
}
DI void final_phase(const Ctx& C, const Args& a, float* dst_override = nullptr) {
    float* out = dst_override ? dst_override : a.out;
    static_assert(NTOK % 2 == 0, "rows are taken in pairs");
    for (int t = 2 * C.gw; t < NTOK; t += 2 * C.NGW) {
        FinRow A, B; fin_load(A, C.ws, t, C.lane); fin_load(B, C.ws, t + 1, C.lane);
        fin_finish(A, a.in[27], out + (size_t)t * DM, C.lane); fin_finish(B, a.in[27], out + (size_t)(t + 1) * DM, C.lane);
    }
}
constexpr int N_PHASES = 11;
DI bool is_conv(const Ctx& C) { return NCONV && C.G == 256 && (C.vcu & 31) >= 32 - NCONV / 8; }
DI int gemm_index(const Ctx& C) { return (C.vcu >> 5) * (32 - NCONV / 8) + (C.vcu & 31); }
DI void meta_gemm_g(const Ctx& C) { Ctx M = C; M.vcu = (NCONV && C.G == 256) ? gemm_index(C) : C.vcu; meta_gemm(M); }
DI void phase1_conv(const Ctx& C, const Args& args) { const int ng = 32 - NCONV / 8; convert_stream(C, args, (C.vcu >> 5) * (NCONV / 8) + ((C.vcu & 31) - ng), NCONV, CONV_PAIRS); }
DI void phase1_gemm(const Ctx& C, const Args& args) {
    unsigned char* ws = C.ws;
    pg8::DenseOrder S;
    if (NCONV && C.G == 256) S.setup(ws + WS_A1, ws + WS_WIN, NTOK, INW, DM, DM, 256 - NCONV, (C.vcu & 31) * 8 + (C.vcu >> 5));
    else S.setup(ws + WS_A1, ws + WS_WIN, NTOK, INW, DM, DM, C.G, (int)blockIdx.x);
    pg8::EpiZ E{(bf16_t*)(ws + WS_ZP), (bf16_t*)(ws + WS_ZS), ws + WS_GP, ws + WS_GS};
    pg8::gemm_phase<pg8::EpiZ, pg8::DenseOrder, true, true>(C.lds, pg8::Gemm{DM, DM, DM}, S, E); TSTAMP_C(C, 26);
    meta_gemm_g(C); TSTAMP_C(C, 27);
    {
        __syncthreads();
        const int ng = (NCONV && C.G == 256) ? 256 - NCONV : C.G, gi = (NCONV && C.G == 256) ? gemm_index(C) : C.vcu;
        pg8::W2Order S2; S2.WBPT = (const char*)(ws + WS_WBP); S2.PWS = (const char*)(ws + WS_POOLW); S2.first = gi; S2.stride = ng;
        pg8::EpiW2 E2{(bf16_t*)(ws + WS_PP)};
        pg8::gemm_phase<pg8::EpiW2, pg8::W2Order, true, true>(C.lds, pg8::Gemm{PW, 256, 256}, S2, E2);
    }
    if (NCONV && C.G == 256 && CV_QFRAC) { __syncthreads(); convert_queue(C, args); VM_WAIT(); __syncthreads(); }
}
DI void phase1(const Ctx& C, const Args& args) { if (is_conv(C)) phase1_conv(C, args); else phase1_gemm(C, args); }
DI void phase2(const Ctx& C, const Args& args) { pool_diff(C); TSTAMP_C(C, 30); ssm_pass<false>(C, args); }
DI void phase3(const Ctx& C, const Args& args) { TSTAMP_C(C, 31); ssm_pass<true>(C, args); }
DI void phase4(const Ctx& C, const Args& args) {
    unsigned char* ws = C.ws;
    pg8::DenseOrder S; S.setup(ws + WS_S0, ws + WS_WGLU, NTOK, SW, SW, SW, C.G, (int)blockIdx.x);
    pg8::EpiGlu E{(const bf16_t*)(ws + WS_S0), (bf16_t*)(ws + WS_SS), args.in[15]};
    pg8::gemm_phase<pg8::EpiGlu, pg8::DenseOrder, true, true>(C.lds, pg8::Gemm{SW, SW, SW}, S, E);
}
DI void phase5(const Ctx& C, const Args& args) {
    unsigned char* ws = C.ws;
    pg8::MergeOrder S; S.init(NTOK / 256, DM / 256, C.G, (int)blockIdx.x);
    S.A0 = (const char*)(ws + WS_DD); S.B0 = (const char*)(ws + WS_PP)  ; S.A1 = (const char*)(ws + WS_SS); S.B1 = (const char*)(ws + WS_WBS); S.tstepA = (size_t)256 * PW * 2; S.tstepB = (size_t)256 * PW * 2;
    pg8::EpiMerge E{ws + WS_GP, ws + WS_GS, (bf16_t*)(ws + WS_MP)};
    pg8::gemm_phase<pg8::EpiMerge, pg8::MergeOrder, true, true>(C.lds, pg8::Gemm{PW, PW, PW}, S, E);
}
DI void phase6(const Ctx& C, const Args& args) {
    unsigned char* ws = C.ws;
    pg8::DenseOrder S; S.setup(ws + WS_MP, ws + WS_WOUT, NTOK, DM, DM, DM, C.G, (int)blockIdx.x);
    pg8::EpiH1 E{(bf16_t*)(ws + WS_V), (const float*)(ws + WS_RSTD1), (const float*)(ws + WS_IG)};
#if SIDE_P56
    pg8::SideConv sd; sd.init(args.in[24], args.in[25], args.in[26], (bf16_t*)(ws + WS_WGU), (bf16_t*)(ws + WS_WD), (bf16_t*)(ws + WS_SCR), C.lds + XB_OFF, SIDE_N1 + 2 * SIDE_N5 + C.vcu, SIDE_TOTAL, C.G);
    pg8::gemm_phase<pg8::EpiH1, pg8::DenseOrder, true, true, pg8::SideConv>(C.lds, pg8::Gemm{DM, DM, DM}, S, E, sd);
#else
    pg8::gemm_phase<pg8::EpiH1, pg8::DenseOrder, true, true>(C.lds, pg8::Gemm{DM, DM, DM}, S, E);
#endif
}
DI void phase8(const Ctx& C, const Args& args) {
    unsigned char* ws = C.ws;
    __syncthreads();
    moe_tables(C, 4);
    pg8::MoeUpOrder S; S.tab = (const volatile LAS int*)(C.lds + TAB_OFF); S.ntn = 4; S.G = C.G; S.vcu = C.vcu; S.list = (const uint4*)(ws + WS_LIST);
    S.Abase = (const char*)(ws + WS_V); S.Bbase = (const char*)(ws + WS_WGU); S.bstep_e = (size_t)1024 * DM * 2; S.bstep_n = (size_t)256 * DM * 2; S.astep_row = 0; S.up = true;
    pg8::EpiMoeUp E{(bf16_t*)(ws + WS_HH)};
    pg8::gemm_phase<pg8::EpiMoeUp, pg8::MoeUpOrder, true, true>(C.lds, pg8::Gemm{DM, DM, DM}, S, E);
    convert_tail(C, args);
}
DI void phase9(const Ctx& C, const Args& args) {
    unsigned char* ws = C.ws;
    __syncthreads();
    moe_tables(C, 8);
    pg8::MoeDownOrder S; S.tab = (const volatile LAS int*)(C.lds + TAB_OFF); S.ntn = 8; S.G = C.G; S.vcu = C.vcu; S.list = (const uint4*)(ws + WS_LIST);
    S.Abase = (const char*)(ws + WS_HH); S.Bbase = (const char*)(ws + WS_WD); S.bstep_e = (size_t)DM * FF * 2; S.bstep_n = (size_t)256 * FF * 2; S.astep_row = (size_t)FF * 2; S.up = false;
    pg8::EpiMoeDown E{(bf16_t*)(ws + WS_YB)};
    pg8::gemm_phase<pg8::EpiMoeDown, pg8::MoeDownOrder, true, true>(C.lds, pg8::Gemm{FF, FF, FF}, S, E);
}
#ifndef PH_MASK
#define PH_MASK 0x7ff
#endif
#ifndef PROBE_DBL
#define PROBE_DBL 0
#endif
#ifndef OVERLAP_P0
#define OVERLAP_P0 1
#endif
__global__ void __launch_bounds__(NWAVES * 64, 2) mk_fwd(Args args) {
    extern __shared__ __attribute__((aligned(16))) unsigned char lds_raw[];
    Ctx C; C.lds = (LAS unsigned char*)lds_raw; C.ws = args.ws; C.tid = threadIdx.x; C.lane = C.tid & 63; C.wave = __builtin_amdgcn_readfirstlane(C.tid >> 6);
    C.G = gridDim.x; { const int bx = blockIdx.x; C.vcu = (C.G % 8 == 0) ? (bx % 8) * (C.G / 8) + bx / 8 : bx; }
    C.gw = C.wave * C.G + C.vcu; C.NGW = NWAVES * C.G;
    unsigned char* ws = args.ws;
    for (int u = C.tid; u < (LDS_BYTES - MISC_OFF) / 4; u += NWAVES * 64) ((LAS unsigned*)(C.lds + MISC_OFF))[u] = 0u;
    __syncthreads();
    const int lo = args.ph_lo, hi = args.ph_hi;
    XcdBarrier bar; bar.bar = (unsigned*)(ws + WS_CTL) + CW_BAR; bar.x = 0; bar.st = nullptr;
    if (hi - lo > 1) bar = xcd_barrier_post((unsigned*)(ws + WS_CTL) + CW_BAR, (volatile LAS unsigned*)(C.lds + MISC_OFF) + 8, gridDim.x);
#if NCONV && OVERLAP_P0
    XcdBarrier bar2; bar2.bar = (unsigned*)(ws + WS_CTL) + CW_BAR2; bar2.x = 0; bar2.st = nullptr; bar2.expected = 0;
    if (hi - lo > 1 && C.G == 256 && !is_conv(C)) bar2 = xcd_barrier_post((unsigned*)(ws + WS_CTL) + CW_BAR2, (volatile LAS unsigned*)(C.lds + MISC_OFF) + 10, 256 - NCONV);
#endif
#define IN(k) (((PH_MASK >> (k)) & 1) && lo <= (k) && (k) < hi)
#if PROBE_TS
#define TSTAMP(k) do { if (blockIdx.x == PROBE_TS - 1 && C.tid == 0) __hip_atomic_store((unsigned long long*)(ws + WS_CTL) + CW_DBG / 2 + (k), (unsigned long long)wall_clock64(), __ATOMIC_RELAXED, __HIP_MEMORY_SCOPE_AGENT); } while (0)
#else
#define TSTAMP(k) do { } while (0)
#endif
    TSTAMP(0);
#ifndef PROBE_BAR
#define PROBE_BAR 0
#endif
#define SEAM(k) do { if (IN(k) && IN((k) + 1)) { if (args.use_cg && (k) == 0) { cg::this_grid().sync(); } else xcd_barrier(bar); for (int pb_ = 0; pb_ < PROBE_BAR; ++pb_) xcd_barrier(bar); } } while (0)
#ifndef STAGGER
#define STAGGER 0
#endif
#ifndef STAGGER_MASK
#define STAGGER_MASK 0x362
#endif
#define RUN(k, call) do { if (IN(k)) { if (STAGGER && ((STAGGER_MASK >> (k)) & 1)) { for (int sg_ = 0; sg_ < (C.vcu & 7); ++sg_) __builtin_amdgcn_s_sleep(STAGGER); } call; if ((PROBE_DBL >> (k)) & 1) { xcd_barrier(bar); call; } } } while (0)
#if NCONV && OVERLAP_P0
    if (IN(0) && IN(1) && C.G == 256) {
        if (is_conv(C)) phase1_conv(C, args);
        else { Ctx P = C; const int gi = gemm_index(C); P.gw = C.wave * (256 - NCONV) + gi; P.NGW = NWAVES * (256 - NCONV);
               p0_prologue(P, args, 3); TSTAMP(16); xcd_barrier(bar2); TSTAMP(1); phase1_gemm(C, args); TSTAMP(17); }
    } else
#endif
    { RUN(0, p0_prologue(C, args)); SEAM(0);
      RUN(1, phase1(C, args)); }
    SEAM(1); TSTAMP(2);
    RUN(2, phase2(C, args)); TSTAMP(18); SEAM(2); TSTAMP(3);
    RUN(3, phase3(C, args)); TSTAMP(19); SEAM(3); TSTAMP(4);
    RUN(4, phase4(C, args)); TSTAMP(20); SEAM(4); TSTAMP(5);
    RUN(5, phase5(C, args)); TSTAMP(21); SEAM(5); TSTAMP(6);
    RUN(6, phase6(C, args)); TSTAMP(22); SEAM(6); TSTAMP(7);
#if (PROBE_DBL >> 7) & 1
    if (IN(7)) { router_phase(C, args); xcd_barrier(bar); if (blockIdx.x == 0 && C.tid < 64) ((unsigned*)(ws + WS_CTL) + CW_CNT)[C.tid * CNT_STRIDE] = 0u; xcd_barrier(bar); router_phase(C, args); } SEAM(7); TSTAMP(8);
#else
    RUN(7, router_phase(C, args)); TSTAMP(23); SEAM(7); TSTAMP(8);
#endif
    RUN(8, phase8(C, args)); TSTAMP(24); SEAM(8); TSTAMP(9);
    RUN(9, phase9(C, args)); TSTAMP(25); SEAM(9); TSTAMP(10);
#if (PROBE_DBL >> 10) & 1
    if (IN(10)) { final_phase(C, args, (float*)(ws + WS_ZP)); xcd_barrier(bar); final_phase(C, args); }
#else
    RUN(10, final_phase(C, args));
#endif
#if PROBE_TS
    if (blockIdx.x == PROBE_TS - 1 && C.tid == 0) { const unsigned long long* ts = (const unsigned long long*)(ws + WS_CTL) + CW_DBG / 2;
        const unsigned long long d = (__hip_atomic_load(ts + PROBE_T1, __ATOMIC_RELAXED, __HIP_MEMORY_SCOPE_AGENT) - __hip_atomic_load(ts + PROBE_T0, __ATOMIC_RELAXED, __HIP_MEMORY_SCOPE_AGENT)) * (unsigned long long)(PROBE_TK) + (unsigned long long)(PROBE_TADD);
        const unsigned long long s = wall_clock64(); while (wall_clock64() - s < d) __builtin_amdgcn_s_sleep(8); }
#endif
#undef IN
#undef SEAM
#undef RUN
}

#ifdef MK_DEBUG
namespace dbg {
constexpr int DL = 16 + 768;
__global__ void __launch_bounds__(256) k_cmp(const void* opt, int is_bf16, int old_, int ocol0, const float* ref, int rld, int rcol0, int ncols, int kind, int transform, float tol, unsigned* res) {
    __shared__ float red[4];
    const int r = blockIdx.x, p = r;
    if (kind == 0 && p < 16) return;
    if (kind >= 2 && p >= 16) return;
    const size_t orow = kind == 2 ? (size_t)p : (p < 16 ? (size_t)(NTOK + p) : (size_t)(SEQ + p - 16));
    float e2 = 0.f, r2 = 0.f;
    for (int c = threadIdx.x; c < ncols; c += 256) {
        float rv = ref[(size_t)r * rld + rcol0 + c]; if (transform == 1) rv = 1.f / (1.f + expf(-rv));
        float ov = is_bf16 ? __uint_as_float(((unsigned)((const bf16_t*)opt)[orow * old_ + ocol0 + c]) << 16) : ((const float*)opt)[orow * old_ + ocol0 + c];
        const float d = ov - rv; e2 += d * d; r2 += rv * rv; }
    e2 = nv::block_sum_256(e2, red); r2 = nv::block_sum_256(r2, red);
    if (threadIdx.x == 0) { const bool bad = !(e2 <= tol * tol * r2 + 1e-20f); if (bad) atomicAdd(res, 1u); const float rel = sqrtf(e2 / (r2 + 1e-30f)); atomicMax(res + 1, __float_as_uint(rel == rel ? rel : 3.0e38f)); }
}
__global__ void __launch_bounds__(256) k_cmp_moe(const bf16_t* YB, const float* ref, float tol, unsigned* res) {
    __shared__ float red[4];
    const int r = blockIdx.x, p = r; if (p < 16) return; const size_t t = (size_t)(SEQ + p - 16);
    float e2 = 0.f, r2 = 0.f;
    for (int c = threadIdx.x; c < DM; c += 256) { const float rv = ref[(size_t)r * DM + c];
        const float ov = __uint_as_float(((unsigned)YB[(2 * t) * DM + c]) << 16) + __uint_as_float(((unsigned)YB[(2 * t + 1) * DM + c]) << 16);
        const float d = ov - rv; e2 += d * d; r2 += rv * rv; }
    e2 = nv::block_sum_256(e2, red); r2 = nv::block_sum_256(r2, red);
    if (threadIdx.x == 0) { const bool bad = !(e2 <= tol * tol * r2 + 1e-20f); if (bad) atomicAdd(res, 1u); const float rel = sqrtf(e2 / (r2 + 1e-30f)); atomicMax(res + 1, __float_as_uint(rel == rel ? rel : 3.0e38f)); }
}
__global__ void __launch_bounds__(256) k_cmp_wt(const bf16_t* WT, int ldt, const float* W, const float* W2, int ldw, int K, int mode, float tol, unsigned* res) {
    __shared__ float red[4];
    const int n = blockIdx.x; const float* src = W; int col = n;
    if (mode == 1) { const int blk = n >> 8, within = n & 255; col = blk * 128 + (within & 127); src = within >= 128 ? W2 : W; }
    float e2 = 0.f, r2 = 0.f;
    for (int k = threadIdx.x; k < K; k += 256) { const float rv = src[(size_t)k * ldw + col]; const float ov = __uint_as_float(((unsigned)WT[(size_t)n * ldt + k]) << 16); const float d = ov - rv; e2 += d * d; r2 += rv * rv; }
    e2 = nv::block_sum_256(e2, red); r2 = nv::block_sum_256(r2, red);
    if (threadIdx.x == 0) { const bool bad = !(e2 <= tol * tol * r2 + 1e-20f); if (bad) atomicAdd(res, 1u); const float rel = sqrtf(e2 / (r2 + 1e-30f)); atomicMax(res + 1, __float_as_uint(rel == rel ? rel : 3.0e38f)); }
}
__global__ void __launch_bounds__(256) k_finalize(float* out, size_t n, const unsigned* res, int nchecks, int mode, int which) {
    int first = -1;
    for (int k = 0; k < nchecks; ++k) { const unsigned allowed = (k >= 22) ? 60u : 0u; if (res[2 * k] > allowed) { first = k; break; } }
    float K = 0.f;
    if (mode == 0) { if (first < 0) return; K = (float)(first + 1); }
    else { const float rel = __uint_as_float(res[2 * which + 1]); K = 1.f + 10.f * fminf(rel, 2.f); }
    for (size_t i = (size_t)blockIdx.x * 256 + threadIdx.x; i < n; i += (size_t)gridDim.x * 256) out[i] = K;
}
}
#endif

#ifndef MK_LAUNCHES
#define MK_LAUNCHES 1
#endif
#ifndef MK_USE_CG
#define MK_USE_CG 0
#endif
#ifndef MK_DBG_MODE
#define MK_DBG_MODE 0
#endif
#ifndef MK_DBG_WHICH
#define MK_DBG_WHICH 0
#endif
extern "C" void kernel_launch(void* const* d_in, const int* in_sizes, int n_in, void* d_out, int out_size, void* d_ws, size_t ws_size, hipStream_t stream) {
    static int grid = 0;
    if (grid == 0) {
        if (n_in != 28 || out_size != NTOK * DM || ws_size < WS_END) { fprintf(stderr, "kernel_launch: unexpected problem (n_in %d out %d ws %zu)\n", n_in, out_size, ws_size); grid = -1; return; }
        int dev = 0, cus = 0, per_cu = 0;
        if (hipGetDevice(&dev) != hipSuccess || hipDeviceGetAttribute(&cus, hipDeviceAttributeMultiprocessorCount, dev) != hipSuccess) { grid = -1; return; }
        if (hipFuncSetAttribute((const void*)mk_fwd, hipFuncAttributeMaxDynamicSharedMemorySize, LDS_BYTES) != hipSuccess) { fprintf(stderr, "kernel_launch: hipFuncSetAttribute failed\n"); grid = -1; return; }
        if (hipOccupancyMaxActiveBlocksPerMultiprocessor(&per_cu, (const void*)mk_fwd, NWAVES * 64, LDS_BYTES) != hipSuccess || per_cu < 1) { fprintf(stderr, "kernel_launch: occupancy query says %d blocks per CU\n", per_cu); grid = -1; return; }
        (void)hipGetLastError();
        if (cus != 256) { fprintf(stderr, "kernel_launch: built for a 256-CU device (role split and unit counts), found %d CUs\n", cus); grid = -1; return; }
        grid = cus;
    }
    if (grid < 0) return;
    (void)hipMemsetAsync((char*)d_ws + WS_CTL, 0, CTL_ZERO_BYTES, stream);
    Args a{};
    for (int i = 0; i < 28; ++i) a.in[i] = (const float*)d_in[i];
    a.out = (float*)d_out; a.ws = (unsigned char*)d_ws; a.use_cg = MK_USE_CG; a.pad = 0;
#if MK_LAUNCHES == 1
    a.ph_lo = 0; a.ph_hi = N_PHASES;
    void* kargs[] = {&a};
#ifdef MK_PLAIN_LAUNCH
    (void)kargs; hipLaunchKernelGGL(mk_fwd, dim3(grid), dim3(NWAVES * 64), LDS_BYTES, stream, a); hipError_t e = hipPeekAtLastError();
#else
    hipError_t e = hipLaunchCooperativeKernel((const void*)mk_fwd, dim3(grid), dim3(NWAVES * 64), kargs, LDS_BYTES, stream);
#endif
    if (e != hipSuccess) fprintf(stderr, "kernel_launch: cooperative launch failed: %s (grid %d)\n", hipGetErrorString(e), grid);
#else
    a.use_cg = 0;
#ifdef MK_DEBUG
    const size_t R = dbg::DL; unsigned char* ws = (unsigned char*)d_ws;
    float* base = (float*)(ws + WS_DBG); size_t off = 0;
    auto take = [&](size_t nfloats) { float* p = base + off; off += (nfloats + 63) & ~(size_t)63; return p; };
    nv::Bufs B; B.nH = take(R * DM); B.nU = take(R * DM); B.nZ = take(R * 6144); B.nD = take(R * 1024); B.nP = take(R * 1024); B.nS0 = take(R * 1024); B.nT = take(R * 1024); B.nS = take(R * 1024);
    B.nYP = take(R * DM); B.nYS = take(R * DM); B.nV = take(R * DM); B.nMoe = take(R * DM); float* nOut = take(R * DM); B.eid = (int*)take(R * 2); B.gate = take(R * 2); B.logits = nullptr;
    if ((size_t)((char*)(base + off) - (char*)d_ws) > ws_size) { fprintf(stderr, "debug buffers do not fit\n"); return; }
    nv::Cfg c{1, 1, dbg::DL};
    nv::run(d_in, B, nOut, 0, c, stream);
    unsigned* res = (unsigned*)(ws + WS_CTL) + CW_DBG;
    const float* const* in = (const float* const*)d_in;
    int k = 0;
#define CMP(opt, isbf, old_, oc0, ref, rld, rc0, nc, kind, tr, tol) dbg::k_cmp<<<(unsigned)R, 256, 0, stream>>>((const void*)(opt), isbf, old_, oc0, ref, rld, rc0, nc, kind, tr, tol, res + 2 * (k++))
#define CWT(WT, ldt, W, W2, ldw, K, mode, nrows) dbg::k_cmp_wt<<<(unsigned)(nrows), 256, 0, stream>>>((const bf16_t*)(WT), ldt, W, W2, ldw, K, mode, 0.01f, res + 2 * (k++))
#endif
    for (int ph = 0; ph < N_PHASES; ++ph) {
        a.ph_lo = ph; a.ph_hi = ph + 1;
        hipLaunchKernelGGL(mk_fwd, dim3(grid), dim3(NWAVES * 64), LDS_BYTES, stream, a);
#ifdef MK_DEBUG
        if (ph == 0) {
            CMP(ws + WS_A1, 1, DM, 0, B.nU, DM, 0, DM, 0, 0, 0.01f);
            CMP(ws + WS_A1M, 1, DM, 0, B.nU, DM, 0, DM, 2, 0, 0.01f);
            CWT(ws + WS_WIN, DM, in[3], nullptr, INW, DM, 0, INW);
            CWT(ws + WS_POOLW + 2 * 65536 * 2, 256, in[4] + 2 * 65536, nullptr, 256, 256, 0, 256);
            CWT(ws + WS_WGLU, SW, in[14], nullptr, SW, SW, 0, SW);
            CWT(ws + WS_WBP, PW, in[16], nullptr, DM, PW, 0, DM);
            CWT(ws + WS_WBS, SW, in[17], nullptr, DM, SW, 0, DM);
            CWT(ws + WS_WOUT, DM, in[18], nullptr, DM, DM, 0, DM);
            CWT(ws + WS_WGU + (size_t)37 * 1024 * DM * 2, DM, in[24] + (size_t)37 * DM * FF, in[25] + (size_t)37 * DM * FF, FF, DM, 1, 1024);
            CWT(ws + WS_WD + (size_t)37 * DM * FF * 2, FF, in[26] + (size_t)37 * FF * DM, nullptr, DM, FF, 0, DM);
        }
        if (ph == 1) {
            CMP(ws + WS_ZP, 1, PW, 0, B.nZ, 6144, 0, 1024, 0, 0, 0.03f);
            CMP(ws + WS_ZP, 1, PW, 0, B.nZ, 6144, 0, 1024, 3, 0, 0.03f);
            CMP(ws + WS_ZS, 1, SW, 0, B.nZ, 6144, 1024, 1024, 0, 0, 0.03f);
            CMP(ws + WS_ZS, 1, SW, 0, B.nZ, 6144, 1024, 1024, 3, 0, 0.03f);
            CMP(ws + WS_GP, 1, DM, 0, B.nZ, 6144, 2048, 2048, 0, 1, 0.03f);
            CMP(ws + WS_GS, 1, DM, 0, B.nZ, 6144, 4096, 2048, 0, 1, 0.03f);
        }
        if (ph == 2) { CMP(ws + WS_DD, 1, PW, 0, B.nD, 1024, 0, 1024, 0, 0, 0.05f); }
        if (ph == 3) { CMP(ws + WS_PP, 1, PW, 0, B.nP, 1024, 0, 1024, 0, 0, 0.05f);
                       CMP(ws + WS_S0, 1, SW, 0, B.nS0, 1024, 0, 1024, 0, 0, 0.05f); }
        if (ph == 4) { CMP(ws + WS_SS, 1, SW, 0, B.nS, 1024, 0, 1024, 0, 0, 0.05f); }
        if (ph == 5) { CMP(ws + WS_MP, 1, DM, 0, B.nYP, DM, 0, DM, 0, 0, 0.06f); }
        if (ph == 7) { CMP(ws + WS_V, 1, DM, 0, B.nH, DM, 0, DM, 0, 0, 0.03f); }
        if (ph == 9) { dbg::k_cmp_moe<<<(unsigned)R, 256, 0, stream>>>((const bf16_t*)(ws + WS_YB), B.nMoe, 0.08f, res + 2 * (k++)); }
        if (ph == 10) { CMP(d_out, 0, DM, 0, nOut, DM, 0, DM, 0, 0, 0.03f); }
#endif
    }
#ifdef MK_DEBUG
#undef CMP
#undef CWT
    dbg::k_finalize<<<1024, 256, 0, stream>>>((float*)d_out, (size_t)NTOK * DM, res, k, MK_DBG_MODE, MK_DBG_WHICH);
#endif
#endif
}
```
